# Optimizing an MI355X kernel written in HIP

```python
import math
import jax, jax.numpy as jnp
from jax import lax
import numpy as np

D_MODEL = 1024
BATCH = 2
SEQ = 8192
DEPTH = 2

EXPAND = 2
D_INNER = EXPAND * D_MODEL
S5_WIDTH = D_INNER // 2
S5_GROUP = 16
S5_GROUPS = S5_WIDTH // S5_GROUP
S5_STATE = 64
RET_WIDTH = D_INNER - S5_WIDTH
RET_HEADS = 4
RET_DK = RET_WIDTH // RET_HEADS
RET_DV = RET_WIDTH // RET_HEADS
RET_CHUNK = 128
ROPE_BASE = 10000.0
EVEN_SPLITS = [S5_WIDTH, S5_WIDTH, RET_HEADS * RET_DK, RET_HEADS * RET_DK, RET_HEADS * RET_DV, RET_HEADS * RET_DV]
EVEN_IN = sum(EVEN_SPLITS)
SGU_WIDTH = D_INNER
SGU_GROUPS = 4
SGU_GROUP_DIM = SGU_WIDTH // SGU_GROUPS
SGU_CHUNK = 128
ODD_IN = 3 * SGU_WIDTH
N_EVEN = (DEPTH + 1) // 2
N_ODD = DEPTH // 2
NORM_EPS = 1e-6

kernel_name = "hybrid_s5_retention_sgu_block"

F32 = jnp.float32


def rms_norm(x, g):
    xf = x.astype(F32)
    y = xf * lax.rsqrt(jnp.mean(xf * xf, axis=-1, keepdims=True) + NORM_EPS)
    return (y * g.astype(F32)).astype(x.dtype)


def rotary(x, pos):
    half = x.shape[-1] // 2
    inv = ROPE_BASE ** (-jnp.arange(half, dtype=F32) / half)
    ang = pos[:, None] * inv[None, :]
    cos = jnp.cos(ang)[None, :, None, :]
    sin = jnp.sin(ang)[None, :, None, :]
    x1, x2 = x[..., :half], x[..., half:]
    return jnp.concatenate([x1 * cos - x2 * sin, x1 * sin + x2 * cos], axis=-1)


def s5_branch(u, lam_re, lam_im, log_dt, b_re, b_im, c_re, c_im, d_skip, w_glu, b_glu):
    bsz, seq, _ = u.shape
    uf = u.astype(F32).reshape(bsz, seq, S5_GROUPS, S5_GROUP)
    lr = jnp.minimum(lam_re.astype(F32), -1e-4)
    li = lam_im.astype(F32)
    dt = jnp.exp(log_dt.astype(F32))[:, None]
    mag = jnp.exp(lr * dt)
    ab_re = mag * jnp.cos(li * dt)
    ab_im = mag * jnp.sin(li * dt)
    den = lr * lr + li * li
    n_re = ab_re - 1.0
    n_im = ab_im
    z_re = (n_re * lr + n_im * li) / den
    z_im = (n_im * lr - n_re * li) / den
    br = b_re.astype(F32)
    bi = b_im.astype(F32)
    bb_re = z_re[..., None] * br - z_im[..., None] * bi
    bb_im = z_re[..., None] * bi + z_im[..., None] * br
    bu_re = jnp.einsum('gph,blgh->blgp', bb_re, uf)
    bu_im = jnp.einsum('gph,blgh->blgp', bb_im, uf)
    a_re = jnp.broadcast_to(ab_re, bu_re.shape)
    a_im = jnp.broadcast_to(ab_im, bu_im.shape)

    def combine(left, right):
        a1r, a1i, b1r, b1i = left
        a2r, a2i, b2r, b2i = right
        return (a2r * a1r - a2i * a1i,
                a2r * a1i + a2i * a1r,
                a2r * b1r - a2i * b1i + b2r,
                a2r * b1i + a2i * b1r + b2i)

    _, _, s_re, s_im = lax.associative_scan(combine, (a_re, a_im, bu_re, bu_im), axis=1)
    y = (jnp.einsum('ghp,blgp->blgh', c_re.astype(F32), s_re)
         - jnp.einsum('ghp,blgp->blgh', c_im.astype(F32), s_im))
    y = y + d_skip.astype(F32).reshape(S5_GROUPS, S5_GROUP) * uf
    y = jax.nn.gelu(y.reshape(bsz, seq, S5_WIDTH))
    y = y * jax.nn.sigmoid(y @ w_glu.astype(F32) + b_glu.astype(F32))
    return y.astype(u.dtype)


def retention_branch(q, k, v, gn_gain):
    bsz, seq, _ = q.shape
    nc = seq // RET_CHUNK
    pos = jnp.arange(seq, dtype=F32)
    qh = rotary(q.astype(F32).reshape(bsz, seq, RET_HEADS, RET_DK), pos)
    kh = rotary(k.astype(F32).reshape(bsz, seq, RET_HEADS, RET_DK), pos) * (RET_DK ** -0.5)
    vh = v.astype(F32).reshape(bsz, seq, RET_HEADS, RET_DV)
    log_g = jnp.log1p(-jnp.exp2(-5.0 - jnp.arange(RET_HEADS, dtype=F32)))
    idx = jnp.arange(RET_CHUNK, dtype=F32)
    diff = idx[:, None] - idx[None, :]
    decay = jnp.where(diff >= 0, jnp.exp(log_g[:, None, None] * jnp.maximum(diff, 0.0)), 0.0)
    xi = jnp.exp(log_g[None, :] * (idx[:, None] + 1.0))
    zeta = jnp.exp(log_g[None, :] * (RET_CHUNK - 1.0 - idx[:, None]))
    chunk_decay = jnp.exp(log_g * RET_CHUNK)
    qc = qh.reshape(bsz, nc, RET_CHUNK, RET_HEADS, RET_DK)
    kc = kh.reshape(bsz, nc, RET_CHUNK, RET_HEADS, RET_DK)
    vc = vh.reshape(bsz, nc, RET_CHUNK, RET_HEADS, RET_DV)
    scores = jnp.einsum('bcnhk,bcmhk->bchnm', qc, kc) * decay[None, None]
    inner = jnp.einsum('bchnm,bcmhv->bcnhv', scores, vc)
    local = jnp.einsum('bcmhk,bcmhv->bchkv', kc * zeta[None, None, :, :, None], vc)

    def step(state, s_chunk):
        return state * chunk_decay[None, :, None, None] + s_chunk, state

    init = jnp.zeros((bsz, RET_HEADS, RET_DK, RET_DV), F32)
    _, prev = lax.scan(step, init, jnp.moveaxis(local, 1, 0))
    prev = jnp.moveaxis(prev, 0, 1)
    cross = jnp.einsum('bcnhk,bchkv->bcnhv', qc * xi[None, None, :, :, None], prev)
    o = (inner + cross).reshape(bsz, seq, RET_HEADS, RET_DV)
    mu = jnp.mean(o, axis=-1, keepdims=True)
    var = jnp.mean(jnp.square(o - mu), axis=-1, keepdims=True)
    o = (o - mu) * lax.rsqrt(var + NORM_EPS)
    o = o.reshape(bsz, seq, RET_HEADS * RET_DV) * gn_gain.astype(F32)
    return o.astype(q.dtype)


def spatial_gating_branch(h, v_gain, w_s, b_s):
    bsz, seq, _ = h.shape
    nc = seq // SGU_CHUNK
    u, v = h[..., :SGU_WIDTH], h[..., SGU_WIDTH:]
    vf = v.astype(F32)
    mu = jnp.mean(vf, axis=-1, keepdims=True)
    var = jnp.mean(jnp.square(vf - mu), axis=-1, keepdims=True)
    vf = (vf - mu) * lax.rsqrt(var + NORM_EPS) * v_gain.astype(F32)
    vc = vf.reshape(bsz, nc, SGU_CHUNK, SGU_GROUPS, SGU_GROUP_DIM)
    mask = jnp.tril(jnp.ones((SGU_CHUNK, SGU_CHUNK), dtype=bool))
    w = jnp.where(mask[None], w_s.astype(F32), 0.0)
    s = jnp.einsum('gts,bcsgd->bctgd', w, vc) + b_s.astype(F32).T[None, None, :, :, None]
    return (u.astype(F32) * s.reshape(bsz, seq, SGU_WIDTH)).astype(h.dtype)


def setup_inputs(seed: int = 0) -> dict:
    key = jax.random.key(seed)
    ks = jax.random.split(key, 24)
    nrm = lambda k, shape, scale: jax.random.normal(k, shape, F32) * scale
    x = jax.random.normal(ks[0], (BATCH, SEQ, D_MODEL), F32)
    norm_even = 1.0 + nrm(ks[1], (N_EVEN, D_MODEL), 0.02)
    w_in_even = nrm(ks[2], (N_EVEN, D_MODEL, EVEN_IN), D_MODEL ** -0.5)
    s5_lam_re = -0.5 + nrm(ks[3], (N_EVEN, S5_GROUPS, S5_STATE), 0.01)
    s5_lam_im = math.pi * jnp.arange(S5_STATE, dtype=F32)[None, None, :] + nrm(ks[4], (N_EVEN, S5_GROUPS, S5_STATE), 0.01)
    s5_log_dt = jax.random.uniform(ks[5], (N_EVEN, S5_GROUPS), F32, math.log(0.001), math.log(0.1))
    s5_b_re = nrm(ks[6], (N_EVEN, S5_GROUPS, S5_STATE, S5_GROUP), (2 * S5_GROUP) ** -0.5)
    s5_b_im = nrm(ks[7], (N_EVEN, S5_GROUPS, S5_STATE, S5_GROUP), (2 * S5_GROUP) ** -0.5)
    s5_c_re = nrm(ks[8], (N_EVEN, S5_GROUPS, S5_GROUP, S5_STATE), (2 * S5_STATE) ** -0.5)
    s5_c_im = nrm(ks[9], (N_EVEN, S5_GROUPS, S5_GROUP, S5_STATE), (2 * S5_STATE) ** -0.5)
    s5_d = nrm(ks[10], (N_EVEN, S5_WIDTH), 1.0)
    s5_w_glu = nrm(ks[11], (N_EVEN, S5_WIDTH, S5_WIDTH), S5_WIDTH ** -0.5)
    s5_b_glu = nrm(ks[12], (N_EVEN, S5_WIDTH), 0.01)
    ret_gn_gain = 1.0 + nrm(ks[13], (N_EVEN, RET_HEADS * RET_DV), 0.02)
    w_out_even = nrm(ks[14], (N_EVEN, D_INNER, D_MODEL), D_INNER ** -0.5)
    norm_odd = 1.0 + nrm(ks[15], (N_ODD, D_MODEL), 0.02)
    w_in_odd = nrm(ks[16], (N_ODD, D_MODEL, ODD_IN), D_MODEL ** -0.5)
    sgu_norm_gain = 1.0 + nrm(ks[17], (N_ODD, SGU_WIDTH), 0.02)
    sgu_w_spatial = nrm(ks[18], (N_ODD, SGU_GROUPS, SGU_CHUNK, SGU_CHUNK), SGU_CHUNK ** -0.5)
    sgu_b_spatial = 1.0 + nrm(ks[19], (N_ODD, SGU_GROUPS, SGU_CHUNK), 0.02)
    w_out_odd = nrm(ks[20], (N_ODD, SGU_WIDTH, D_MODEL), SGU_WIDTH ** -0.5)
    final_norm = 1.0 + nrm(ks[21], (D_MODEL,), 0.02)
    return {"x": x, "norm_even": norm_even, "w_in_even": w_in_even,
            "s5_lam_re": s5_lam_re, "s5_lam_im": s5_lam_im, "s5_log_dt": s5_log_dt,
            "s5_b_re": s5_b_re, "s5_b_im": s5_b_im, "s5_c_re": s5_c_re, "s5_c_im": s5_c_im,
            "s5_d": s5_d, "s5_w_glu": s5_w_glu, "s5_b_glu": s5_b_glu,
            "ret_gn_gain": ret_gn_gain, "w_out_even": w_out_even,
            "norm_odd": norm_odd, "w_in_odd": w_in_odd, "sgu_norm_gain": sgu_norm_gain,
            "sgu_w_spatial": sgu_w_spatial, "sgu_b_spatial": sgu_b_spatial,
            "w_out_odd": w_out_odd, "final_norm": final_norm}


def reference(x, norm_even, w_in_even, s5_lam_re, s5_lam_im, s5_log_dt, s5_b_re, s5_b_im,
              s5_c_re, s5_c_im, s5_d, s5_w_glu, s5_b_glu, ret_gn_gain, w_out_even,
              norm_odd, w_in_odd, sgu_norm_gain, sgu_w_spatial, sgu_b_spatial, w_out_odd,
              final_norm):
    split_pts = [int(p) for p in np.cumsum(EVEN_SPLITS)[:-1]]
    for layer in range(DEPTH):
        i = layer // 2
        if layer % 2 == 0:
            h = rms_norm(x, norm_even[i])
            p = h @ w_in_even[i]
            a_u, a_z, q, k, v, b_z = jnp.split(p, split_pts, axis=-1)
            ya = s5_branch(a_u, s5_lam_re[i], s5_lam_im[i], s5_log_dt[i], s5_b_re[i], s5_b_im[i],
                           s5_c_re[i], s5_c_im[i], s5_d[i], s5_w_glu[i], s5_b_glu[i]) * jax.nn.silu(a_z)
            yb = retention_branch(q, k, v, ret_gn_gain[i]) * jax.nn.silu(b_z)
            x = x + jnp.concatenate([ya, yb], axis=-1) @ w_out_even[i]
        else:
            h = rms_norm(x, norm_odd[i])
            p = h @ w_in_odd[i]
            hz = jax.nn.gelu(p[..., :2 * SGU_WIDTH])
            z = p[..., 2 * SGU_WIDTH:]
            y = spatial_gating_branch(hz, sgu_norm_gain[i], sgu_w_spatial[i], sgu_b_spatial[i]) * jax.nn.silu(z)
            x = x + y @ w_out_odd[i]
    return rms_norm(x, final_norm)
```

```cpp
#include <hip/hip_runtime.h>
#include <hip/hip_cooperative_groups.h>
#include <cstdio>
#include <cstdint>
namespace cg = cooperative_groups;
namespace pg8 {
#define PG8_LAS __attribute__((address_space(3)))
typedef unsigned short bf16_t;
typedef short bf16x8 __attribute__((ext_vector_type(8)));
typedef float f32x4 __attribute__((ext_vector_type(4)));
typedef unsigned u32x4 __attribute__((ext_vector_type(4)));
constexpr int BM = 256, BK = 64, HALF = 128, HTB = HALF * BK * 2  , STAGE_BYTES = 8 * HTB, NXCD = 8, WGM = 8;

__host__ __device__ __forceinline__ int lds_byte(int r, int c) { const int st = (r >> 4) * 2 + (c >> 5), rr = r & 15, cc = c & 31, ob = rr * 64 + cc * 2; return st * 1024 + (ob ^ (((ob >> 9) & 1) << 5)); }
__host__ __device__ __forceinline__ void stage_rc(int b, int& R, int& C) { const int st = b / 1024, sb = b % 1024, swz = sb ^ (((sb >> 9) & 1) << 5); R = (st >> 1) * 16 + swz / 64; C = (st & 1) * 32 + (swz % 64) / 2; }
__host__ __device__ __forceinline__ int perm32(int rho) { const int n = rho >> 4, i = rho & 15; return 8 * (i >> 2) + 4 * n + (i & 3); }

struct Unit { int pm, pn; };
struct Gemm { const bf16_t* A; const bf16_t* Bt; int M, N, K; };

struct StaticOrder {
    int nM, nN, nwg, G, c;
    __host__ __device__ void init(int M, int N, int G_, int c_) { nM = M / BM; nN = N / BM; nwg = nM * nN; G = G_; c = c_; }
    __host__ __device__ bool next(int i, Unit& u) const {
        const long L = (long)i * G + c; if (L >= nwg) return false;
        int wgid = (int)L; { const int q = nwg / NXCD, r = nwg % NXCD, xcd = wgid % NXCD, off = wgid / NXCD; wgid = (xcd < r ? xcd * (q + 1) : r * (q + 1) + (xcd - r) * q) + off; }
        const int nig = WGM * nN, gid = wgid / nig, fm = gid * WGM, gsz = (nM - fm) < WGM ? (nM - fm) : WGM;
        u.pm = fm + ((wgid % nig) % gsz); u.pn = (wgid % nig) / gsz; return true;
    }
    __device__ __forceinline__ void a_ready(const Unit&) const {}
    __device__ __forceinline__ void done(const Unit&) const {}
};

__device__ __forceinline__ unsigned cvt_pk_bf16(float lo, float hi) { unsigned r; asm volatile("v_cvt_pk_bf16_f32 %0, %1, %2" : "=v"(r) : "v"(lo), "v"(hi)); return r; }
template <class Epi, class Sched, bool ALIGN_EPI = false, bool SP2 = false>
__device__ __forceinline__ void gemm_phase(PG8_LAS unsigned char* lds, const Gemm g, const Sched& S, const Epi& E) {
    const int tid = threadIdx.x, wid = __builtin_amdgcn_readfirstlane(tid >> 6), lane = tid & 63, wr = wid >> 2, wc = wid & 3, fr = lane & 15, fq = lane >> 4;
    const int K = g.K, nt = K / BK;
    unsigned voffA[2], voffB[2];
#pragma unroll
    for (int i = 0; i < 2; ++i) { int R, C; stage_rc(tid * 16 + i * 8192, R, C); const int Rb = Epi::PERM ? ((R & ~31) + perm32(R & 31)) : R;
        voffA[i] = (unsigned)(R * K + C) * 2u; voffB[i] = (unsigned)(Rb * K + C) * 2u; }
    const size_t kstep = (size_t)(BK * 2);
    const size_t hstep = (size_t)HALF * K * 2;
    const size_t tstep = 2 * hstep;
    const unsigned ldsw = (unsigned)wid * 1024u;
    const int aoff = lds_byte(wr * 64 + fr, fq * 8), boff = lds_byte(wc * 32 + fr, fq * 8);
#define PG8_SA(b, h) (((b) * 2 + (h)) * HTB)
#define PG8_SB(b, h) ((4 + (b) * 2 + (h)) * HTB)
#define PG8_STAGE(bufoff, gbase, voff) do { _Pragma("unroll") for (int _i = 0; _i < 2; ++_i) \
        __builtin_amdgcn_global_load_lds((const unsigned*)((const char*)(gbase) + (voff)[_i]), (PG8_LAS unsigned*)(lds + (bufoff) + ldsw + _i * 8192), 16, 0, 0); } while (0)
#define PG8_LDA(dst, b, h) do { _Pragma("unroll") for (int m = 0; m < 4; ++m) _Pragma("unroll") for (int k = 0; k < 2; ++k) dst[m][k] = *(const PG8_LAS bf16x8*)(lds + PG8_SA(b, h) + aoff + m * 2048 + k * 1024); } while (0)
#define PG8_LDB(dst, b, h) do { _Pragma("unroll") for (int n = 0; n < 2; ++n) _Pragma("unroll") for (int k = 0; k < 2; ++k) dst[n][k] = *(const PG8_LAS bf16x8*)(lds + PG8_SB(b, h) + boff + n * 2048 + k * 1024); } while (0)
#define PG8_MMA(ai, bj, At, Bt) do { __builtin_amdgcn_s_setprio(1); _Pragma("unroll") for (int m = 0; m < 4; ++m) _Pragma("unroll") for (int n = 0; n < 2; ++n) _Pragma("unroll") for (int k = 0; k < 2; ++k) \
        acc[ai][bj][m][n] = __builtin_amdgcn_mfma_f32_16x16x32_bf16(Bt[n][k], At[m][k], acc[ai][bj][m][n], 0, 0, 0); __builtin_amdgcn_s_setprio(0); } while (0)
#define PG8_WAIT_V(n) asm volatile("s_waitcnt vmcnt(" #n ")" ::: "memory")
#define PG8_WAIT_L(n) asm volatile("s_waitcnt lgkmcnt(" #n ")" ::: "memory")
#define PG8_BAR __builtin_amdgcn_s_barrier()
#define PG8_SCHED __builtin_amdgcn_sched_barrier(0)
    Unit cur, nxt; int ui = 0;
    if (!S.next(0, cur)) return;
    f32x4 acc[2][2][4][2];
#pragma unroll
    for (int a = 0; a < 2; ++a)
#pragma unroll
        for (int b = 0; b < 2; ++b)
#pragma unroll
            for (int m = 0; m < 4; ++m)
#pragma unroll
                for (int n = 0; n < 2; ++n) acc[a][b][m][n] = (f32x4){0.f, 0.f, 0.f, 0.f};
    bf16x8 At[4][2], B0[2][2], B1[2][2];
    const char* cA = (const char*)g.A + (size_t)cur.pm * tstep; const char* cB = (const char*)g.Bt + (size_t)cur.pn * tstep;
    S.a_ready(cur);
    if constexpr (SP2) {
        PG8_STAGE(PG8_SB(0, 0), cB, voffB); PG8_STAGE(PG8_SB(0, 1), cB + hstep, voffB); PG8_STAGE(PG8_SA(0, 0), cA, voffA); PG8_STAGE(PG8_SA(0, 1), cA + hstep, voffA);
        if (wr == 1) PG8_BAR;
        PG8_WAIT_V(2); PG8_BAR;
        PG8_STAGE(PG8_SB(1, 0), cB + kstep, voffB); PG8_STAGE(PG8_SA(1, 0), cA + kstep, voffA); PG8_STAGE(PG8_SB(1, 1), cB + hstep + kstep, voffB);
        PG8_WAIT_V(6); PG8_BAR;
    } else {
        PG8_STAGE(PG8_SB(0, 0), cB, voffB); PG8_STAGE(PG8_SA(0, 0), cA, voffA); PG8_STAGE(PG8_SB(0, 1), cB + hstep, voffB); PG8_STAGE(PG8_SA(0, 1), cA + hstep, voffA);
        if (wr == 1) PG8_BAR;
        PG8_WAIT_V(4); PG8_BAR;
        PG8_STAGE(PG8_SB(1, 0), cB + kstep, voffB); PG8_STAGE(PG8_SA(1, 0), cA + kstep, voffA); PG8_STAGE(PG8_SB(1, 1), cB + hstep + kstep, voffB);
        PG8_WAIT_V(6); PG8_BAR;
    }
    for (;;) {
        const bool has_next = S.next(ui + 1, nxt);
        const char* nA = has_next ? (const char*)g.A + (size_t)nxt.pm * tstep : cA; const char* nB = has_next ? (const char*)g.Bt + (size_t)nxt.pn * tstep : cB;
        for (int t = 0; t < nt; t += 2) {
            const bool last = (t == nt - 2);
            const char* a1 = cA + (size_t)(t + 1) * kstep;
            const char* a2 = last ? nA : cA + (size_t)(t + 2) * kstep; const char* b2 = last ? nB : cB + (size_t)(t + 2) * kstep;
            const char* a3 = a2 + kstep; const char* b3 = b2 + kstep;
            if (last && has_next) S.a_ready(nxt);
            if constexpr (SP2) {
            PG8_LDB(B0, 0, 0); PG8_LDB(B1, 0, 1); PG8_SCHED; PG8_LDA(At, 0, 0); PG8_STAGE(PG8_SA(1, 1), a1 + hstep, voffA);
            PG8_WAIT_V(8); PG8_WAIT_L(0); PG8_BAR; PG8_MMA(0, 0, At, B0); PG8_MMA(0, 1, At, B1); PG8_BAR; PG8_SCHED;
            PG8_LDA(At, 0, 1); PG8_STAGE(PG8_SB(0, 0), b2, voffB); PG8_STAGE(PG8_SB(0, 1), b2 + hstep, voffB); PG8_STAGE(PG8_SA(0, 0), a2, voffA);
            PG8_WAIT_V(8); PG8_WAIT_L(0); PG8_BAR; PG8_MMA(1, 0, At, B0); PG8_MMA(1, 1, At, B1); PG8_BAR; PG8_SCHED;
            PG8_LDB(B0, 1, 0); PG8_LDB(B1, 1, 1); PG8_SCHED; PG8_LDA(At, 1, 0); PG8_STAGE(PG8_SA(0, 1), a2 + hstep, voffA);
            PG8_WAIT_V(8); PG8_WAIT_L(0); PG8_BAR; PG8_MMA(0, 0, At, B0); PG8_MMA(0, 1, At, B1); PG8_BAR; PG8_SCHED;
            PG8_LDA(At, 1, 1); PG8_STAGE(PG8_SB(1, 0), b3, voffB); PG8_STAGE(PG8_SB(1, 1), b3 + hstep, voffB); PG8_STAGE(PG8_SA(1, 0), a3, voffA);
            PG8_WAIT_V(8); PG8_WAIT_L(0); PG8_BAR; PG8_MMA(1, 0, At, B0); PG8_MMA(1, 1, At, B1); PG8_BAR; PG8_SCHED;
            } else {
            PG8_LDB(B0, 0, 0); PG8_SCHED; PG8_LDA(At, 0, 0); PG8_STAGE(PG8_SA(1, 1), a1 + hstep, voffA);
            PG8_WAIT_L(8); PG8_BAR; PG8_WAIT_L(0); PG8_MMA(0, 0, At, B0); PG8_BAR; PG8_SCHED;
            PG8_LDB(B1, 0, 1); PG8_STAGE(PG8_SB(0, 0), b2, voffB);
            PG8_BAR; PG8_WAIT_L(0); PG8_MMA(0, 1, At, B1); PG8_BAR;
            PG8_LDA(At, 0, 1); PG8_STAGE(PG8_SA(0, 0), a2, voffA);
            PG8_BAR; PG8_WAIT_L(0); PG8_MMA(1, 0, At, B0); PG8_BAR; PG8_SCHED;
            PG8_STAGE(PG8_SB(0, 1), b2 + hstep, voffB);
            PG8_WAIT_V(6); PG8_BAR; PG8_MMA(1, 1, At, B1); PG8_BAR;
            PG8_LDB(B0, 1, 0); PG8_SCHED; PG8_LDA(At, 1, 0); PG8_STAGE(PG8_SA(0, 1), a2 + hstep, voffA);
            PG8_WAIT_L(8); PG8_BAR; PG8_WAIT_L(0); PG8_MMA(0, 0, At, B0); PG8_BAR; PG8_SCHED;
            PG8_LDB(B1, 1, 1); PG8_STAGE(PG8_SB(1, 0), b3, voffB);
            PG8_BAR; PG8_WAIT_L(0); PG8_MMA(0, 1, At, B1); PG8_BAR;
            PG8_LDA(At, 1, 1); PG8_STAGE(PG8_SA(1, 0), a3, voffA);
            PG8_BAR; PG8_WAIT_L(0); PG8_MMA(1, 0, At, B0); PG8_BAR; PG8_SCHED;
            PG8_STAGE(PG8_SB(1, 1), b3 + hstep, voffB);
            PG8_WAIT_V(6); PG8_BAR; PG8_MMA(1, 1, At, B1); PG8_BAR;
            }
        }
        if constexpr (ALIGN_EPI) { if (wr == 0) PG8_BAR; }
        if constexpr (!Epi::AFTER_DRAIN) { E(acc, cur, wr, wc, fr, fq); S.done(cur); }
        if (!has_next) break;
#pragma unroll
        for (int a = 0; a < 2; ++a)
#pragma unroll
            for (int b = 0; b < 2; ++b)
#pragma unroll
                for (int m = 0; m < 4; ++m)
#pragma unroll
                    for (int n = 0; n < 2; ++n) acc[a][b][m][n] = (f32x4){0.f, 0.f, 0.f, 0.f};
        cur = nxt; cA = nA; cB = nB; ++ui;
        if constexpr (ALIGN_EPI) { if (wr == 1) PG8_BAR; }
    }
    PG8_WAIT_V(0);
    if constexpr (!ALIGN_EPI) { if (wr == 0) PG8_BAR; }
    PG8_BAR;
    if constexpr (Epi::AFTER_DRAIN) { E.fused(acc, cur, wr, wc, fr, fq, lds, wid, lane); S.done(cur); }
#undef PG8_SA
#undef PG8_SB
#undef PG8_STAGE
#undef PG8_LDA
#undef PG8_LDB
#undef PG8_MMA
#undef PG8_WAIT_V
#undef PG8_WAIT_L
#undef PG8_BAR
#undef PG8_SCHED
}
}

#ifndef MK_PER_PHASE
#define MK_PER_PHASE 0
#endif
using pg8::bf16_t; using pg8::bf16x8; using pg8::f32x4; using pg8::u32x4;
typedef float f32x16 __attribute__((ext_vector_type(16)));
typedef unsigned u32x2 __attribute__((ext_vector_type(2)));
#define LAS __attribute__((address_space(3)))
constexpr int M = 16384, D = 1024, SEQ = 8192, NTHR = 512, NPH = 12;
constexpr float EPS = 1e-6f;
constexpr size_t MiB = 1u << 20;
constexpr size_t WS_RSS0 = 0, WS_RSS1 = 65536, WS_VSUM = 131072, WS_VSQ = 196608, WS_RSS2 = 262144;
constexpr size_t WS_APOW = 1 * MiB, WS_A128 = 1 * MiB + 131072, WS_BBT = 1 * MiB + 262144, WS_CCT = 1 * MiB + 524288;
constexpr size_t WS_COS = 2 * MiB, WS_SIN = 6 * MiB, WS_CHS = 10 * MiB;
constexpr size_t WS_WINE = 16 * MiB, WS_WGLU = 28 * MiB, WS_WOUTE = 30 * MiB, WS_WINO = 34 * MiB, WS_WOUTO = 46 * MiB;
constexpr size_t WS_U = 52 * MiB, WS_CAT = 84 * MiB, WS_K = 148 * MiB, WS_V = 180 * MiB, WS_SZB = 212 * MiB, WS_END = 244 * MiB;
constexpr size_t WS_X1 = WS_K;
constexpr int LDS_BYTES = 143360;

struct Args { const float* in[22]; float* out; unsigned char* ws; int ph_lo, ph_hi; };

__device__ __forceinline__ unsigned f2bf(float f) { unsigned u = __builtin_bit_cast(unsigned, f); return (u + 0x7fffu + ((u >> 16) & 1u)) >> 16; }
__device__ __forceinline__ unsigned pk2(float lo, float hi) { return pg8::cvt_pk_bf16(lo, hi); }
__device__ __forceinline__ float bflo(unsigned w) { return __builtin_bit_cast(float, w << 16); }
__device__ __forceinline__ float bfhi(unsigned w) { return __builtin_bit_cast(float, w & 0xffff0000u); }
__device__ __forceinline__ float bf2f(bf16_t b) { return __builtin_bit_cast(float, (unsigned)b << 16); }
__device__ __forceinline__ float fast_rcp(float x) { return __builtin_amdgcn_rcpf(x); }
__device__ __forceinline__ float sigmoidf_(float t) { return fast_rcp(1.f + __builtin_amdgcn_exp2f(-1.4426950408889634f * t)); }
__device__ __forceinline__ float siluf_(float t) { return t * sigmoidf_(t); }
__device__ __forceinline__ float geluf_(float x) { const float u = 0.7978845608028654f * (x + 0.044715f * x * x * x); return x * sigmoidf_(2.f * u); }
__device__ __forceinline__ float wave_sum(float v) {
#pragma unroll
    for (int o = 1; o < 64; o <<= 1) v += __shfl_xor(v, o);
    return v;
}
__device__ __forceinline__ float lg_gamma(int h) { return h == 0 ? -0.04580368961312479f : (h == 1 ? -0.02272007650008353f : (h == 2 ? -0.011315313227834146f : -0.005646563141142063f)); }
__device__ __forceinline__ void sincos_d(double x, double& s, double& c) {
    double t = x * 0.15915494309189535; t -= __builtin_rint(t);
    const double qd = __builtin_rint(4.0 * t); const int q = (int)qd;
    const double r = (t - 0.25 * qd) * 6.283185307179586; const double r2 = r * r;
    double sp = -1.0 / 1307674368000.0; sp = sp * r2 + 1.0 / 6227020800.0; sp = sp * r2 - 1.0 / 39916800.0; sp = sp * r2 + 1.0 / 362880.0; sp = sp * r2 - 1.0 / 5040.0; sp = sp * r2 + 1.0 / 120.0; sp = sp * r2 - 1.0 / 6.0; sp = sp * r2 + 1.0;
    const double sr = sp * r;
    double cp = 1.0 / 20922789888000.0; cp = cp * r2 - 1.0 / 87178291200.0; cp = cp * r2 + 1.0 / 479001600.0; cp = cp * r2 - 1.0 / 3628800.0; cp = cp * r2 + 1.0 / 40320.0; cp = cp * r2 - 1.0 / 720.0; cp = cp * r2 + 1.0 / 24.0; cp = cp * r2 - 0.5; cp = cp * r2 + 1.0;
    const int qq = q & 3;
    if (qq == 0) { s = sr; c = cp; } else if (qq == 1) { s = cp; c = -sr; } else if (qq == 2) { s = -sr; c = -cp; } else { s = -cp; c = sr; }
}

#define EPI_ARGS const f32x4 (&acc)[2][2][4][2], const pg8::Unit& u, int wr, int wc, int fr, int fq
__device__ __forceinline__ void st8bf(bf16_t* p, const float (&v)[8]) { u32x4 w; w.x = pk2(v[0], v[1]); w.y = pk2(v[2], v[3]); w.z = pk2(v[4], v[5]); w.w = pk2(v[6], v[7]); *(u32x4*)p = w; }
__device__ __forceinline__ void ld8bf(const bf16_t* p, float (&v)[8]) { const u32x4 w = *(const u32x4*)p; v[0] = bflo(w.x); v[1] = bfhi(w.x); v[2] = bflo(w.y); v[3] = bfhi(w.y); v[4] = bflo(w.z); v[5] = bfhi(w.z); v[6] = bflo(w.w); v[7] = bfhi(w.w); }
__device__ __forceinline__ void ld8f(const float* p, float (&v)[8]) { const f32x4 a = *(const f32x4*)p, b = *(const f32x4*)(p + 4); v[0] = a.x; v[1] = a.y; v[2] = a.z; v[3] = a.w; v[4] = b.x; v[5] = b.y; v[6] = b.z; v[7] = b.w; }
__device__ __forceinline__ void st8f(float* p, const float (&v)[8]) { *(f32x4*)p = (f32x4){v[0], v[1], v[2], v[3]}; *(f32x4*)(p + 4) = (f32x4){v[4], v[5], v[6], v[7]}; }
#define ACC8(dst, ai, bj, m, sc) do { const f32x4 _a = acc[ai][bj][m][0], _b = acc[ai][bj][m][1]; dst[0] = _a.x * (sc); dst[1] = _a.y * (sc); dst[2] = _a.z * (sc); dst[3] = _a.w * (sc); dst[4] = _b.x * (sc); dst[5] = _b.y * (sc); dst[6] = _b.z * (sc); dst[7] = _b.w * (sc); } while (0)

struct Epi1 {
    static constexpr bool PERM = true, AFTER_DRAIN = false;
    const float* rss; bf16_t* U; bf16_t* CAT; bf16_t* Kb; bf16_t* Vb; bf16_t* SZB; const float* COS; const float* SIN;
    __device__ __forceinline__ void operator()(EPI_ARGS) const {
        const int seg = u.pn >> 2, cb = (u.pn & 3) * 256, colL = wc * 32 + 8 * fq;
        const int row0 = u.pm * 256 + wr * 64 + fr;
#pragma unroll
        for (int ai = 0; ai < 2; ++ai)
#pragma unroll
            for (int m = 0; m < 4; ++m) {
                const int row = row0 + ai * 128 + m * 16;
                const float rs = __builtin_amdgcn_rsqf(rss[row] * (1.f / 1024.f) + EPS);
                if (seg == 2 || seg == 3) {
                    float x1[8], x2[8], cs[8], sn[8], o1[8], o2[8];
                    const float sc = (seg == 3) ? rs * 0.0625f : rs;
                    ACC8(x1, ai, 0, m, sc); ACC8(x2, ai, 1, m, sc);
                    const int pos = row & (SEQ - 1);
                    ld8f(COS + (size_t)pos * 128 + colL, cs); ld8f(SIN + (size_t)pos * 128 + colL, sn);
#pragma unroll
                    for (int j = 0; j < 8; ++j) { o1[j] = x1[j] * cs[j] - x2[j] * sn[j]; o2[j] = x1[j] * sn[j] + x2[j] * cs[j]; }
                    bf16_t* dst = (seg == 2) ? CAT + (size_t)row * 2048 + 1024 + cb + colL : Kb + (size_t)row * 1024 + cb + colL;
                    st8bf(dst, o1); st8bf(dst + 128, o2);
                } else {
#pragma unroll
                    for (int bj = 0; bj < 2; ++bj) {
                        float v[8]; ACC8(v, ai, bj, m, rs);
                        const int col = cb + bj * 128 + colL;
                        if (seg == 1 || seg == 5) {
#pragma unroll
                            for (int j = 0; j < 8; ++j) v[j] = siluf_(v[j]);
                        }
                        bf16_t* dst = (seg == 0) ? U + (size_t)row * 1024 + col : (seg == 1) ? CAT + (size_t)row * 2048 + col : (seg == 4) ? Vb + (size_t)row * 1024 + col : SZB + (size_t)row * 1024 + col;
                        st8bf(dst, v);
                    }
                }
            }
    }
};
struct EpiGlu {
    static constexpr bool PERM = true, AFTER_DRAIN = false;
    const float* bglu; const bf16_t* Y1; bf16_t* CAT;
    __device__ __forceinline__ void operator()(EPI_ARGS) const {
        const int colL = wc * 32 + 8 * fq, row0 = u.pm * 256 + wr * 64 + fr;
#pragma unroll
        for (int bj = 0; bj < 2; ++bj) {
            const int col = u.pn * 256 + bj * 128 + colL;
            float bb[8]; ld8f(bglu + col, bb);
#pragma unroll
            for (int ai = 0; ai < 2; ++ai)
#pragma unroll
                for (int m = 0; m < 4; ++m) {
                    const int row = row0 + ai * 128 + m * 16;
                    float t[8], y[8], z[8]; ACC8(t, ai, bj, m, 1.f);
                    ld8bf(Y1 + (size_t)row * 1024 + col, y); ld8bf(CAT + (size_t)row * 2048 + col, z);
#pragma unroll
                    for (int j = 0; j < 8; ++j) t[j] = y[j] * sigmoidf_(t[j] + bb[j]) * z[j];
                    st8bf(CAT + (size_t)row * 2048 + col, t);
                }
        }
    }
};
struct EpiOut {
    static constexpr bool PERM = true, AFTER_DRAIN = false;
    const float* Xi; float* Xo; bf16_t* XG; const float* g; float* rss;
    __device__ __forceinline__ void operator()(EPI_ARGS) const {
        const int colL = wc * 32 + 8 * fq, row0 = u.pm * 256 + wr * 64 + fr;
#pragma unroll
        for (int ai = 0; ai < 2; ++ai)
#pragma unroll
            for (int m = 0; m < 4; ++m) {
                const int row = row0 + ai * 128 + m * 16; float ss = 0.f;
#pragma unroll
                for (int bj = 0; bj < 2; ++bj) {
                    const int col = u.pn * 256 + bj * 128 + colL;
                    float a[8], x[8]; ACC8(a, ai, bj, m, 1.f); ld8f(Xi + (size_t)row * 1024 + col, x);
#pragma unroll
                    for (int j = 0; j < 8; ++j) { x[j] += a[j]; ss += x[j] * x[j]; }
                    st8f(Xo + (size_t)row * 1024 + col, x);
                    if (XG) { float gg[8]; ld8f(g + col, gg);
#pragma unroll
                        for (int j = 0; j < 8; ++j) x[j] *= gg[j];
                        st8bf(XG + (size_t)row * 1024 + col, x); }
                }
                ss += __shfl_xor(ss, 16); ss += __shfl_xor(ss, 32);
                if (fq == 0) atomicAdd(rss + row, ss);
            }
    }
};
struct Epi7 {
    static constexpr bool PERM = true, AFTER_DRAIN = false;
    const float* rss; bf16_t* VB; float* vsum; float* vsq;
    __device__ __forceinline__ void operator()(EPI_ARGS) const {
        const int colL = wc * 32 + 8 * fq, row0 = u.pm * 256 + wr * 64 + fr;
#pragma unroll
        for (int ai = 0; ai < 2; ++ai)
#pragma unroll
            for (int m = 0; m < 4; ++m) {
                const int row = row0 + ai * 128 + m * 16; float s = 0.f, q = 0.f;
                const float rs = __builtin_amdgcn_rsqf(rss[row] * (1.f / 1024.f) + EPS);
#pragma unroll
                for (int bj = 0; bj < 2; ++bj) {
                    const int col = u.pn * 256 + bj * 128 + colL;
                    float v[8]; ACC8(v, ai, bj, m, rs);
#pragma unroll
                    for (int j = 0; j < 8; ++j) { v[j] = geluf_(v[j]); s += v[j]; q += v[j] * v[j]; }
                    st8bf(VB + (size_t)row * 2048 + col, v);
                }
                s += __shfl_xor(s, 16); s += __shfl_xor(s, 32); q += __shfl_xor(q, 16); q += __shfl_xor(q, 32);
                if (fq == 0) { atomicAdd(vsum + row, s); atomicAdd(vsq + row, q); }
            }
    }
};
struct Epi9 {
    static constexpr bool PERM = true, AFTER_DRAIN = false;
    const float* rss; const bf16_t* SB; bf16_t* Y;
    __device__ __forceinline__ void operator()(EPI_ARGS) const {
        const int colL = wc * 32 + 8 * fq, row0 = u.pm * 256 + wr * 64 + fr, col = u.pn * 128 + colL;
#pragma unroll
        for (int ai = 0; ai < 2; ++ai)
#pragma unroll
            for (int m = 0; m < 4; ++m) {
                const int row = row0 + ai * 128 + m * 16;
                const float rs = __builtin_amdgcn_rsqf(rss[row] * (1.f / 1024.f) + EPS);
                float uu[8], zz[8], s[8]; ACC8(uu, ai, 0, m, rs); ACC8(zz, ai, 1, m, rs); ld8bf(SB + (size_t)row * 2048 + col, s);
#pragma unroll
                for (int j = 0; j < 8; ++j) uu[j] = geluf_(uu[j]) * s[j] * siluf_(zz[j]);
                st8bf(Y + (size_t)row * 2048 + col, uu);
            }
    }
};

__device__ __forceinline__ void p0_transpose_item(const float* W, int K, int N, bf16_t* WT, int row_off, LAS float* scr, int kb, int nb, int lane) {
    const int k0 = 64 * kb, n0 = 32 * nb;
#pragma unroll 8
    for (int i = 0; i < 32; ++i) { const int kk = 2 * i + (lane >> 5); scr[kk * 33 + (lane & 31)] = W[(size_t)(k0 + kk) * N + n0 + (lane & 31)]; }
    asm volatile("s_waitcnt lgkmcnt(0)" ::: "memory");
    const int c = lane & 7;
#pragma unroll
    for (int j = 0; j < 4; ++j) { const int n = (lane >> 3) + 8 * j; const LAS float* s = scr + (8 * c) * 33 + n;
        u32x4 o; o.x = pk2(s[0 * 33], s[1 * 33]); o.y = pk2(s[2 * 33], s[3 * 33]); o.z = pk2(s[4 * 33], s[5 * 33]); o.w = pk2(s[6 * 33], s[7 * 33]);
        *(u32x4*)(WT + (size_t)(row_off + n0 + n) * K + k0 + 8 * c) = o; }
    asm volatile("s_waitcnt lgkmcnt(0)" ::: "memory");
}
__device__ __forceinline__ int wino_row(int n) {
    if (n < 2048) return 2048 + 256 * (n >> 7) + (n & 127);
    if (n < 4096) return n - 2048;
    const int z = n - 4096; return 2048 + 256 * (z >> 7) + 128 + (z & 127);
}

template <bool FINAL>
__device__ __forceinline__ void s5_item(int b, int c, int g, bf16_t* U, float* CHS, const float* APOW, const bf16_t* BBT, const bf16_t* CCT, const float* dsk, LAS unsigned char* wlds, int lane) {
    const int h = lane >> 5, r = lane & 31;
    const size_t row0 = (size_t)b * SEQ + (size_t)c * 128;
    bf16x8 bfrag[4];
#pragma unroll
    for (int nt = 0; nt < 4; ++nt) bfrag[nt] = *(const bf16x8*)(BBT + ((size_t)(g * 128 + nt * 32 + r) * 16 + 8 * h));
    float ar[2][4], ai_[2][4], cr[2], ci[2];
#pragma unroll
    for (int ph = 0; ph < 2; ++ph) {
        const int p = 32 * ph + r; const f32x4 w0 = *(const f32x4*)(APOW + (size_t)(g * 64 + p) * 8), w1 = *(const f32x4*)(APOW + (size_t)(g * 64 + p) * 8 + 4);
        ar[ph][0] = w0.x; ai_[ph][0] = w0.y; ar[ph][1] = w0.z; ai_[ph][1] = w0.w; ar[ph][2] = w1.x; ai_[ph][2] = w1.y; ar[ph][3] = w1.z; ai_[ph][3] = w1.w;
        if (FINAL) { const float* cp = CHS + ((size_t)((b * 64 + c) * 64 + g) * 64 + p) * 2; cr[ph] = cp[0]; ci[ph] = cp[1]; } else { cr[ph] = 0.f; ci[ph] = 0.f; }
    }
    bf16x8 cfrag[4];
    if (FINAL) {
#pragma unroll
        for (int ks = 0; ks < 4; ++ks) cfrag[ks] = *(const bf16x8*)(CCT + ((size_t)(g * 16 + (lane & 15)) * 128 + ks * 32 + 8 * (lane >> 4)));
    }
    const float dk = FINAL ? dsk[g * 16 + (lane & 15)] : 0.f;
    for (int sb = 0; sb < 4; ++sb) {
        const bf16x8 afrag = *(const bf16x8*)(U + (row0 + sb * 32 + r) * 1024 + g * 16 + 8 * h);
        f32x16 re[2], im[2];
        const f32x16 zero16 = {0.f, 0.f, 0.f, 0.f, 0.f, 0.f, 0.f, 0.f, 0.f, 0.f, 0.f, 0.f, 0.f, 0.f, 0.f, 0.f};
        re[0] = __builtin_amdgcn_mfma_f32_32x32x16_bf16(afrag, bfrag[0], zero16, 0, 0, 0);
        re[1] = __builtin_amdgcn_mfma_f32_32x32x16_bf16(afrag, bfrag[1], zero16, 0, 0, 0);
        im[0] = __builtin_amdgcn_mfma_f32_32x32x16_bf16(afrag, bfrag[2], zero16, 0, 0, 0);
        im[1] = __builtin_amdgcn_mfma_f32_32x32x16_bf16(afrag, bfrag[3], zero16, 0, 0, 0);
#pragma unroll
        for (int ph = 0; ph < 2; ++ph) {
            const float a1r = ar[ph][0], a1i = ai_[ph][0], a4r = ar[ph][3], a4i = ai_[ph][3];
#pragma unroll
            for (int q = 0; q < 4; ++q) {
#pragma unroll
                for (int j = 1; j < 4; ++j) { const int i = 4 * q + j; const float pr = re[ph][i - 1], pi = im[ph][i - 1];
                    re[ph][i] += a1r * pr - a1i * pi; im[ph][i] += a1r * pi + a1i * pr; }
            }
#pragma unroll
            for (int q = 0; q < 4; ++q) {
                const float Er = re[ph][4 * q + 3], Ei = im[ph][4 * q + 3];
                const float Xr = Er + a4r * cr[ph] - a4i * ci[ph], Xi = Ei + a4r * ci[ph] + a4i * cr[ph];
                const float Xor_ = __shfl_xor(Xr, 32), Xoi = __shfl_xor(Xi, 32);
                const float cinr = h ? Xor_ : cr[ph], cini = h ? Xoi : ci[ph];
                const float Yr = Er + a4r * cinr - a4i * cini, Yi = Ei + a4r * cini + a4i * cinr;
                const float Yor = __shfl_xor(Yr, 32), Yoi = __shfl_xor(Yi, 32);
                if (FINAL) {
#pragma unroll
                    for (int j = 0; j < 4; ++j) { const int i = 4 * q + j; re[ph][i] += ar[ph][j] * cinr - ai_[ph][j] * cini; im[ph][i] += ar[ph][j] * cini + ai_[ph][j] * cinr; }
                }
                cr[ph] = h ? Yr : Yor; ci[ph] = h ? Yi : Yoi;
            }
        }
        if (FINAL) {
#pragma unroll
            for (int ph = 0; ph < 2; ++ph)
#pragma unroll
                for (int i = 0; i < 16; ++i) { const int tok = (i & 3) + 8 * (i >> 2) + 4 * h; const int p = 32 * ph + r;
                    *(LAS unsigned*)(wlds + tok * 272 + 4 * p) = pk2(re[ph][i], im[ph][i]); }
            asm volatile("s_waitcnt lgkmcnt(0)" ::: "memory");
            f32x4 yacc[2] = {(f32x4){0.f, 0.f, 0.f, 0.f}, (f32x4){0.f, 0.f, 0.f, 0.f}};
#pragma unroll
            for (int mt = 0; mt < 2; ++mt)
#pragma unroll
                for (int ks = 0; ks < 4; ++ks) { const bf16x8 a = *(const LAS bf16x8*)(wlds + (mt * 16 + (lane & 15)) * 272 + (ks * 32 + 8 * (lane >> 4)) * 2);
                    yacc[mt] = __builtin_amdgcn_mfma_f32_16x16x32_bf16(a, cfrag[ks], yacc[mt], 0, 0, 0); }
            asm volatile("s_waitcnt lgkmcnt(0)" ::: "memory");
#pragma unroll
            for (int mt = 0; mt < 2; ++mt)
#pragma unroll
                for (int j = 0; j < 4; ++j) { const size_t row = row0 + sb * 32 + mt * 16 + 4 * (lane >> 4) + j; bf16_t* pu = U + row * 1024 + g * 16 + (lane & 15);
                    const float y = yacc[mt][j] + dk * bf2f(*pu); *pu = (bf16_t)f2bf(geluf_(y)); }
        }
    }
    if (!FINAL && h == 0) {
#pragma unroll
        for (int ph = 0; ph < 2; ++ph) { float* cp = CHS + ((size_t)((b * 64 + c) * 64 + g) * 64 + 32 * ph + r) * 2; cp[0] = cr[ph]; cp[1] = ci[ph]; }
    }
}

__device__ __forceinline__ bf16x8 gather8(const LAS bf16_t* p, int pitch) {
    bf16x8 v;
#pragma unroll
    for (int j = 0; j < 8; ++j) v[j] = (short)p[j * pitch];
    return v;
}
#define MFMA32(a, b, c) __builtin_amdgcn_mfma_f32_32x32x16_bf16((a), (b), (c), 0, 0, 0)
#define ZERO16 ((f32x16){0.f, 0.f, 0.f, 0.f, 0.f, 0.f, 0.f, 0.f, 0.f, 0.f, 0.f, 0.f, 0.f, 0.f, 0.f, 0.f})

__global__ void __launch_bounds__(NTHR, 2) mk_fwd(Args args) {
    extern __shared__ __attribute__((aligned(16))) unsigned char lds_raw[];
    LAS unsigned char* lds = (LAS unsigned char*)lds_raw;
    cg::grid_group grid = cg::this_grid();
    const int tid = threadIdx.x, lane = tid & 63, wid = __builtin_amdgcn_readfirstlane(tid >> 6);
    const int G = gridDim.x, bid = blockIdx.x;
    const int gw = bid * 8 + wid, NGW = G * 8;
    const int gtid = bid * NTHR + tid, NGT = G * NTHR;
    unsigned char* ws = args.ws;
    const float* x = args.in[0];
    float* RSS0 = (float*)(ws + WS_RSS0); float* RSS1 = (float*)(ws + WS_RSS1); float* VSUM = (float*)(ws + WS_VSUM); float* VSQ = (float*)(ws + WS_VSQ); float* RSS2 = (float*)(ws + WS_RSS2);
    float* APOW = (float*)(ws + WS_APOW); float* A128 = (float*)(ws + WS_A128); bf16_t* BBT = (bf16_t*)(ws + WS_BBT); bf16_t* CCT = (bf16_t*)(ws + WS_CCT);
    float* COS = (float*)(ws + WS_COS); float* SIN = (float*)(ws + WS_SIN); float* CHS = (float*)(ws + WS_CHS);
    bf16_t* WINE = (bf16_t*)(ws + WS_WINE); bf16_t* WGLU = (bf16_t*)(ws + WS_WGLU); bf16_t* WOUTE = (bf16_t*)(ws + WS_WOUTE); bf16_t* WINO = (bf16_t*)(ws + WS_WINO); bf16_t* WOUTO = (bf16_t*)(ws + WS_WOUTO);
    bf16_t* U = (bf16_t*)(ws + WS_U); bf16_t* CAT = (bf16_t*)(ws + WS_CAT); bf16_t* Kb = (bf16_t*)(ws + WS_K); bf16_t* Vb = (bf16_t*)(ws + WS_V); bf16_t* SZB = (bf16_t*)(ws + WS_SZB);
    float* X1 = (float*)(ws + WS_X1);
    bf16_t* XG0 = (bf16_t*)args.out;
    bf16_t* STATE = (bf16_t*)args.out;
    bf16_t* VB = (bf16_t*)args.out;
    const int lo = args.ph_lo, hi = args.ph_hi;
#ifndef PHMASK
#define PHMASK 0xFFF
#endif
#define IN(k) (((PHMASK >> (k)) & 1) && lo <= (k) && (k) < hi)
#define SEAM(k) do { if (IN(k) && IN((k) + 1)) grid.sync(); } while (0)

    if (IN(0)) {
        LAS float* scr = (LAS float*)(lds + wid * 16384);
        constexpr int I_INE = 16 * 192, I_GLU = 16 * 32, I_OUTE = 32 * 32, I_INO = 16 * 192, I_OUTO = 32 * 32;
        constexpr int NIT = I_INE + I_GLU + I_OUTE + I_INO + I_OUTO;
        for (int it = gw; it < NIT; it += NGW) {
            int rr = it;
            if (rr < I_INE) { p0_transpose_item(args.in[2], 1024, 6144, WINE, 0, scr, rr / 192, rr % 192, lane); continue; } rr -= I_INE;
            if (rr < I_GLU) { p0_transpose_item(args.in[11], 1024, 1024, WGLU, 0, scr, rr / 32, rr % 32, lane); continue; } rr -= I_GLU;
            if (rr < I_OUTE) { p0_transpose_item(args.in[14], 2048, 1024, WOUTE, 0, scr, rr / 32, rr % 32, lane); continue; } rr -= I_OUTE;
            if (rr < I_INO) { const int nb = rr % 192; p0_transpose_item(args.in[16], 1024, 6144, WINO, wino_row(32 * nb) - 32 * nb, scr, rr / 192, nb, lane); continue; } rr -= I_INO;
            p0_transpose_item(args.in[20], 2048, 1024, WOUTO, 0, scr, rr / 32, rr % 32, lane);
        }
        for (int m = gw; m < M; m += NGW) {
            const f32x4* xr = (const f32x4*)(x + (size_t)m * D) + lane; const f32x4* gr = (const f32x4*)args.in[1] + lane;
            float s = 0.f; u32x2* o8 = (u32x2*)(XG0 + (size_t)m * D) + lane;
#pragma unroll
            for (int j = 0; j < 4; ++j) { const f32x4 v = xr[64 * j], gg = gr[64 * j]; s += (v.x * v.x + v.y * v.y) + (v.z * v.z + v.w * v.w);
                u32x2 w; w.x = pk2(v.x * gg.x, v.y * gg.y); w.y = pk2(v.z * gg.z, v.w * gg.w); o8[64 * j] = w; }
            s = wave_sum(s); if (lane == 0) RSS0[m] = s;
        }
        for (int e = gtid; e < SEQ * 128; e += NGT) { const int pos = e >> 7, i = e & 127;
            const double inv = exp(-(double)i * (9.210340371976184 / 128.0)); double s, c; sincos_d((double)pos * inv, s, c); COS[e] = (float)c; SIN[e] = (float)s; }
        for (int e = gtid; e < 4096; e += NGT) { const int g = e >> 6, p = e & 63;
            const double lr = fmin((double)args.in[3][e], -1e-4), li = (double)args.in[4][e], dt = exp((double)args.in[5][g]);
            const double mag = exp(lr * dt); double sn, cs; sincos_d(li * dt, sn, cs);
            const double abr = mag * cs, abi = mag * sn, den = lr * lr + li * li, nr = abr - 1.0, ni = abi;
            const double zr = (nr * lr + ni * li) / den, zi = (ni * lr - nr * li) / den;
            double pr = abr, pi = abi;
#pragma unroll
            for (int k = 0; k < 4; ++k) { APOW[e * 8 + 2 * k] = (float)pr; APOW[e * 8 + 2 * k + 1] = (float)pi; const double t = pr * abr - pi * abi; pi = pr * abi + pi * abr; pr = t; }
            double qr = abr, qi = abi;
#pragma unroll
            for (int k = 0; k < 7; ++k) { const double t = qr * qr - qi * qi; qi = 2.0 * qr * qi; qr = t; }
            A128[e * 2] = (float)qr; A128[e * 2 + 1] = (float)qi;
            const float* br = args.in[6] + (size_t)e * 16; const float* bi = args.in[7] + (size_t)e * 16;
#pragma unroll
            for (int k = 0; k < 16; ++k) { const double b_r = br[k], b_i = bi[k];
                BBT[(size_t)(g * 128 + p) * 16 + k] = (bf16_t)f2bf((float)(zr * b_r - zi * b_i)); BBT[(size_t)(g * 128 + 64 + p) * 16 + k] = (bf16_t)f2bf((float)(zr * b_i + zi * b_r)); }
#pragma unroll
            for (int hh = 0; hh < 16; ++hh) { const float c_r = args.in[8][(size_t)(g * 16 + hh) * 64 + p], c_i = args.in[9][(size_t)(g * 16 + hh) * 64 + p];
                CCT[(size_t)(g * 16 + hh) * 128 + 2 * p] = (bf16_t)f2bf(c_r); CCT[(size_t)(g * 16 + hh) * 128 + 2 * p + 1] = (bf16_t)f2bf(-c_i); }
        }
        for (int e = gtid; e < M; e += NGT) { RSS1[e] = 0.f; VSUM[e] = 0.f; VSQ[e] = 0.f; RSS2[e] = 0.f; }
        __syncthreads();
    }
    SEAM(0);
    if (IN(1)) {
        pg8::Gemm g{XG0, WINE, M, 6144, 1024}; pg8::StaticOrder S; S.init(M, 6144, G, bid);
        Epi1 E{RSS0, U, CAT, Kb, Vb, SZB, COS, SIN};
        pg8::gemm_phase<Epi1, pg8::StaticOrder, true, true>(lds, g, S, E);
    }
    SEAM(1);
    if (IN(2)) {
        for (int it = gw; it < 2 * 64 * 64; it += NGW) { const int g = it & 63, c = (it >> 6) & 63, b = it >> 12;
            s5_item<false>(b, c, g, U, CHS, APOW, BBT, CCT, args.in[10], lds + wid * 8704, lane); }
        __syncthreads();
        LAS bf16_t* Vs = (LAS bf16_t*)lds; LAS bf16_t* Ks = (LAS bf16_t*)(lds + 34816);
        const int wm = wid >> 1, wn = wid & 1, h5 = lane >> 5, r = lane & 31;
        for (int it = bid; it < 2048; it += G) {
            const int kt = it & 1, vt = (it >> 1) & 1, hh = (it >> 2) & 3, c = (it >> 4) & 63, b = it >> 10;
            const size_t row0 = (size_t)b * SEQ + (size_t)c * 128; const float lg = lg_gamma(hh);
#pragma unroll
            for (int i = 0; i < 4; ++i) { const int idx = tid + NTHR * i, row = idx >> 4, ch = idx & 15;
                float v[8]; ld8bf(Vb + (row0 + row) * 1024 + hh * 256 + vt * 128 + ch * 8, v);
                const float z = __builtin_amdgcn_exp2f((float)(127 - row) * lg);
#pragma unroll
                for (int j = 0; j < 8; ++j) v[j] *= z;
                u32x4 w; w.x = pk2(v[0], v[1]); w.y = pk2(v[2], v[3]); w.z = pk2(v[4], v[5]); w.w = pk2(v[6], v[7]);
                *(LAS u32x4*)(Vs + row * 136 + ch * 8) = w;
                *(LAS u32x4*)(Ks + row * 136 + ch * 8) = *(const u32x4*)(Kb + (row0 + row) * 1024 + hh * 256 + kt * 128 + ch * 8); }
            __syncthreads();
            f32x16 acc[2] = {ZERO16, ZERO16};
#pragma unroll
            for (int ks = 0; ks < 8; ++ks) { const int m0 = 16 * ks + 8 * h5;
                const bf16x8 a = gather8(Vs + m0 * 136 + 32 * wm + r, 136);
#pragma unroll
                for (int nt = 0; nt < 2; ++nt) { const bf16x8 bb = gather8(Ks + m0 * 136 + 64 * wn + 32 * nt + r, 136); acc[nt] = MFMA32(a, bb, acc[nt]); } }
            bf16_t* dst = STATE + ((size_t)((b * 64 + c) * 4 + hh) * 256 + vt * 128 + 32 * wm) * 256 + kt * 128 + 64 * wn + r;
#pragma unroll
            for (int nt = 0; nt < 2; ++nt)
#pragma unroll
                for (int i = 0; i < 16; ++i) { const int rw = (i & 3) + 8 * (i >> 2) + 4 * h5; dst[(size_t)rw * 256 + 32 * nt] = (bf16_t)f2bf(acc[nt][i]); }
            __syncthreads();
        }
    }
    SEAM(2);
    if (IN(3)) {
        for (int e = gtid; e < 131072; e += NGT) { const int bh = e >> 14, idx4 = e & 16383, b = bh >> 2, hh = bh & 3;
            const float cd = __builtin_amdgcn_exp2f(128.f * lg_gamma(hh)); float s0 = 0.f, s1 = 0.f, s2 = 0.f, s3 = 0.f;
            u32x2* p = (u32x2*)(STATE + ((size_t)(b * 64) * 4 + hh) * 65536 + (size_t)idx4 * 4);
#pragma unroll 8
            for (int c = 0; c < 64; ++c) { u32x2* q = p + (size_t)c * (4 * 65536 / 4); const u32x2 w = *q;
                u32x2 o; o.x = pk2(s0, s1); o.y = pk2(s2, s3); *q = o;
                s0 = s0 * cd + bflo(w.x); s1 = s1 * cd + bfhi(w.x); s2 = s2 * cd + bflo(w.y); s3 = s3 * cd + bfhi(w.y); } }
        for (int e = gtid; e < 8192; e += NGT) { const int b = e >> 12, gp = e & 4095; const float ar = A128[gp * 2], ai = A128[gp * 2 + 1]; float cr = 0.f, ci = 0.f;
            for (int c = 0; c < 64; ++c) { float* q = CHS + ((size_t)(b * 64 + c) * 4096 + gp) * 2; const float lr_ = q[0], li_ = q[1]; q[0] = cr; q[1] = ci;
                const float t = ar * cr - ai * ci + lr_; ci = ar * ci + ai * cr + li_; cr = t; } }
    }
    SEAM(3);
    if (IN(4)) {
#ifndef NO_S5C
        for (int it = gw; it < 2 * 64 * 64; it += NGW) { const int g = it & 63, c = (it >> 6) & 63, b = it >> 12;
            s5_item<true>(b, c, g, U, CHS, APOW, BBT, CCT, args.in[10], lds + wid * 8704, lane); }
#endif
        __syncthreads();
#ifndef NO_RETC
        LAS bf16_t* Qs = (LAS bf16_t*)lds; LAS bf16_t* Ks = (LAS bf16_t*)(lds + 67584); LAS bf16_t* Ps = (LAS bf16_t*)(lds + 67584); LAS bf16_t* Xs = (LAS bf16_t*)(lds + 67584 + 34816);
        LAS float* red = (LAS float*)lds;
        const int wm = wid >> 1, wn = wid & 1, h5_ = lane >> 5, r_ = lane & 31;
        const float* gain = args.in[13];
        for (int it = bid; it < 512; it += G) {
            const int hh = it & 3, c = (it >> 2) & 63, b = it >> 8;
            int h5 = h5_, r = r_; asm volatile("" : "+v"(h5), "+v"(r));
            const size_t row0 = (size_t)b * SEQ + (size_t)c * 128; const float lg = lg_gamma(hh);
#pragma unroll
            for (int i = 0; i < 8; ++i) { const int idx = tid + NTHR * i, row = idx >> 5, ch = idx & 31;
                *(LAS u32x4*)(Qs + row * 264 + ch * 8) = *(const u32x4*)(CAT + (row0 + row) * 2048 + 1024 + hh * 256 + ch * 8);
                *(LAS u32x4*)(Ks + row * 264 + ch * 8) = *(const u32x4*)(Kb + (row0 + row) * 1024 + hh * 256 + ch * 8); }
            __syncthreads();
            f32x16 sacc[2] = {ZERO16, ZERO16};
#pragma unroll 4
            for (int ks = 0; ks < 16; ++ks) { const int k0 = 16 * ks + 8 * h5;
                const bf16x8 a = *(const LAS bf16x8*)(Qs + (32 * wm + r) * 264 + k0);
#pragma unroll
                for (int nt = 0; nt < 2; ++nt) { const bf16x8 bb = *(const LAS bf16x8*)(Ks + (64 * wn + 32 * nt + r) * 264 + k0); sacc[nt] = MFMA32(a, bb, sacc[nt]); } }
            __syncthreads();
            asm volatile("" : "+v"(h5), "+v"(r));
#pragma unroll
            for (int nt = 0; nt < 2; ++nt) { const int mcol = 64 * wn + 32 * nt + r; const float dm = __builtin_amdgcn_exp2f(-(float)(mcol + 1) * lg);
#pragma unroll
                for (int i = 0; i < 16; ++i) { const int n = 32 * wm + (i & 3) + 8 * (i >> 2) + 4 * h5; Ps[n * 136 + mcol] = (bf16_t)f2bf(n >= mcol ? sacc[nt][i] * dm : 0.f); } }
            f32x16 oacc[2][2] = {{ZERO16, ZERO16}, {ZERO16, ZERO16}};
#pragma unroll
            for (int vh = 0; vh < 2; ++vh) {
                asm volatile("" : "+v"(h5), "+v"(r));
#pragma unroll
                for (int i = 0; i < 4; ++i) { const int idx = tid + NTHR * i, row = idx >> 4, ch = idx & 15;
                    *(LAS u32x4*)(Xs + row * 136 + ch * 8) = *(const u32x4*)(Vb + (row0 + row) * 1024 + hh * 256 + vh * 128 + ch * 8); }
                __syncthreads();
#pragma unroll 2
                for (int ks = 0; ks < 8; ++ks) { const int m0 = 16 * ks + 8 * h5;
                    const bf16x8 a = *(const LAS bf16x8*)(Ps + (32 * wm + r) * 136 + m0);
#pragma unroll
                    for (int nt = 0; nt < 2; ++nt) { const bf16x8 bb = gather8(Xs + m0 * 136 + 64 * wn + 32 * nt + r, 136); oacc[vh][nt] = MFMA32(a, bb, oacc[vh][nt]); } }
                const bf16_t* st = STATE + ((size_t)((b * 64 + c) * 4 + hh) * 256 + vh * 128) * 256;
#pragma unroll 1
                for (int kc = 0; kc < 4; ++kc) {
                    __syncthreads();
#pragma unroll
                    for (int i = 0; i < 2; ++i) { const int idx = tid + NTHR * i, row = idx >> 3, ch = idx & 7;
                        *(LAS u32x4*)(Xs + row * 72 + ch * 8) = *(const u32x4*)(st + (size_t)row * 256 + kc * 64 + ch * 8); }
                    __syncthreads();
#pragma unroll
                    for (int ks = 0; ks < 4; ++ks) { const int k0 = 16 * ks + 8 * h5;
                        const bf16x8 a = *(const LAS bf16x8*)(Qs + (32 * wm + r) * 264 + kc * 64 + k0);
#pragma unroll
                        for (int nt = 0; nt < 2; ++nt) { const bf16x8 bb = *(const LAS bf16x8*)(Xs + (64 * wn + 32 * nt + r) * 72 + k0); oacc[vh][nt] = MFMA32(a, bb, oacc[vh][nt]); } }
                }
                __syncthreads();
            }
            asm volatile("" : "+v"(h5), "+v"(r));
            float ps[16], pq[16];
#pragma unroll
            for (int i = 0; i < 16; ++i) { const int n = 32 * wm + (i & 3) + 8 * (i >> 2) + 4 * h5; const float xi = __builtin_amdgcn_exp2f((float)(n + 1) * lg); float s = 0.f, q = 0.f;
#pragma unroll
                for (int vh = 0; vh < 2; ++vh)
#pragma unroll
                    for (int nt = 0; nt < 2; ++nt) { const float o = oacc[vh][nt][i] * xi; oacc[vh][nt][i] = o; s += o; q += o * o; }
                ps[i] = s; pq[i] = q; }
#pragma unroll
            for (int o = 1; o < 32; o <<= 1)
#pragma unroll
                for (int i = 0; i < 16; ++i) { ps[i] += __shfl_xor(ps[i], o); pq[i] += __shfl_xor(pq[i], o); }
            if (r == 0) {
#pragma unroll
                for (int i = 0; i < 16; ++i) { const int n = 32 * wm + (i & 3) + 8 * (i >> 2) + 4 * h5; red[(wn * 128 + n) * 2] = ps[i]; red[(wn * 128 + n) * 2 + 1] = pq[i]; } }
            __syncthreads();
            asm volatile("" : "+v"(h5), "+v"(r));
#pragma unroll
            for (int i = 0; i < 16; ++i) { const int n = 32 * wm + (i & 3) + 8 * (i >> 2) + 4 * h5;
                const float s = red[n * 2] + red[(128 + n) * 2], q = red[n * 2 + 1] + red[(128 + n) * 2 + 1];
                const float mu = s * (1.f / 256.f), var = fmaxf(q * (1.f / 256.f) - mu * mu, 0.f), rstd = __builtin_amdgcn_rsqf(var + EPS);
#pragma unroll
                for (int vh = 0; vh < 2; ++vh)
#pragma unroll
                    for (int nt = 0; nt < 2; ++nt) { const int col = hh * 256 + vh * 128 + 64 * wn + 32 * nt + r;
                        const float y = (oacc[vh][nt][i] - mu) * rstd * gain[col] * bf2f(SZB[(row0 + n) * 1024 + col]);
                        CAT[(row0 + n) * 2048 + 1024 + col] = (bf16_t)f2bf(y); }
                __builtin_amdgcn_sched_barrier(0); }
            __syncthreads();
        }
#endif
    }
    SEAM(4);
    if (IN(5)) {
        pg8::Gemm g{U, WGLU, M, 1024, 1024}; pg8::StaticOrder S; S.init(M, 1024, G, bid);
        EpiGlu E{args.in[12], U, CAT};
        pg8::gemm_phase<EpiGlu, pg8::StaticOrder, true, true>(lds, g, S, E);
    }
    SEAM(5);
    if (IN(6)) {
        pg8::Gemm g{CAT, WOUTE, M, 1024, 2048}; pg8::StaticOrder S; S.init(M, 1024, G, bid);
        EpiOut E{x, X1, U, args.in[15], RSS1};
        pg8::gemm_phase<EpiOut, pg8::StaticOrder, true, true>(lds, g, S, E);
    }
    SEAM(6);
    if (IN(7)) {
        pg8::Gemm g{U, WINO, M, 2048, 1024}; pg8::StaticOrder S; S.init(M, 2048, G, bid);
        Epi7 E{RSS1, VB, VSUM, VSQ};
        pg8::gemm_phase<Epi7, pg8::StaticOrder, true, true>(lds, g, S, E);
    }
    SEAM(7);
    if (IN(8)) {
        LAS bf16_t* Wsm = (LAS bf16_t*)lds; LAS bf16_t* Vs = (LAS bf16_t*)(lds + 34816);
        const int wm = wid >> 1, wn = wid & 1, h5 = lane >> 5, r = lane & 31;
        const float* vgain = args.in[17]; const float* wsp = args.in[18]; const float* bsp = args.in[19];
        for (int it = bid; it < 2048; it += G) {
            const int ds = it & 3, gg = (it >> 2) & 3, c = (it >> 4) & 63, b = it >> 10;
            const size_t row0 = (size_t)b * SEQ + (size_t)c * 128; const int col0 = gg * 512 + ds * 128;
#pragma unroll
            for (int i = 0; i < 4; ++i) { const int idx = tid + NTHR * i, row = idx >> 4, ch = idx & 15;
                float w[8]; ld8f(wsp + ((size_t)gg * 128 + row) * 128 + ch * 8, w);
#pragma unroll
                for (int j = 0; j < 8; ++j) w[j] = (ch * 8 + j <= row) ? w[j] : 0.f;
                u32x4 o; o.x = pk2(w[0], w[1]); o.y = pk2(w[2], w[3]); o.z = pk2(w[4], w[5]); o.w = pk2(w[6], w[7]);
                *(LAS u32x4*)(Wsm + row * 136 + ch * 8) = o;
                float v[8], gn[8]; ld8bf(VB + (row0 + row) * 2048 + col0 + ch * 8, v); ld8f(vgain + col0 + ch * 8, gn);
                const float mu = VSUM[row0 + row] * (1.f / 2048.f), var = fmaxf(VSQ[row0 + row] * (1.f / 2048.f) - mu * mu, 0.f), rstd = __builtin_amdgcn_rsqf(var + EPS);
#pragma unroll
                for (int j = 0; j < 8; ++j) v[j] = (v[j] - mu) * rstd * gn[j];
                u32x4 o2; o2.x = pk2(v[0], v[1]); o2.y = pk2(v[2], v[3]); o2.z = pk2(v[4], v[5]); o2.w = pk2(v[6], v[7]);
                *(LAS u32x4*)(Vs + row * 136 + ch * 8) = o2; }
            __syncthreads();
            f32x16 acc[2] = {ZERO16, ZERO16};
#pragma unroll
            for (int ks = 0; ks < 8; ++ks) { const int m0 = 16 * ks + 8 * h5;
                const bf16x8 a = *(const LAS bf16x8*)(Wsm + (32 * wm + r) * 136 + m0);
#pragma unroll
                for (int nt = 0; nt < 2; ++nt) { const bf16x8 bb = gather8(Vs + m0 * 136 + 64 * wn + 32 * nt + r, 136); acc[nt] = MFMA32(a, bb, acc[nt]); } }
#pragma unroll
            for (int i = 0; i < 16; ++i) { const int t = 32 * wm + (i & 3) + 8 * (i >> 2) + 4 * h5; const float bias = bsp[gg * 128 + t];
#pragma unroll
                for (int nt = 0; nt < 2; ++nt) VB[(row0 + t) * 2048 + col0 + 64 * wn + 32 * nt + r] = (bf16_t)f2bf(acc[nt][i] + bias); }
            __syncthreads();
        }
    }
    SEAM(8);
    if (IN(9)) {
        pg8::Gemm g{U, WINO + (size_t)2048 * 1024, M, 4096, 1024}; pg8::StaticOrder S; S.init(M, 4096, G, bid);
        Epi9 E{RSS1, VB, CAT};
        pg8::gemm_phase<Epi9, pg8::StaticOrder, true, true>(lds, g, S, E);
    }
    SEAM(9);
    if (IN(10)) {
        pg8::Gemm g{CAT, WOUTO, M, 1024, 2048}; pg8::StaticOrder S; S.init(M, 1024, G, bid);
        EpiOut E{X1, X1, nullptr, nullptr, RSS2};
        pg8::gemm_phase<EpiOut, pg8::StaticOrder, true, true>(lds, g, S, E);
    }
    SEAM(10);
    if (IN(11)) {
        for (int m = gw; m < M; m += NGW) {
            const f32x4* xr = (const f32x4*)(X1 + (size_t)m * D) + lane; const f32x4* gr = (const f32x4*)args.in[21] + lane; f32x4* o = (f32x4*)(args.out + (size_t)m * D) + lane;
            const float rs = __builtin_amdgcn_rsqf(RSS2[m] * (1.f / 1024.f) + EPS);
#pragma unroll
            for (int j = 0; j < 4; ++j) { const f32x4 v = xr[64 * j], gg = gr[64 * j]; o[64 * j] = (f32x4){v.x * rs * gg.x, v.y * rs * gg.y, v.z * rs * gg.z, v.w * rs * gg.w}; }
        }
    }
#undef IN
#undef SEAM
}

extern "C" void kernel_launch(void* const* d_in, const int* in_sizes, int n_in, void* d_out, int out_size, void* d_ws, size_t ws_size, hipStream_t stream) {
    static int grid = 0;
    if (grid == 0) {
        if (n_in != 22 || out_size != M * D || ws_size < WS_END) { fprintf(stderr, "kernel_launch: unexpected shapes (n_in %d out %d ws %zu)\n", n_in, out_size, ws_size); grid = -1; return; }
        int dev = 0, cus = 0, per_cu = 0;
        hipGetDevice(&dev); hipDeviceGetAttribute(&cus, hipDeviceAttributeMultiprocessorCount, dev);
        if (hipFuncSetAttribute((const void*)mk_fwd, hipFuncAttributeMaxDynamicSharedMemorySize, LDS_BYTES) != hipSuccess) { fprintf(stderr, "kernel_launch: hipFuncSetAttribute failed\n"); grid = -1; return; }
        if (hipOccupancyMaxActiveBlocksPerMultiprocessor(&per_cu, (const void*)mk_fwd, NTHR, LDS_BYTES) != hipSuccess || per_cu < 1) { fprintf(stderr, "kernel_launch: occupancy query says %d\n", per_cu); grid = -1; return; }
        grid = cus * (per_cu > 1 ? 1 : per_cu);
    }
    if (grid < 0) return;
    Args a{};
    for (int i = 0; i < 22; ++i) a.in[i] = (const float*)d_in[i];
    a.out = (float*)d_out; a.ws = (unsigned char*)d_ws;
#if MK_PER_PHASE
    for (int p = 0; p < NPH; ++p) { a.ph_lo = p; a.ph_hi = p + 1; hipLaunchKernelGGL(mk_fwd, dim3(grid), dim3(NTHR), LDS_BYTES, stream, a); }
#else
    a.ph_lo = 0; a.ph_hi = NPH;
    void* kargs[] = {&a};
    hipError_t e = hipLaunchCooperativeKernel((const void*)mk_fwd, dim3(grid), dim3(NTHR), kargs, LDS_BYTES, stream);
    if (e != hipSuccess) fprintf(stderr, "kernel_launch: cooperative launch failed: %s (grid %d)\n", hipGetErrorString(e), grid);
#endif
}
```

```cpp
#include <hip/hip_runtime.h>
#include <hip/hip_cooperative_groups.h>
#include <cstdio>
#include <cstdint>
namespace cg = cooperative_groups;
namespace pg8 {
#define PG8_LAS __attribute__((address_space(3)))
typedef unsigned short bf16_t;
typedef short bf16x8 __attribute__((ext_vector_type(8)));
typedef float f32x4 __attribute__((ext_vector_type(4)));
typedef unsigned u32x4 __attribute__((ext_vector_type(4)));
constexpr int BM = 256, BK = 64, HALF = 128, HTB = HALF * BK * 2  , STAGE_BYTES = 8 * HTB, NXCD = 8, WGM = 8;

__host__ __device__ __forceinline__ int lds_byte(int r, int c) { const int st = (r >> 4) * 2 + (c >> 5), rr = r & 15, cc = c & 31, ob = rr * 64 + cc * 2; return st * 1024 + (ob ^ (((ob >> 9) & 1) << 5)); }
__host__ __device__ __forceinline__ void stage_rc(int b, int& R, int& C) { const int st = b / 1024, sb = b % 1024, swz = sb ^ (((sb >> 9) & 1) << 5); R = (st >> 1) * 16 + swz / 64; C = (st & 1) * 32 + (swz % 64) / 2; }
__host__ __device__ __forceinline__ int perm32(int rho) { const int n = rho >> 4, i = rho & 15; return 8 * (i >> 2) + 4 * n + (i & 3); }

struct Unit { int pm, pn; };
struct Gemm { const bf16_t* A; const bf16_t* Bt; int M, N, K; };

struct StaticOrder {
    int nM, nN, nwg, G, c;
    __host__ __device__ void init(int M, int N, int G_, int c_) { nM = M / BM; nN = N / BM; nwg = nM * nN; G = G_; c = c_; }
    __host__ __device__ bool next(int i, Unit& u) const {
        const long L = (long)i * G + c; if (L >= nwg) return false;
        int wgid = (int)L; { const int q = nwg / NXCD, r = nwg % NXCD, xcd = wgid % NXCD, off = wgid / NXCD; wgid = (xcd < r ? xcd * (q + 1) : r * (q + 1) + (xcd - r) * q) + off; }
        const int nig = WGM * nN, gid = wgid / nig, fm = gid * WGM, gsz = (nM - fm) < WGM ? (nM - fm) : WGM;
        u.pm = fm + ((wgid % nig) % gsz); u.pn = (wgid % nig) / gsz; return true;
    }
    __device__ __forceinline__ void a_ready(const Unit&) const {}
    __device__ __forceinline__ void done(const Unit&) const {}
};

__device__ __forceinline__ unsigned cvt_pk_bf16(float lo, float hi) { unsigned r; asm volatile("v_cvt_pk_bf16_f32 %0, %1, %2" : "=v"(r) : "v"(lo), "v"(hi)); return r; }
template <class Epi, class Sched, bool ALIGN_EPI = false, bool SP2 = false>
__device__ __forceinline__ void gemm_phase(PG8_LAS unsigned char* lds, const Gemm g, const Sched& S, const Epi& E) {
    const int tid = threadIdx.x, wid = __builtin_amdgcn_readfirstlane(tid >> 6), lane = tid & 63, wr = wid >> 2, wc = wid & 3, fr = lane & 15, fq = lane >> 4;
    const int K = g.K, nt = K / BK;
    unsigned voffA[2], voffB[2];
#pragma unroll
    for (int i = 0; i < 2; ++i) { int R, C; stage_rc(tid * 16 + i * 8192, R, C); const int Rb = Epi::PERM ? ((R & ~31) + perm32(R & 31)) : R;
        voffA[i] = (unsigned)(R * K + C) * 2u; voffB[i] = (unsigned)(Rb * K + C) * 2u; }
    const size_t kstep = (size_t)(BK * 2);
    const size_t hstep = (size_t)HALF * K * 2;
    const size_t tstep = 2 * hstep;
    const unsigned ldsw = (unsigned)wid * 1024u;
    const int aoff = lds_byte(wr * 64 + fr, fq * 8), boff = lds_byte(wc * 32 + fr, fq * 8);
#define PG8_SA(b, h) (((b) * 2 + (h)) * HTB)
#define PG8_SB(b, h) ((4 + (b) * 2 + (h)) * HTB)
#define PG8_STAGE(bufoff, gbase, voff) do { _Pragma("unroll") for (int _i = 0; _i < 2; ++_i) \
        __builtin_amdgcn_global_load_lds((const unsigned*)((const char*)(gbase) + (voff)[_i]), (PG8_LAS unsigned*)(lds + (bufoff) + ldsw + _i * 8192), 16, 0, 0); } while (0)
#define PG8_LDA(dst, b, h) do { _Pragma("unroll") for (int m = 0; m < 4; ++m) _Pragma("unroll") for (int k = 0; k < 2; ++k) dst[m][k] = *(const PG8_LAS bf16x8*)(lds + PG8_SA(b, h) + aoff + m * 2048 + k * 1024); } while (0)
#define PG8_LDB(dst, b, h) do { _Pragma("unroll") for (int n = 0; n < 2; ++n) _Pragma("unroll") for (int k = 0; k < 2; ++k) dst[n][k] = *(const PG8_LAS bf16x8*)(lds + PG8_SB(b, h) + boff + n * 2048 + k * 1024); } while (0)
#define PG8_MMA(ai, bj, At, Bt) do { __builtin_amdgcn_s_setprio(1); _Pragma("unroll") for (int m = 0; m < 4; ++m) _Pragma("unroll") for (int n = 0; n < 2; ++n) _Pragma("unroll") for (int k = 0; k < 2; ++k) \
        acc[ai][bj][m][n] = __builtin_amdgcn_mfma_f32_16x16x32_bf16(Bt[n][k], At[m][k], acc[ai][bj][m][n], 0, 0, 0); __builtin_amdgcn_s_setprio(0); } while (0)
#define PG8_WAIT_V(n) asm volatile("s_waitcnt vmcnt(" #n ")" ::: "memory")
#define PG8_WAIT_L(n) asm volatile("s_waitcnt lgkmcnt(" #n ")" ::: "memory")
#define PG8_BAR __builtin_amdgcn_s_barrier()
#define PG8_SCHED __builtin_amdgcn_sched_barrier(0)
    Unit cur, nxt; int ui = 0;
    if (!S.next(0, cur)) return;
    f32x4 acc[2][2][4][2];
#pragma unroll
    for (int a = 0; a < 2; ++a)
#pragma unroll
        for (int b = 0; b < 2; ++b)
#pragma unroll
            for (int m = 0; m < 4; ++m)
#pragma unroll
                for (int n = 0; n < 2; ++n) acc[a][b][m][n] = (f32x4){0.f, 0.f, 0.f, 0.f};
    bf16x8 At[4][2], B0[2][2], B1[2][2];
    const char* cA = (const char*)g.A + (size_t)cur.pm * tstep; const char* cB = (const char*)g.Bt + (size_t)cur.pn * tstep;
    S.a_ready(cur);
    if constexpr (SP2) {
        PG8_STAGE(PG8_SB(0, 0), cB, voffB); PG8_STAGE(PG8_SB(0, 1), cB + hstep, voffB); PG8_STAGE(PG8_SA(0, 0), cA, voffA); PG8_STAGE(PG8_SA(0, 1), cA + hstep, voffA);
        if (wr == 1) PG8_BAR;
        PG8_WAIT_V(2); PG8_BAR;
        PG8_STAGE(PG8_SB(1, 0), cB + kstep, voffB); PG8_STAGE(PG8_SA(1, 0), cA + kstep, voffA); PG8_STAGE(PG8_SB(1, 1), cB + hstep + kstep, voffB);
        PG8_WAIT_V(6); PG8_BAR;
    } else {
        PG8_STAGE(PG8_SB(0, 0), cB, voffB); PG8_STAGE(PG8_SA(0, 0), cA, voffA); PG8_STAGE(PG8_SB(0, 1), cB + hstep, voffB); PG8_STAGE(PG8_SA(0, 1), cA + hstep, voffA);
        if (wr == 1) PG8_BAR;
        PG8_WAIT_V(4); PG8_BAR;
        PG8_STAGE(PG8_SB(1, 0), cB + kstep, voffB); PG8_STAGE(PG8_SA(1, 0), cA + kstep, voffA); PG8_STAGE(PG8_SB(1, 1), cB + hstep + kstep, voffB);
        PG8_WAIT_V(6); PG8_BAR;
    }
    for (;;) {
        const bool has_next = S.next(ui + 1, nxt);
        const char* nA = has_next ? (const char*)g.A + (size_t)nxt.pm * tstep : cA; const char* nB = has_next ? (const char*)g.Bt + (size_t)nxt.pn * tstep : cB;
        for (int t = 0; t < nt; t += 2) {
            const bool last = (t == nt - 2);
            const char* a1 = cA + (size_t)(t + 1) * kstep;
            const char* a2 = last ? nA : cA + (size_t)(t + 2) * kstep; const char* b2 = last ? nB : cB + (size_t)(t + 2) * kstep;
            const char* a3 = a2 + kstep; const char* b3 = b2 + kstep;
            if (last && has_next) S.a_ready(nxt);
            if constexpr (SP2) {
            PG8_LDB(B0, 0, 0); PG8_LDB(B1, 0, 1); PG8_SCHED; PG8_LDA(At, 0, 0); PG8_STAGE(PG8_SA(1, 1), a1 + hstep, voffA);
            PG8_WAIT_V(8); PG8_WAIT_L(0); PG8_BAR; PG8_MMA(0, 0, At, B0); PG8_MMA(0, 1, At, B1); PG8_BAR; PG8_SCHED;
            PG8_LDA(At, 0, 1); PG8_STAGE(PG8_SB(0, 0), b2, voffB); PG8_STAGE(PG8_SB(0, 1), b2 + hstep, voffB); PG8_STAGE(PG8_SA(0, 0), a2, voffA);
            PG8_WAIT_V(8); PG8_WAIT_L(0); PG8_BAR; PG8_MMA(1, 0, At, B0); PG8_MMA(1, 1, At, B1); PG8_BAR; PG8_SCHED;
            PG8_LDB(B0, 1, 0); PG8_LDB(B1, 1, 1); PG8_SCHED; PG8_LDA(At, 1, 0); PG8_STAGE(PG8_SA(0, 1), a2 + hstep, voffA);
            PG8_WAIT_V(8); PG8_WAIT_L(0); PG8_BAR; PG8_MMA(0, 0, At, B0); PG8_MMA(0, 1, At, B1); PG8_BAR; PG8_SCHED;
            PG8_LDA(At, 1, 1); PG8_STAGE(PG8_SB(1, 0), b3, voffB); PG8_STAGE(PG8_SB(1, 1), b3 + hstep, voffB); PG8_STAGE(PG8_SA(1, 0), a3, voffA);
            PG8_WAIT_V(8); PG8_WAIT_L(0); PG8_BAR; PG8_MMA(1, 0, At, B0); PG8_MMA(1, 1, At, B1); PG8_BAR; PG8_SCHED;
            } else {
            PG8_LDB(B0, 0, 0); PG8_SCHED; PG8_LDA(At, 0, 0); PG8_STAGE(PG8_SA(1, 1), a1 + hstep, voffA);
            PG8_WAIT_L(8); PG8_BAR; PG8_WAIT_L(0); PG8_MMA(0, 0, At, B0); PG8_BAR; PG8_SCHED;
            PG8_LDB(B1, 0, 1); PG8_STAGE(PG8_SB(0, 0), b2, voffB);
            PG8_BAR; PG8_WAIT_L(0); PG8_MMA(0, 1, At, B1); PG8_BAR;
            PG8_LDA(At, 0, 1); PG8_STAGE(PG8_SA(0, 0), a2, voffA);
            PG8_BAR; PG8_WAIT_L(0); PG8_MMA(1, 0, At, B0); PG8_BAR; PG8_SCHED;
            PG8_STAGE(PG8_SB(0, 1), b2 + hstep, voffB);
            PG8_WAIT_V(6); PG8_BAR; PG8_MMA(1, 1, At, B1); PG8_BAR;
            PG8_LDB(B0, 1, 0); PG8_SCHED; PG8_LDA(At, 1, 0); PG8_STAGE(PG8_SA(0, 1), a2 + hstep, voffA);
            PG8_WAIT_L(8); PG8_BAR; PG8_WAIT_L(0); PG8_MMA(0, 0, At, B0); PG8_BAR; PG8_SCHED;
            PG8_LDB(B1, 1, 1); PG8_STAGE(PG8_SB(1, 0), b3, voffB);
            PG8_BAR; PG8_WAIT_L(0); PG8_MMA(0, 1, At, B1); PG8_BAR;
            PG8_LDA(At, 1, 1); PG8_STAGE(PG8_SA(1, 0), a3, voffA);
            PG8_BAR; PG8_WAIT_L(0); PG8_MMA(1, 0, At, B0); PG8_BAR; PG8_SCHED;
            PG8_STAGE(PG8_SB(1, 1), b3 + hstep, voffB);
            PG8_WAIT_V(6); PG8_BAR; PG8_MMA(1, 1, At, B1); PG8_BAR;
            }
        }
        if constexpr (ALIGN_EPI) { if (wr == 0) PG8_BAR; }
        if constexpr (!Epi::AFTER_DRAIN) { E(acc, cur, wr, wc, fr, fq); S.done(cur); }
        if (!has_next) break;
#pragma unroll
        for (int a = 0; a < 2; ++a)
#pragma unroll
            for (int b = 0; b < 2; ++b)
#pragma unroll
                for (int m = 0; m < 4; ++m)
#pragma unroll
                    for (int n = 0; n < 2; ++n) acc[a][b][m][n] = (f32x4){0.f, 0.f, 0.f, 0.f};
        cur = nxt; cA = nA; cB = nB; ++ui;
        if constexpr (ALIGN_EPI) { if (wr == 1) PG8_BAR; }
    }
    PG8_WAIT_V(0);
    if constexpr (!ALIGN_EPI) { if (wr == 0) PG8_BAR; }
    PG8_BAR;
    if constexpr (Epi::AFTER_DRAIN) { E.fused(acc, cur, wr, wc, fr, fq, lds, wid, lane); S.done(cur); }
#undef PG8_SA
#undef PG8_SB
#undef PG8_STAGE
#undef PG8_LDA
#undef PG8_LDB
#undef PG8_MMA
#undef PG8_WAIT_V
#undef PG8_WAIT_L
#undef PG8_BAR
#undef PG8_SCHED
}
}

#ifndef MK_PER_PHASE
#define MK_PER_PHASE 0
#endif
using pg8::bf16_t; using pg8::bf16x8; using pg8::f32x4; using pg8::u32x4;
typedef float f32x16 __attribute__((ext_vector_type(16)));
typedef unsigned u32x2 __attribute__((ext_vector_type(2)));
#define LAS __attribute__((address_space(3)))
constexpr int M = 16384, D = 1024, SEQ = 8192, NTHR = 512, NPH = 12;
constexpr float EPS = 1e-6f;
constexpr size_t MiB = 1u << 20;
constexpr size_t WS_RSS0 = 0, WS_RSS1 = 65536, WS_VSUM = 131072, WS_VSQ = 196608, WS_RSS2 = 262144;
constexpr size_t WS_APOW = 1 * MiB, WS_A128 = 1 * MiB + 131072, WS_BBT = 1 * MiB + 262144, WS_CCT = 1 * MiB + 524288;
constexpr size_t WS_COS = 2 * MiB, WS_SIN = 6 * MiB, WS_CHS = 10 * MiB;
constexpr size_t WS_WINE = 16 * MiB, WS_WGLU = 28 * MiB, WS_WOUTE = 30 * MiB, WS_WINO = 34 * MiB, WS_WOUTO = 46 * MiB;
constexpr size_t WS_U = 52 * MiB, WS_CAT = 84 * MiB, WS_K = 148 * MiB, WS_V = 180 * MiB, WS_SZB = 212 * MiB, WS_END = 244 * MiB;
constexpr size_t WS_X1 = WS_K;
constexpr int LDS_BYTES = 143360;

struct Args { const float* in[22]; float* out; unsigned char* ws; int ph_lo, ph_hi; };

__device__ __forceinline__ unsigned f2bf(float f) { unsigned u = __builtin_bit_cast(unsigned, f); return (u + 0x7fffu + ((u >> 16) & 1u)) >> 16; }
__device__ __forceinline__ unsigned pk2(float lo, float hi) { return pg8::cvt_pk_bf16(lo, hi); }
__device__ __forceinline__ float bflo(unsigned w) { return __builtin_bit_cast(float, w << 16); }
__device__ __forceinline__ float bfhi(unsigned w) { return __builtin_bit_cast(float, w & 0xffff0000u); }
__device__ __forceinline__ float bf2f(bf16_t b) { return __builtin_bit_cast(float, (unsigned)b << 16); }
__device__ __forceinline__ float fast_rcp(float x) { return __builtin_amdgcn_rcpf(x); }
__device__ __forceinline__ float sigmoidf_(float t) { return fast_rcp(1.f + __builtin_amdgcn_exp2f(-1.4426950408889634f * t)); }
__device__ __forceinline__ float siluf_(float t) { return t * sigmoidf_(t); }
__device__ __forceinline__ float geluf_(float x) { const float u = 0.7978845608028654f * (x + 0.044715f * x * x * x); return x * sigmoidf_(2.f * u); }
__device__ __forceinline__ float wave_sum(float v) {
#pragma unroll
    for (int o = 1; o < 64; o <<= 1) v += __shfl_xor(v, o);
    return v;
}
__device__ __forceinline__ float lg_gamma(int h) { return h == 0 ? -0.04580368961312479f : (h == 1 ? -0.02272007650008353f : (h == 2 ? -0.011315313227834146f : -0.005646563141142063f)); }
__device__ __forceinline__ void sincos_d(double x, double& s, double& c) {
    double t = x * 0.15915494309189535; t -= __builtin_rint(t);
    const double qd = __builtin_rint(4.0 * t); const int q = (int)qd;
    const double r = (t - 0.25 * qd) * 6.283185307179586; const double r2 = r * r;
    double sp = -1.0 / 1307674368000.0; sp = sp * r2 + 1.0 / 6227020800.0; sp = sp * r2 - 1.0 / 39916800.0; sp = sp * r2 + 1.0 / 362880.0; sp = sp * r2 - 1.0 / 5040.0; sp = sp * r2 + 1.0 / 120.0; sp = sp * r2 - 1.0 / 6.0; sp = sp * r2 + 1.0;
    const double sr = sp * r;
    double cp = 1.0 / 20922789888000.0; cp = cp * r2 - 1.0 / 87178291200.0; cp = cp * r2 + 1.0 / 479001600.0; cp = cp * r2 - 1.0 / 3628800.0; cp = cp * r2 + 1.0 / 40320.0; cp = cp * r2 - 1.0 / 720.0; cp = cp * r2 + 1.0 / 24.0; cp = cp * r2 - 0.5; cp = cp * r2 + 1.0;
    const int qq = q & 3;
    if (qq == 0) { s = sr; c = cp; } else if (qq == 1) { s = cp; c = -sr; } else if (qq == 2) { s = -sr; c = -cp; } else { s = -cp; c = sr; }
}

#define EPI_ARGS const f32x4 (&acc)[2][2][4][2], const pg8::Unit& u, int wr, int wc, int fr, int fq
__device__ __forceinline__ void st8bf(bf16_t* p, const float (&v)[8]) { u32x4 w; w.x = pk2(v[0], v[1]); w.y = pk2(v[2], v[3]); w.z = pk2(v[4], v[5]); w.w = pk2(v[6], v[7]); *(u32x4*)p = w; }
__device__ __forceinline__ void ld8bf(const bf16_t* p, float (&v)[8]) { const u32x4 w = *(const u32x4*)p; v[0] = bflo(w.x); v[1] = bfhi(w.x); v[2] = bflo(w.y); v[3] = bfhi(w.y); v[4] = bflo(w.z); v[5] = bfhi(w.z); v[6] = bflo(w.w); v[7] = bfhi(w.w); }
__device__ __forceinline__ void ld8f(const float* p, float (&v)[8]) { const f32x4 a = *(const f32x4*)p, b = *(const f32x4*)(p + 4); v[0] = a.x; v[1] = a.y; v[2] = a.z; v[3] = a.w; v[4] = b.x; v[5] = b.y; v[6] = b.z; v[7] = b.w; }
__device__ __forceinline__ void st8f(float* p, const float (&v)[8]) { *(f32x4*)p = (f32x4){v[0], v[1], v[2], v[3]}; *(f32x4*)(p + 4) = (f32x4){v[4], v[5], v[6], v[7]}; }
#define ACC8(dst, ai, bj, m, sc) do { const f32x4 _a = acc[ai][bj][m][0], _b = acc[ai][bj][m][1]; dst[0] = _a.x * (sc); dst[1] = _a.y * (sc); dst[2] = _a.z * (sc); dst[3] = _a.w * (sc); dst[4] = _b.x * (sc); dst[5] = _b.y * (sc); dst[6] = _b.z * (sc); dst[7] = _b.w * (sc); } while (0)

struct Epi1 {
    static constexpr bool PERM = true, AFTER_DRAIN = false;
    const float* rss; bf16_t* U; bf16_t* CAT; bf16_t* Kb; bf16_t* Vb; bf16_t* SZB; const float* COS; const float* SIN;
    __device__ __forceinline__ void operator()(EPI_ARGS) const {
        const int seg = u.pn >> 2, cb = (u.pn & 3) * 256, colL = wc * 32 + 8 * fq;
        const int row0 = u.pm * 256 + wr * 64 + fr;
#pragma unroll
        for (int ai = 0; ai < 2; ++ai)
#pragma unroll
            for (int m = 0; m < 4; ++m) {
                const int row = row0 + ai * 128 + m * 16;
                const float rs = __builtin_amdgcn_rsqf(rss[row] * (1.f / 1024.f) + EPS);
                if (seg == 2 || seg == 3) {
                    float x1[8], x2[8], cs[8], sn[8], o1[8], o2[8];
                    const float sc = (seg == 3) ? rs * 0.0625f : rs;
                    ACC8(x1, ai, 0, m, sc); ACC8(x2, ai, 1, m, sc);
                    const int pos = row & (SEQ - 1);
                    ld8f(COS + (size_t)pos * 128 + colL, cs); ld8f(SIN + (size_t)pos * 128 + colL, sn);
#pragma unroll
                    for (int j = 0; j < 8; ++j) { o1[j] = x1[j] * cs[j] - x2[j] * sn[j]; o2[j] = x1[j] * sn[j] + x2[j] * cs[j]; }
                    bf16_t* dst = (seg == 2) ? CAT + (size_t)row * 2048 + 1024 + cb + colL : Kb + (size_t)row * 1024 + cb + colL;
                    st8bf(dst, o1); st8bf(dst + 128, o2);
                } else {
#pragma unroll
                    for (int bj = 0; bj < 2; ++bj) {
                        float v[8]; ACC8(v, ai, bj, m, rs);
                        const int col = cb + bj * 128 + colL;
                        if (seg == 1 || seg == 5) {
#pragma unroll
                            for (int j = 0; j < 8; ++j) v[j] = siluf_(v[j]);
                        }
                        bf16_t* dst = (seg == 0) ? U + (size_t)row * 1024 + col : (seg == 1) ? CAT + (size_t)row * 2048 + col : (seg == 4) ? Vb + (size_t)row * 1024 + col : SZB + (size_t)row * 1024 + col;
                        st8bf(dst, v);
                    }
                }
            }
    }
};
struct EpiGlu {
    static constexpr bool PERM = true, AFTER_DRAIN = false;
    const float* bglu; const bf16_t* Y1; bf16_t* CAT;
    __device__ __forceinline__ void operator()(EPI_ARGS) const {
        const int colL = wc * 32 + 8 * fq, row0 = u.pm * 256 + wr * 64 + fr;
#pragma unroll
        for (int bj = 0; bj < 2; ++bj) {
            const int col = u.pn * 256 + bj * 128 + colL;
            float bb[8]; ld8f(bglu + col, bb);
#pragma unroll
            for (int ai = 0; ai < 2; ++ai)
#pragma unroll
                for (int m = 0; m < 4; ++m) {
                    const int row = row0 + ai * 128 + m * 16;
                    float t[8], y[8], z[8]; ACC8(t, ai, bj, m, 1.f);
                    ld8bf(Y1 + (size_t)row * 1024 + col, y); ld8bf(CAT + (size_t)row * 2048 + col, z);
#pragma unroll
                    for (int j = 0; j < 8; ++j) t[j] = y[j] * sigmoidf_(t[j] + bb[j]) * z[j];
                    st8bf(CAT + (size_t)row * 2048 + col, t);
                }
        }
    }
};
struct EpiOut {
    static constexpr bool PERM = true, AFTER_DRAIN = false;
    const float* Xi; float* Xo; bf16_t* XG; const float* g; float* rss;
    __device__ __forceinline__ void operator()(EPI_ARGS) const {
        const int colL = wc * 32 + 8 * fq, row0 = u.pm * 256 + wr * 64 + fr;
#pragma unroll
        for (int ai = 0; ai < 2; ++ai)
#pragma unroll
            for (int m = 0; m < 4; ++m) {
                const int row = row0 + ai * 128 + m * 16; float ss = 0.f;
#pragma unroll
                for (int bj = 0; bj < 2; ++bj) {
                    const int col = u.pn * 256 + bj * 128 + colL;
                    float a[8], x[8]; ACC8(a, ai, bj, m, 1.f); ld8f(Xi + (size_t)row * 1024 + col, x);
#pragma unroll
                    for (int j = 0; j < 8; ++j) { x[j] += a[j]; ss += x[j] * x[j]; }
                    st8f(Xo + (size_t)row * 1024 + col, x);
                    if (XG) { float gg[8]; ld8f(g + col, gg);
#pragma unroll
                        for (int j = 0; j < 8; ++j) x[j] *= gg[j];
                        st8bf(XG + (size_t)row * 1024 + col, x); }
                }
                ss += __shfl_xor(ss, 16); ss += __shfl_xor(ss, 32);
                if (fq == 0) atomicAdd(rss + row, ss);
            }
    }
};
struct Epi7 {
    static constexpr bool PERM = true, AFTER_DRAIN = false;
    const float* rss; bf16_t* VB; float* vsum; float* vsq;
    __device__ __forceinline__ void operator()(EPI_ARGS) const {
        const int colL = wc * 32 + 8 * fq, row0 = u.pm * 256 + wr * 64 + fr;
#pragma unroll
        for (int ai = 0; ai < 2; ++ai)
#pragma unroll
            for (int m = 0; m < 4; ++m) {
                const int row = row0 + ai * 128 + m * 16; float s = 0.f, q = 0.f;
                const float rs = __builtin_amdgcn_rsqf(rss[row] * (1.f / 1024.f) + EPS);
#pragma unroll
                for (int bj = 0; bj < 2; ++bj) {
                    const int col = u.pn * 256 + bj * 128 + colL;
                    float v[8]; ACC8(v, ai, bj, m, rs);
#pragma unroll
                    for (int j = 0; j < 8; ++j) { v[j] = geluf_(v[j]); s += v[j]; q += v[j] * v[j]; }
                    st8bf(VB + (size_t)row * 2048 + col, v);
                }
                s += __shfl_xor(s, 16); s += __shfl_xor(s, 32); q += __shfl_xor(q, 16); q += __shfl_xor(q, 32);
                if (fq == 0) { atomicAdd(vsum + row, s); atomicAdd(vsq + row, q); }
            }
    }
};
struct Epi9 {
    static constexpr bool PERM = true, AFTER_DRAIN = false;
    const float* rss; const bf16_t* SB; bf16_t* Y;
    __device__ __forceinline__ void operator()(EPI_ARGS) const {
        const int colL = wc * 32 + 8 * fq, row0 = u.pm * 256 + wr * 64 + fr, col = u.pn * 128 + colL;
#pragma unroll
        for (int ai = 0; ai < 2; ++ai)
#pragma unroll
            for (int m = 0; m < 4; ++m) {
                const int row = row0 + ai * 128 + m * 16;
                const float rs = __builtin_amdgcn_rsqf(rss[row] * (1.f / 1024.f) + EPS);
                float uu[8], zz[8], s[8]; ACC8(uu, ai, 0, m, rs); ACC8(zz, ai, 1, m, rs); ld8bf(SB + (size_t)row * 2048 + col, s);
#pragma unroll
                for (int j = 0; j < 8; ++j) uu[j] = geluf_(uu[j]) * s[j] * siluf_(zz[j]);
                st8bf(Y + (size_t)row * 2048 + col, uu);
            }
    }
};

__device__ __forceinline__ void p0_transpose_item(const float* W, int K, int N, bf16_t* WT, int row_off, LAS float* scr, int kb, int nb, int lane) {
    const int k0 = 64 * kb, n0 = 32 * nb;
#pragma unroll 8
    for (int i = 0; i < 32; ++i) { const int kk = 2 * i + (lane >> 5); scr[kk * 33 + (lane & 31)] = W[(size_t)(k0 + kk) * N + n0 + (lane & 31)]; }
    asm volatile("s_waitcnt lgkmcnt(0)" ::: "memory");
    const int c = lane & 7;
#pragma unroll
    for (int j = 0; j < 4; ++j) { const int n = (lane >> 3) + 8 * j; const LAS float* s = scr + (8 * c) * 33 + n;
        u32x4 o; o.x = pk2(s[0 * 33], s[1 * 33]); o.y = pk2(s[2 * 33], s[3 * 33]); o.z = pk2(s[4 * 33], s[5 * 33]); o.w = pk2(s[6 * 33], s[7 * 33]);
        *(u32x4*)(WT + (size_t)(row_off + n0 + n) * K + k0 + 8 * c) = o; }
    asm volatile("s_waitcnt lgkmcnt(0)" ::: "memory");
}
__device__ __forceinline__ int wino_row(int n) {
    if (n < 2048) return 2048 + 256 * (n >> 7) + (n & 127);
    if (n < 4096) return n - 2048;
    const int z = n - 4096; return 2048 + 256 * (z >> 7) + 128 + (z & 127);
}

template <bool FINAL>
__device__ __forceinline__ void s5_item(int b, int c, int g, bf16_t* U, float* CHS, const float* APOW, const bf16_t* BBT, const bf16_t* CCT, const float* dsk, LAS unsigned char* wlds, int lane) {
    const int h = lane >> 5, r = lane & 31;
    const size_t row0 = (size_t)b * SEQ + (size_t)c * 128;
    bf16x8 bfrag[4];
#pragma unroll
    for (int nt = 0; nt < 4; ++nt) bfrag[nt] = *(const bf16x8*)(BBT + ((size_t)(g * 128 + nt * 32 + r) * 16 + 8 * h));
    float ar[2][4], ai_[2][4], cr[2], ci[2];
#pragma unroll
    for (int ph = 0; ph < 2; ++ph) {
        const int p = 32 * ph + r; const f32x4 w0 = *(const f32x4*)(APOW + (size_t)(g * 64 + p) * 8), w1 = *(const f32x4*)(APOW + (size_t)(g * 64 + p) * 8 + 4);
        ar[ph][0] = w0.x; ai_[ph][0] = w0.y; ar[ph][1] = w0.z; ai_[ph][1] = w0.w; ar[ph][2] = w1.x; ai_[ph][2] = w1.y; ar[ph][3] = w1.z; ai_[ph][3] = w1.w;
        if (FINAL) { const float* cp = CHS + ((size_t)((b * 64 + c) * 64 + g) * 64 + p) * 2; cr[ph] = cp[0]; ci[ph] = cp[1]; } else { cr[ph] = 0.f; ci[ph] = 0.f; }
    }
    bf16x8 cfrag[4];
    if (FINAL) {
#pragma unroll
        for (int ks = 0; ks < 4; ++ks) cfrag[ks] = *(const bf16x8*)(CCT + ((size_t)(g * 16 + (lane & 15)) * 128 + ks * 32 + 8 * (lane >> 4)));
    }
    const float dk = FINAL ? dsk[g * 16 + (lane & 15)] : 0.f;
    for (int sb = 0; sb < 4; ++sb) {
        const bf16x8 afrag = *(const bf16x8*)(U + (row0 + sb * 32 + r) * 1024 + g * 16 + 8 * h);
        f32x16 re[2], im[2];
        const f32x16 zero16 = {0.f, 0.f, 0.f, 0.f, 0.f, 0.f, 0.f, 0.f, 0.f, 0.f, 0.f, 0.f, 0.f, 0.f, 0.f, 0.f};
        re[0] = __builtin_amdgcn_mfma_f32_32x32x16_bf16(afrag, bfrag[0], zero16, 0, 0, 0);
        re[1] = __builtin_amdgcn_mfma_f32_32x32x16_bf16(afrag, bfrag[1], zero16, 0, 0, 0);
        im[0] = __builtin_amdgcn_mfma_f32_32x32x16_bf16(afrag, bfrag[2], zero16, 0, 0, 0);
        im[1] = __builtin_amdgcn_mfma_f32_32x32x16_bf16(afrag, bfrag[3], zero16, 0, 0, 0);
#pragma unroll
        for (int ph = 0; ph < 2; ++ph) {
            const float a1r = ar[ph][0], a1i = ai_[ph][0], a4r = ar[ph][3], a4i = ai_[ph][3];
#pragma unroll
            for (int q = 0; q < 4; ++q) {
#pragma unroll
                for (int j = 1; j < 4; ++j) { const int i = 4 * q + j; const float pr = re[ph][i - 1], pi = im[ph][i - 1];
                    re[ph][i] += a1r * pr - a1i * pi; im[ph][i] += a1r * pi + a1i * pr; }
            }
#pragma unroll
            for (int q = 0; q < 4; ++q) {
                const float Er = re[ph][4 * q + 3], Ei = im[ph][4 * q + 3];
                const float Xr = Er + a4r * cr[ph] - a4i * ci[ph], Xi = Ei + a4r * ci[ph] + a4i * cr[ph];
                const float Xor_ = __shfl_xor(Xr, 32), Xoi = __shfl_xor(Xi, 32);
                const float cinr = h ? Xor_ : cr[ph], cini = h ? Xoi : ci[ph];
                const float Yr = Er + a4r * cinr - a4i * cini, Yi = Ei + a4r * cini + a4i * cinr;
                const float Yor = __shfl_xor(Yr, 32), Yoi = __shfl_xor(Yi, 32);
                if (FINAL) {
#pragma unroll
                    for (int j = 0; j < 4; ++j) { const int i = 4 * q + j; re[ph][i] += ar[ph][j] * cinr - ai_[ph][j] * cini; im[ph][i] += ar[ph][j] * cini + ai_[ph][j] * cinr; }
                }
                cr[ph] = h ? Yr : Yor; ci[ph] = h ? Yi : Yoi;
            }
        }
        if (FINAL) {
#pragma unroll
            for (int ph = 0; ph < 2; ++ph)
#pragma unroll
                for (int i = 0; i < 16; ++i) { const int tok = (i & 3) + 8 * (i >> 2) + 4 * h; const int p = 32 * ph + r;
                    *(LAS unsigned*)(wlds + tok * 272 + 4 * p) = pk2(re[ph][i], im[ph][i]); }
            asm volatile("s_waitcnt lgkmcnt(0)" ::: "memory");
            f32x4 yacc[2] = {(f32x4){0.f, 0.f, 0.f, 0.f}, (f32x4){0.f, 0.f, 0.f, 0.f}};
#pragma unroll
            for (int mt = 0; mt < 2; ++mt)
#pragma unroll
                for (int ks = 0; ks < 4; ++ks) { const bf16x8 a = *(const LAS bf16x8*)(wlds + (mt * 16 + (lane & 15)) * 272 + (ks * 32 + 8 * (lane >> 4)) * 2);
                    yacc[mt] = __builtin_amdgcn_mfma_f32_16x16x32_bf16(a, cfrag[ks], yacc[mt], 0, 0, 0); }
            asm volatile("s_waitcnt lgkmcnt(0)" ::: "memory");
#pragma unroll
            for (int mt = 0; mt < 2; ++mt)
#pragma unroll
                for (int j = 0; j < 4; ++j) { const size_t row = row0 + sb * 32 + mt * 16 + 4 * (lane >> 4) + j; const bf16_t* pu = U + row * 1024 + g * 16 + (lane & 15);
                    const float y = yacc[mt][j] + dk * bf2f(*pu); U[row * 1024 + g * 16 + (lane & 15)] = (bf16_t)f2bf(geluf_(y)); }
        }
    }
    if (!FINAL && h == 0) {
#pragma unroll
        for (int ph = 0; ph < 2; ++ph) { float* cp = CHS + ((size_t)((b * 64 + c) * 64 + g) * 64 + 32 * ph + r) * 2; cp[0] = cr[ph]; cp[1] = ci[ph]; }
    }
}

__device__ __forceinline__ bf16x8 gather8(const LAS bf16_t* p, int pitch) {
    bf16x8 v;
#pragma unroll
    for (int j = 0; j < 8; ++j) v[j] = (short)p[j * pitch];
    return v;
}
#define MFMA32(a, b, c) __builtin_amdgcn_mfma_f32_32x32x16_bf16((a), (b), (c), 0, 0, 0)
#define ZERO16 ((f32x16){0.f, 0.f, 0.f, 0.f, 0.f, 0.f, 0.f, 0.f, 0.f, 0.f, 0.f, 0.f, 0.f, 0.f, 0.f, 0.f})

__global__ void __launch_bounds__(NTHR, 2) mk_fwd(Args args) {
    extern __shared__ __attribute__((aligned(16))) unsigned char lds_raw[];
    LAS unsigned char* lds = (LAS unsigned char*)lds_raw;
    cg::grid_group grid = cg::this_grid();
    const int tid = threadIdx.x, lane = tid & 63, wid = __builtin_amdgcn_readfirstlane(tid >> 6);
    const int G = gridDim.x, bid = blockIdx.x;
    const int gw = bid * 8 + wid, NGW = G * 8;
    const int gtid = bid * NTHR + tid, NGT = G * NTHR;
    unsigned char* ws = args.ws;
    const float* x = args.in[0];
    float* RSS0 = (float*)(ws + WS_RSS0); float* RSS1 = (float*)(ws + WS_RSS1); float* VSUM = (float*)(ws + WS_VSUM); float* VSQ = (float*)(ws + WS_VSQ); float* RSS2 = (float*)(ws + WS_RSS2);
    float* APOW = (float*)(ws + WS_APOW); float* A128 = (float*)(ws + WS_A128); bf16_t* BBT = (bf16_t*)(ws + WS_BBT); bf16_t* CCT = (bf16_t*)(ws + WS_CCT);
    float* COS = (float*)(ws + WS_COS); float* SIN = (float*)(ws + WS_SIN); float* CHS = (float*)(ws + WS_CHS);
    bf16_t* WINE = (bf16_t*)(ws + WS_WINE); bf16_t* WGLU = (bf16_t*)(ws + WS_WGLU); bf16_t* WOUTE = (bf16_t*)(ws + WS_WOUTE); bf16_t* WINO = (bf16_t*)(ws + WS_WINO); bf16_t* WOUTO = (bf16_t*)(ws + WS_WOUTO);
    bf16_t* U = (bf16_t*)(ws + WS_U); bf16_t* CAT = (bf16_t*)(ws + WS_CAT); bf16_t* Kb = (bf16_t*)(ws + WS_K); bf16_t* Vb = (bf16_t*)(ws + WS_V); bf16_t* SZB = (bf16_t*)(ws + WS_SZB);
    float* X1 = (float*)(ws + WS_X1);
    bf16_t* XG0 = (bf16_t*)args.out;
    bf16_t* STATE = (bf16_t*)args.out;
    bf16_t* VB = (bf16_t*)args.out;
    const int lo = args.ph_lo, hi = args.ph_hi;
#ifndef PHMASK
#define PHMASK 0xFFF
#endif
#define IN(k) (((PHMASK >> (k)) & 1) && lo <= (k) && (k) < hi)
#define SEAM(k) do { if (IN(k) && IN((k) + 1)) grid.sync(); } while (0)
#ifndef PROBE_REP
#define PROBE_REP (-1)
#endif
#define PROBE_BEGIN(k) for (int pass = (PROBE_REP == (k)) ? 0 : 1; pass < 2; ++pass) { const bool dummy = (pass == 0); const size_t omask = dummy ? (size_t)2047 : ~(size_t)0; (void)omask;
#define PROBE_END if (pass == 0) grid.sync(); }
    bf16_t* DUMMY = (bf16_t*)(ws + WS_END);

    if (IN(0)) {
        LAS float* scr = (LAS float*)(lds + wid * 16384);
        constexpr int I_INE = 16 * 192, I_GLU = 16 * 32, I_OUTE = 32 * 32, I_INO = 16 * 192, I_OUTO = 32 * 32;
        constexpr int NIT = I_INE + I_GLU + I_OUTE + I_INO + I_OUTO;
        for (int it = gw; it < NIT; it += NGW) {
            int rr = it;
            if (rr < I_INE) { p0_transpose_item(args.in[2], 1024, 6144, WINE, 0, scr, rr / 192, rr % 192, lane); continue; } rr -= I_INE;
            if (rr < I_GLU) { p0_transpose_item(args.in[11], 1024, 1024, WGLU, 0, scr, rr / 32, rr % 32, lane); continue; } rr -= I_GLU;
            if (rr < I_OUTE) { p0_transpose_item(args.in[14], 2048, 1024, WOUTE, 0, scr, rr / 32, rr % 32, lane); continue; } rr -= I_OUTE;
            if (rr < I_INO) { const int nb = rr % 192; p0_transpose_item(args.in[16], 1024, 6144, WINO, wino_row(32 * nb) - 32 * nb, scr, rr / 192, nb, lane); continue; } rr -= I_INO;
            p0_transpose_item(args.in[20], 2048, 1024, WOUTO, 0, scr, rr / 32, rr % 32, lane);
        }
        for (int m = gw; m < M; m += NGW) {
            const f32x4* xr = (const f32x4*)(x + (size_t)m * D) + lane; const f32x4* gr = (const f32x4*)args.in[1] + lane;
            float s = 0.f; u32x2* o8 = (u32x2*)(XG0 + (size_t)m * D) + lane;
#pragma unroll
            for (int j = 0; j < 4; ++j) { const f32x4 v = xr[64 * j], gg = gr[64 * j]; s += (v.x * v.x + v.y * v.y) + (v.z * v.z + v.w * v.w);
                u32x2 w; w.x = pk2(v.x * gg.x, v.y * gg.y); w.y = pk2(v.z * gg.z, v.w * gg.w); o8[64 * j] = w; }
            s = wave_sum(s); if (lane == 0) RSS0[m] = s;
        }
        for (int e = gtid; e < SEQ * 128; e += NGT) { const int pos = e >> 7, i = e & 127;
            const double inv = exp(-(double)i * (9.210340371976184 / 128.0)); double s, c; sincos_d((double)pos * inv, s, c); COS[e] = (float)c; SIN[e] = (float)s; }
        for (int e = gtid; e < 4096; e += NGT) { const int g = e >> 6, p = e & 63;
            const double lr = fmin((double)args.in[3][e], -1e-4), li = (double)args.in[4][e], dt = exp((double)args.in[5][g]);
            const double mag = exp(lr * dt); double sn, cs; sincos_d(li * dt, sn, cs);
            const double abr = mag * cs, abi = mag * sn, den = lr * lr + li * li, nr = abr - 1.0, ni = abi;
            const double zr = (nr * lr + ni * li) / den, zi = (ni * lr - nr * li) / den;
            double pr = abr, pi = abi;
#pragma unroll
            for (int k = 0; k < 4; ++k) { APOW[e * 8 + 2 * k] = (float)pr; APOW[e * 8 + 2 * k + 1] = (float)pi; const double t = pr * abr - pi * abi; pi = pr * abi + pi * abr; pr = t; }
            double qr = abr, qi = abi;
#pragma unroll
            for (int k = 0; k < 7; ++k) { const double t = qr * qr - qi * qi; qi = 2.0 * qr * qi; qr = t; }
            A128[e * 2] = (float)qr; A128[e * 2 + 1] = (float)qi;
            const float* br = args.in[6] + (size_t)e * 16; const float* bi = args.in[7] + (size_t)e * 16;
#pragma unroll
            for (int k = 0; k < 16; ++k) { const double b_r = br[k], b_i = bi[k];
                BBT[(size_t)(g * 128 + p) * 16 + k] = (bf16_t)f2bf((float)(zr * b_r - zi * b_i)); BBT[(size_t)(g * 128 + 64 + p) * 16 + k] = (bf16_t)f2bf((float)(zr * b_i + zi * b_r)); }
#pragma unroll
            for (int hh = 0; hh < 16; ++hh) { const float c_r = args.in[8][(size_t)(g * 16 + hh) * 64 + p], c_i = args.in[9][(size_t)(g * 16 + hh) * 64 + p];
                CCT[(size_t)(g * 16 + hh) * 128 + 2 * p] = (bf16_t)f2bf(c_r); CCT[(size_t)(g * 16 + hh) * 128 + 2 * p + 1] = (bf16_t)f2bf(-c_i); }
        }
        for (int e = gtid; e < M; e += NGT) { RSS1[e] = 0.f; VSUM[e] = 0.f; VSQ[e] = 0.f; RSS2[e] = 0.f; }
        __syncthreads();
    }
    SEAM(0);
    if (IN(1)) {
        pg8::Gemm g{XG0, WINE, M, 6144, 1024}; pg8::StaticOrder S; S.init(M, 6144, G, bid);
        Epi1 E{RSS0, U, CAT, Kb, Vb, SZB, COS, SIN};
        pg8::gemm_phase<Epi1, pg8::StaticOrder, true, true>(lds, g, S, E);
    }
    SEAM(1);
    if (IN(2)) {
        for (int it = gw; it < 2 * 64 * 64; it += NGW) { const int g = it & 63, c = (it >> 6) & 63, b = it >> 12;
            s5_item<false>(b, c, g, U, CHS, APOW, BBT, CCT, args.in[10], lds + wid * 8704, lane); }
        __syncthreads();
        LAS bf16_t* Vs = (LAS bf16_t*)lds; LAS bf16_t* Ks = (LAS bf16_t*)(lds + 34816);
        const int wm = wid >> 1, wn = wid & 1, h5_ = lane >> 5, r_ = lane & 31;
        u32x4 pv[4], pk[4];
#define RA_LOAD(IT) do { const int kt_ = (IT) & 1, vt_ = ((IT) >> 1) & 1, hh_ = ((IT) >> 2) & 3, c_ = ((IT) >> 4) & 63, b_ = (IT) >> 10; const size_t rw0 = (size_t)b_ * SEQ + (size_t)c_ * 128; \
            _Pragma("unroll") for (int i = 0; i < 4; ++i) { const int idx = tid + NTHR * i, row = idx >> 4, ch = idx & 15; \
                pv[i] = *(const u32x4*)(Vb + (rw0 + row) * 1024 + hh_ * 256 + vt_ * 128 + ch * 8); pk[i] = *(const u32x4*)(Kb + (rw0 + row) * 1024 + hh_ * 256 + kt_ * 128 + ch * 8); } } while (0)
        if (bid < 2048) RA_LOAD(bid);
        for (int it = bid; it < 2048; it += G) {
            const int kt = it & 1, vt = (it >> 1) & 1, hh = (it >> 2) & 3, c = (it >> 4) & 63, b = it >> 10;
            const float lg = lg_gamma(hh);
            int h5 = h5_, r = r_; asm volatile("" : "+v"(h5), "+v"(r));
#pragma unroll
            for (int i = 0; i < 4; ++i) { const int idx = tid + NTHR * i, row = idx >> 4, ch = idx & 15;
                const float z = __builtin_amdgcn_exp2f((float)(127 - row) * lg); const u32x4 w = pv[i]; u32x4 o;
                o.x = pk2(bflo(w.x) * z, bfhi(w.x) * z); o.y = pk2(bflo(w.y) * z, bfhi(w.y) * z); o.z = pk2(bflo(w.z) * z, bfhi(w.z) * z); o.w = pk2(bflo(w.w) * z, bfhi(w.w) * z);
                *(LAS u32x4*)(Vs + row * 136 + ch * 8) = o; *(LAS u32x4*)(Ks + row * 136 + ch * 8) = pk[i]; }
            __syncthreads();
            if (it + G < 2048) RA_LOAD(it + G);
            f32x16 acc[2] = {ZERO16, ZERO16};
#pragma unroll 4
            for (int ks = 0; ks < 8; ++ks) { const int m0 = 16 * ks + 8 * h5;
                const bf16x8 a = gather8(Vs + m0 * 136 + 32 * wm + r, 136);
#pragma unroll
                for (int nt = 0; nt < 2; ++nt) { const bf16x8 bb = gather8(Ks + m0 * 136 + 64 * wn + 32 * nt + r, 136); acc[nt] = MFMA32(bb, a, acc[nt]); } }
            bf16_t* dst = STATE + ((size_t)((b * 64 + c) * 4 + hh) * 256 + vt * 128 + 32 * wm + r) * 256 + kt * 128 + 64 * wn + 4 * h5;
#pragma unroll
            for (int nt = 0; nt < 2; ++nt)
#pragma unroll
                for (int iq = 0; iq < 4; ++iq) { u32x2 w; w.x = pk2(acc[nt][4 * iq], acc[nt][4 * iq + 1]); w.y = pk2(acc[nt][4 * iq + 2], acc[nt][4 * iq + 3]); *(u32x2*)(dst + 32 * nt + 8 * iq) = w; }
            __syncthreads();
        }
#undef RA_LOAD
    }
    SEAM(2);
    if (IN(3)) {
        for (int e = gtid; e < 131072; e += NGT) { const int bh = e >> 14, idx4 = e & 16383, b = bh >> 2, hh = bh & 3;
            const float cd = __builtin_amdgcn_exp2f(128.f * lg_gamma(hh)); float s0 = 0.f, s1 = 0.f, s2 = 0.f, s3 = 0.f;
            u32x2* p = (u32x2*)(STATE + ((size_t)(b * 64) * 4 + hh) * 65536 + (size_t)idx4 * 4);
#pragma unroll 8
            for (int c = 0; c < 64; ++c) { u32x2* q = p + (size_t)c * (4 * 65536 / 4); const u32x2 w = *q;
                u32x2 o; o.x = pk2(s0, s1); o.y = pk2(s2, s3); *q = o;
                s0 = s0 * cd + bflo(w.x); s1 = s1 * cd + bfhi(w.x); s2 = s2 * cd + bflo(w.y); s3 = s3 * cd + bfhi(w.y); } }
        for (int e = gtid; e < 8192; e += NGT) { const int b = e >> 12, gp = e & 4095; const float ar = A128[gp * 2], ai = A128[gp * 2 + 1]; float cr = 0.f, ci = 0.f;
            for (int c = 0; c < 64; ++c) { float* q = CHS + ((size_t)(b * 64 + c) * 4096 + gp) * 2; const float lr_ = q[0], li_ = q[1]; q[0] = cr; q[1] = ci;
                const float t = ar * cr - ai * ci + lr_; ci = ar * ci + ai * cr + li_; cr = t; } }
    }
    SEAM(3);
    if (IN(4)) {
        for (int it = gw; it < 2 * 64 * 64; it += NGW) { const int g = it & 63, c = (it >> 6) & 63, b = it >> 12;
            s5_item<true>(b, c, g, U, CHS, APOW, BBT, CCT, args.in[10], lds + wid * 8704, lane); }
        __syncthreads();
        LAS bf16_t* Qs = (LAS bf16_t*)lds; LAS bf16_t* Ks = (LAS bf16_t*)(lds + 67584); LAS bf16_t* Ps = (LAS bf16_t*)(lds + 67584); LAS bf16_t* Xs = (LAS bf16_t*)(lds + 67584 + 34816);
        LAS float* red = (LAS float*)lds;
        const int wm = wid >> 1, wn = wid & 1, h5_ = lane >> 5, r_ = lane & 31;
        const float* gain = args.in[13];
#define OPQ() asm volatile("" : "+v"(h5), "+v"(r))
        for (int it = bid; it < 512; it += G) {
            const int hh = it & 3, c = (it >> 2) & 63, b = it >> 8;
            const size_t row0 = (size_t)b * SEQ + (size_t)c * 128; const float lg = lg_gamma(hh);
            int h5 = h5_, r = r_; OPQ();
#pragma unroll 4
            for (int i = 0; i < 8; ++i) { const int idx = tid + NTHR * i, row = idx >> 5, ch = idx & 31;
                *(LAS u32x4*)(Qs + row * 264 + ch * 8) = *(const u32x4*)(CAT + (row0 + row) * 2048 + 1024 + hh * 256 + ch * 8);
                *(LAS u32x4*)(Ks + row * 264 + ch * 8) = *(const u32x4*)(Kb + (row0 + row) * 1024 + hh * 256 + ch * 8); }
            __syncthreads();
            u32x4 pvv[4], pc[2];
#define RC_LOADV(VH) do { _Pragma("unroll") for (int i = 0; i < 4; ++i) { const int idx = tid + NTHR * i, row = idx >> 4, ch = idx & 15; pvv[i] = *(const u32x4*)(Vb + (row0 + row) * 1024 + hh * 256 + (VH) * 128 + ch * 8); } } while (0)
#define RC_STOREV() do { _Pragma("unroll") for (int i = 0; i < 4; ++i) { const int idx = tid + NTHR * i, row = idx >> 4, ch = idx & 15; *(LAS u32x4*)(Xs + row * 136 + ch * 8) = pvv[i]; } } while (0)
#define RC_LOADC(STP, KC) do { _Pragma("unroll") for (int i = 0; i < 2; ++i) { const int idx = tid + NTHR * i, row = idx >> 3, ch = idx & 7; pc[i] = *(const u32x4*)((STP) + (size_t)row * 256 + (KC) * 64 + ch * 8); } } while (0)
#define RC_STOREC() do { _Pragma("unroll") for (int i = 0; i < 2; ++i) { const int idx = tid + NTHR * i, row = idx >> 3, ch = idx & 7; *(LAS u32x4*)(Xs + row * 72 + ch * 8) = pc[i]; } } while (0)
            RC_LOADV(0);
            f32x16 sacc[2] = {ZERO16, ZERO16};
#pragma unroll 4
            for (int ks = 0; ks < 16; ++ks) { const int k0 = 16 * ks + 8 * h5;
                const bf16x8 a = *(const LAS bf16x8*)(Qs + (32 * wm + r) * 264 + k0);
#pragma unroll
                for (int nt = 0; nt < 2; ++nt) { const bf16x8 bb = *(const LAS bf16x8*)(Ks + (64 * wn + 32 * nt + r) * 264 + k0); sacc[nt] = MFMA32(bb, a, sacc[nt]); } }
            __syncthreads();
            OPQ();
            { const int n = 32 * wm + r;
#pragma unroll
              for (int nt = 0; nt < 2; ++nt)
#pragma unroll
                for (int iq = 0; iq < 4; ++iq) { const int m0 = 64 * wn + 32 * nt + 8 * iq + 4 * h5; float pvl[4];
#pragma unroll
                    for (int j = 0; j < 4; ++j) { const int mc = m0 + j; pvl[j] = (n >= mc) ? sacc[nt][4 * iq + j] * __builtin_amdgcn_exp2f(-(float)(mc + 1) * lg) : 0.f; }
                    u32x2 w; w.x = pk2(pvl[0], pvl[1]); w.y = pk2(pvl[2], pvl[3]); *(LAS u32x2*)(Ps + n * 136 + m0) = w; } }
            RC_STOREV();
            __syncthreads();
            f32x16 oacc[2][2] = {{ZERO16, ZERO16}, {ZERO16, ZERO16}};
#pragma unroll
            for (int vh = 0; vh < 2; ++vh) {
                OPQ();
                const bf16_t* st = STATE + ((size_t)((b * 64 + c) * 4 + hh) * 256 + vh * 128) * 256;
                RC_LOADC(st, 0);
#pragma unroll 2
                for (int ks = 0; ks < 8; ++ks) { const int m0 = 16 * ks + 8 * h5;
                    const bf16x8 a = *(const LAS bf16x8*)(Ps + (32 * wm + r) * 136 + m0);
#pragma unroll
                    for (int nt = 0; nt < 2; ++nt) { const bf16x8 bb = gather8(Xs + m0 * 136 + 64 * wn + 32 * nt + r, 136); oacc[vh][nt] = MFMA32(bb, a, oacc[vh][nt]); } }
#pragma unroll 1
                for (int kc = 0; kc < 4; ++kc) {
                    __syncthreads();
                    RC_STOREC();
                    __syncthreads();
                    if (kc < 3) RC_LOADC(st, kc + 1); else if (vh == 0) RC_LOADV(1);
#pragma unroll
                    for (int ks = 0; ks < 4; ++ks) { const int k0 = 16 * ks + 8 * h5;
                        const bf16x8 a = *(const LAS bf16x8*)(Qs + (32 * wm + r) * 264 + kc * 64 + k0);
#pragma unroll
                        for (int nt = 0; nt < 2; ++nt) { const bf16x8 bb = *(const LAS bf16x8*)(Xs + (64 * wn + 32 * nt + r) * 72 + k0); oacc[vh][nt] = MFMA32(bb, a, oacc[vh][nt]); } }
                }
                __syncthreads();
                if (vh == 0) { RC_STOREV(); __syncthreads(); }
            }
            OPQ();
            const int n = 32 * wm + r; const float xi = __builtin_amdgcn_exp2f((float)(n + 1) * lg);
            float s = 0.f, q = 0.f;
#pragma unroll
            for (int vh = 0; vh < 2; ++vh)
#pragma unroll
                for (int nt = 0; nt < 2; ++nt)
#pragma unroll
                    for (int i = 0; i < 16; ++i) { const float o = oacc[vh][nt][i] * xi; oacc[vh][nt][i] = o; s += o; q += o * o; }
            s += __shfl_xor(s, 32); q += __shfl_xor(q, 32);
            if (h5 == 0) { red[(wn * 128 + n) * 2] = s; red[(wn * 128 + n) * 2 + 1] = q; }
            __syncthreads();
            OPQ();
            { const float st_ = red[n * 2] + red[(128 + n) * 2], qt = red[n * 2 + 1] + red[(128 + n) * 2 + 1];
              const float mu = st_ * (1.f / 256.f), var = fmaxf(qt * (1.f / 256.f) - mu * mu, 0.f), rstd = __builtin_amdgcn_rsqf(var + EPS);
#pragma unroll
              for (int vh = 0; vh < 2; ++vh)
#pragma unroll
                for (int nt = 0; nt < 2; ++nt)
#pragma unroll
                    for (int iq = 0; iq < 4; ++iq) { const int col = hh * 256 + vh * 128 + 64 * wn + 32 * nt + 8 * iq + 4 * h5;
                        const f32x4 gv = *(const f32x4*)(gain + col); const u32x2 zz = *(const u32x2*)(SZB + (row0 + n) * 1024 + col);
                        const float y0 = (oacc[vh][nt][4 * iq] - mu) * rstd * gv.x * bflo(zz.x), y1 = (oacc[vh][nt][4 * iq + 1] - mu) * rstd * gv.y * bfhi(zz.x);
                        const float y2 = (oacc[vh][nt][4 * iq + 2] - mu) * rstd * gv.z * bflo(zz.y), y3 = (oacc[vh][nt][4 * iq + 3] - mu) * rstd * gv.w * bfhi(zz.y);
                        u32x2 w; w.x = pk2(y0, y1); w.y = pk2(y2, y3); *(u32x2*)(CAT + (row0 + n) * 2048 + 1024 + col) = w; } }
            __syncthreads();
        }
#undef RC_LOADV
#undef RC_STOREV
#undef RC_LOADC
#undef RC_STOREC
    }
    SEAM(4);
    if (IN(5)) {
        pg8::Gemm g{U, WGLU, M, 1024, 1024}; pg8::StaticOrder S; S.init(M, 1024, G, bid);
        EpiGlu E{args.in[12], U, CAT};
        pg8::gemm_phase<EpiGlu, pg8::StaticOrder, true, true>(lds, g, S, E);
    }
    SEAM(5);
    if (IN(6)) {
        pg8::Gemm g{CAT, WOUTE, M, 1024, 2048}; pg8::StaticOrder S; S.init(M, 1024, G, bid);
        EpiOut E{x, X1, U, args.in[15], RSS1};
        pg8::gemm_phase<EpiOut, pg8::StaticOrder, true, true>(lds, g, S, E);
    }
    SEAM(6);
    if (IN(7)) {
        pg8::Gemm g{U, WINO, M, 2048, 1024}; pg8::StaticOrder S; S.init(M, 2048, G, bid);
        Epi7 E{RSS1, VB, VSUM, VSQ};
        pg8::gemm_phase<Epi7, pg8::StaticOrder, true, true>(lds, g, S, E);
    }
    SEAM(7);
    if (IN(8)) {
        LAS bf16_t* Wsm = (LAS bf16_t*)lds; LAS bf16_t* Vs = (LAS bf16_t*)(lds + 34816);
        const int wm = wid >> 1, wn = wid & 1, h5_ = lane >> 5, r_ = lane & 31;
        const float* vgain = args.in[17]; const float* wsp = args.in[18]; const float* bsp = args.in[19];
        u32x4 pvv[4]; f32x4 pw[4][2], pg[2]; float psum[4], psq[4];
#define SG_LOAD(IT) do { const int ds_ = (IT) & 3, gg_ = ((IT) >> 2) & 3, c_ = ((IT) >> 4) & 63, b_ = (IT) >> 10; const size_t rw0 = (size_t)b_ * SEQ + (size_t)c_ * 128; const int cl0 = gg_ * 512 + ds_ * 128; \
            pg[0] = *(const f32x4*)(vgain + cl0 + (tid & 15) * 8); pg[1] = *(const f32x4*)(vgain + cl0 + (tid & 15) * 8 + 4); \
            _Pragma("unroll") for (int i = 0; i < 4; ++i) { const int idx = tid + NTHR * i, row = idx >> 4, ch = idx & 15; \
                const float* wp = wsp + ((size_t)gg_ * 128 + row) * 128 + ch * 8; pw[i][0] = *(const f32x4*)wp; pw[i][1] = *(const f32x4*)(wp + 4); \
                pvv[i] = *(const u32x4*)(VB + (rw0 + row) * 2048 + cl0 + ch * 8); psum[i] = VSUM[rw0 + row]; psq[i] = VSQ[rw0 + row]; } } while (0)
        if (bid < 2048) SG_LOAD(bid);
        for (int it = bid; it < 2048; it += G) {
            const int ds = it & 3, gg = (it >> 2) & 3, c = (it >> 4) & 63, b = it >> 10;
            const size_t row0 = (size_t)b * SEQ + (size_t)c * 128; const int col0 = gg * 512 + ds * 128;
            int h5 = h5_, r = r_; asm volatile("" : "+v"(h5), "+v"(r));
#pragma unroll
            for (int i = 0; i < 4; ++i) { const int idx = tid + NTHR * i, row = idx >> 4, ch = idx & 15;
                float w[8] = {pw[i][0].x, pw[i][0].y, pw[i][0].z, pw[i][0].w, pw[i][1].x, pw[i][1].y, pw[i][1].z, pw[i][1].w};
#pragma unroll
                for (int j = 0; j < 8; ++j) w[j] = (ch * 8 + j <= row) ? w[j] : 0.f;
                u32x4 o; o.x = pk2(w[0], w[1]); o.y = pk2(w[2], w[3]); o.z = pk2(w[4], w[5]); o.w = pk2(w[6], w[7]);
                *(LAS u32x4*)(Wsm + row * 136 + ch * 8) = o;
                const float mu = psum[i] * (1.f / 2048.f), var = fmaxf(psq[i] * (1.f / 2048.f) - mu * mu, 0.f), rstd = __builtin_amdgcn_rsqf(var + EPS);
                const u32x4 vv = pvv[i]; u32x4 o2;
                o2.x = pk2((bflo(vv.x) - mu) * rstd * pg[0].x, (bfhi(vv.x) - mu) * rstd * pg[0].y); o2.y = pk2((bflo(vv.y) - mu) * rstd * pg[0].z, (bfhi(vv.y) - mu) * rstd * pg[0].w);
                o2.z = pk2((bflo(vv.z) - mu) * rstd * pg[1].x, (bfhi(vv.z) - mu) * rstd * pg[1].y); o2.w = pk2((bflo(vv.w) - mu) * rstd * pg[1].z, (bfhi(vv.w) - mu) * rstd * pg[1].w);
                *(LAS u32x4*)(Vs + row * 136 + ch * 8) = o2; }
            __syncthreads();
            if (it + G < 2048) SG_LOAD(it + G);
            f32x16 acc[2] = {ZERO16, ZERO16};
            const int nks = 2 * wm + 2;
#pragma unroll 2
            for (int ks = 0; ks < nks; ++ks) { const int m0 = 16 * ks + 8 * h5;
                const bf16x8 a = *(const LAS bf16x8*)(Wsm + (32 * wm + r) * 136 + m0);
#pragma unroll
                for (int nt = 0; nt < 2; ++nt) { const bf16x8 bb = gather8(Vs + m0 * 136 + 64 * wn + 32 * nt + r, 136); acc[nt] = MFMA32(bb, a, acc[nt]); } }
            const int t = 32 * wm + r; const float bias = bsp[gg * 128 + t];
            bf16_t* dst = VB + (row0 + t) * 2048 + col0 + 64 * wn + 4 * h5;
#pragma unroll
            for (int nt = 0; nt < 2; ++nt)
#pragma unroll
                for (int iq = 0; iq < 4; ++iq) { u32x2 w; w.x = pk2(acc[nt][4 * iq] + bias, acc[nt][4 * iq + 1] + bias); w.y = pk2(acc[nt][4 * iq + 2] + bias, acc[nt][4 * iq + 3] + bias); *(u32x2*)(dst + 32 * nt + 8 * iq) = w; }
            __syncthreads();
        }
#undef SG_LOAD
    }
    SEAM(8);
    if (IN(9)) {
        pg8::Gemm g{U, WINO + (size_t)2048 * 1024, M, 4096, 1024}; pg8::StaticOrder S; S.init(M, 4096, G, bid);
        Epi9 E{RSS1, VB, CAT};
        pg8::gemm_phase<Epi9, pg8::StaticOrder, true, true>(lds, g, S, E);
    }
    SEAM(9);
    if (IN(10)) {
        pg8::Gemm g{CAT, WOUTO, M, 1024, 2048}; pg8::StaticOrder S; S.init(M, 1024, G, bid);
        EpiOut E{X1, X1, nullptr, nullptr, RSS2};
        pg8::gemm_phase<EpiOut, pg8::StaticOrder, true, true>(lds, g, S, E);
    }
    SEAM(10);
    if (IN(11)) {
        for (int m = gw; m < M; m += NGW) {
            const f32x4* xr = (const f32x4*)(X1 + (size_t)m * D) + lane; const f32x4* gr = (const f32x4*)args.in[21] + lane; f32x4* o = (f32x4*)(args.out + (size_t)m * D) + lane;
            const float rs = __builtin_amdgcn_rsqf(RSS2[m] * (1.f / 1024.f) + EPS);
#pragma unroll
            for (int j = 0; j < 4; ++j) { const f32x4 v = xr[64 * j], gg = gr[64 * j]; o[64 * j] = (f32x4){v.x * rs * gg.x, v.y * rs * gg.y, v.z * rs * gg.z, v.w * rs * gg.w}; }
        }
    }
#undef IN
#undef SEAM
}

extern "C" void kernel_launch(void* const* d_in, const int* in_sizes, int n_in, void* d_out, int out_size, void* d_ws, size_t ws_size, hipStream_t stream) {
    static int grid = 0;
    if (grid == 0) {
        if (n_in != 22 || out_size != M * D || ws_size < WS_END) { fprintf(stderr, "kernel_launch: unexpected shapes (n_in %d out %d ws %zu)\n", n_in, out_size, ws_size); grid = -1; return; }
        int dev = 0, cus = 0, per_cu = 0;
        hipGetDevice(&dev); hipDeviceGetAttribute(&cus, hipDeviceAttributeMultiprocessorCount, dev);
        if (hipFuncSetAttribute((const void*)mk_fwd, hipFuncAttributeMaxDynamicSharedMemorySize, LDS_BYTES) != hipSuccess) { fprintf(stderr, "kernel_launch: hipFuncSetAttribute failed\n"); grid = -1; return; }
        if (hipOccupancyMaxActiveBlocksPerMultiprocessor(&per_cu, (const void*)mk_fwd, NTHR, LDS_BYTES) != hipSuccess || per_cu < 1) { fprintf(stderr, "kernel_launch: occupancy query says %d\n", per_cu); grid = -1; return; }
        grid = cus * (per_cu > 1 ? 1 : per_cu);
    }
    if (grid < 0) return;
    Args a{};
    for (int i = 0; i < 22; ++i) a.in[i] = (const float*)d_in[i];
    a.out = (float*)d_out; a.ws = (unsigned char*)d_ws;
#if MK_PER_PHASE
    for (int p = 0; p < NPH; ++p) { a.ph_lo = p; a.ph_hi = p + 1; hipLaunchKernelGGL(mk_fwd, dim3(grid), dim3(NTHR), LDS_BYTES, stream, a); }
#else
    a.ph_lo = 0; a.ph_hi = NPH;
    void* kargs[] = {&a};
    hipError_t e = hipLaunchCooperativeKernel((const void*)mk_fwd, dim3(grid), dim3(NTHR), kargs, LDS_BYTES, stream);
    if (e != hipSuccess) fprintf(stderr, "kernel_launch: cooperative launch failed: %s (grid %d)\n", hipGetErrorString(e), grid);
#endif
}
```

```cpp
#include <hip/hip_runtime.h>
#include <hip/hip_cooperative_groups.h>
#include <cstdio>
#include <cstdint>
namespace cg = cooperative_groups;
namespace pg8 {
#define PG8_LAS __attribute__((address_space(3)))
typedef unsigned short bf16_t;
typedef short bf16x8 __attribute__((ext_vector_type(8)));
typedef float f32x4 __attribute__((ext_vector_type(4)));
typedef unsigned u32x4 __attribute__((ext_vector_type(4)));
constexpr int BM = 256, BK = 64, HALF = 128, HTB = HALF * BK * 2  , STAGE_BYTES = 8 * HTB, NXCD = 8, WGM = 8;

__host__ __device__ __forceinline__ int lds_byte(int r, int c) { const int st = (r >> 4) * 2 + (c >> 5), rr = r & 15, cc = c & 31, ob = rr * 64 + cc * 2; return st * 1024 + (ob ^ (((ob >> 9) & 1) << 5)); }
__host__ __device__ __forceinline__ void stage_rc(int b, int& R, int& C) { const int st = b / 1024, sb = b % 1024, swz = sb ^ (((sb >> 9) & 1) << 5); R = (st >> 1) * 16 + swz / 64; C = (st & 1) * 32 + (swz % 64) / 2; }
__host__ __device__ __forceinline__ int perm32(int rho) { const int n = rho >> 4, i = rho & 15; return 8 * (i >> 2) + 4 * n + (i & 3); }

struct Unit { int pm, pn; };
struct Gemm { const bf16_t* A; const bf16_t* Bt; int M, N, K; };

struct StaticOrder {
    int nM, nN, nwg, G, c;
    __host__ __device__ void init(int M, int N, int G_, int c_) { nM = M / BM; nN = N / BM; nwg = nM * nN; G = G_; c = c_; }
    __host__ __device__ bool next(int i, Unit& u) const {
        const long L = (long)i * G + c; if (L >= nwg) return false;
        int wgid = (int)L; { const int q = nwg / NXCD, r = nwg % NXCD, xcd = wgid % NXCD, off = wgid / NXCD; wgid = (xcd < r ? xcd * (q + 1) : r * (q + 1) + (xcd - r) * q) + off; }
        const int nig = WGM * nN, gid = wgid / nig, fm = gid * WGM, gsz = (nM - fm) < WGM ? (nM - fm) : WGM;
        u.pm = fm + ((wgid % nig) % gsz); u.pn = (wgid % nig) / gsz; return true;
    }
    __device__ __forceinline__ void a_ready(const Unit&) const {}
    __device__ __forceinline__ void done(const Unit&) const {}
};

__device__ __forceinline__ unsigned cvt_pk_bf16(float lo, float hi) { unsigned r; asm volatile("v_cvt_pk_bf16_f32 %0, %1, %2" : "=v"(r) : "v"(lo), "v"(hi)); return r; }
template <class Epi, class Sched, bool ALIGN_EPI = false, bool SP2 = false>
__device__ __forceinline__ void gemm_phase(PG8_LAS unsigned char* lds, const Gemm g, const Sched& S, const Epi& E) {
    const int tid = threadIdx.x, wid = __builtin_amdgcn_readfirstlane(tid >> 6), lane = tid & 63, wr = wid >> 2, wc = wid & 3, fr = lane & 15, fq = lane >> 4;
    const int K = g.K, nt = K / BK;
    unsigned voffA[2], voffB[2];
#pragma unroll
    for (int i = 0; i < 2; ++i) { int R, C; stage_rc(tid * 16 + i * 8192, R, C); const int Rb = Epi::PERM ? ((R & ~31) + perm32(R & 31)) : R;
        voffA[i] = (unsigned)(R * K + C) * 2u; voffB[i] = (unsigned)(Rb * K + C) * 2u; }
    const size_t kstep = (size_t)(BK * 2);
    const size_t hstep = (size_t)HALF * K * 2;
    const size_t tstep = 2 * hstep;
    const unsigned ldsw = (unsigned)wid * 1024u;
    const int aoff = lds_byte(wr * 64 + fr, fq * 8), boff = lds_byte(wc * 32 + fr, fq * 8);
#define PG8_SA(b, h) (((b) * 2 + (h)) * HTB)
#define PG8_SB(b, h) ((4 + (b) * 2 + (h)) * HTB)
#define PG8_STAGE(bufoff, gbase, voff) do { _Pragma("unroll") for (int _i = 0; _i < 2; ++_i) \
        __builtin_amdgcn_global_load_lds((const unsigned*)((const char*)(gbase) + (voff)[_i]), (PG8_LAS unsigned*)(lds + (bufoff) + ldsw + _i * 8192), 16, 0, 0); } while (0)
#define PG8_LDA(dst, b, h) do { _Pragma("unroll") for (int m = 0; m < 4; ++m) _Pragma("unroll") for (int k = 0; k < 2; ++k) dst[m][k] = *(const PG8_LAS bf16x8*)(lds + PG8_SA(b, h) + aoff + m * 2048 + k * 1024); } while (0)
#define PG8_LDB(dst, b, h) do { _Pragma("unroll") for (int n = 0; n < 2; ++n) _Pragma("unroll") for (int k = 0; k < 2; ++k) dst[n][k] = *(const PG8_LAS bf16x8*)(lds + PG8_SB(b, h) + boff + n * 2048 + k * 1024); } while (0)
#define PG8_MMA(ai, bj, At, Bt) do { __builtin_amdgcn_s_setprio(1); _Pragma("unroll") for (int m = 0; m < 4; ++m) _Pragma("unroll") for (int n = 0; n < 2; ++n) _Pragma("unroll") for (int k = 0; k < 2; ++k) \
        acc[ai][bj][m][n] = __builtin_amdgcn_mfma_f32_16x16x32_bf16(Bt[n][k], At[m][k], acc[ai][bj][m][n], 0, 0, 0); __builtin_amdgcn_s_setprio(0); } while (0)
#define PG8_WAIT_V(n) asm volatile("s_waitcnt vmcnt(" #n ")" ::: "memory")
#define PG8_WAIT_L(n) asm volatile("s_waitcnt lgkmcnt(" #n ")" ::: "memory")
#define PG8_BAR __builtin_amdgcn_s_barrier()
#define PG8_SCHED __builtin_amdgcn_sched_barrier(0)
    Unit cur, nxt; int ui = 0;
    if (!S.next(0, cur)) return;
    f32x4 acc[2][2][4][2];
#pragma unroll
    for (int a = 0; a < 2; ++a)
#pragma unroll
        for (int b = 0; b < 2; ++b)
#pragma unroll
            for (int m = 0; m < 4; ++m)
#pragma unroll
                for (int n = 0; n < 2; ++n) acc[a][b][m][n] = (f32x4){0.f, 0.f, 0.f, 0.f};
    bf16x8 At[4][2], B0[2][2], B1[2][2];
    const char* cA = (const char*)g.A + (size_t)cur.pm * tstep; const char* cB = (const char*)g.Bt + (size_t)cur.pn * tstep;
    S.a_ready(cur);
    if constexpr (SP2) {
        PG8_STAGE(PG8_SB(0, 0), cB, voffB); PG8_STAGE(PG8_SB(0, 1), cB + hstep, voffB); PG8_STAGE(PG8_SA(0, 0), cA, voffA); PG8_STAGE(PG8_SA(0, 1), cA + hstep, voffA);
        if (wr == 1) PG8_BAR;
        PG8_WAIT_V(2); PG8_BAR;
        PG8_STAGE(PG8_SB(1, 0), cB + kstep, voffB); PG8_STAGE(PG8_SA(1, 0), cA + kstep, voffA); PG8_STAGE(PG8_SB(1, 1), cB + hstep + kstep, voffB);
        PG8_WAIT_V(6); PG8_BAR;
    } else {
        PG8_STAGE(PG8_SB(0, 0), cB, voffB); PG8_STAGE(PG8_SA(0, 0), cA, voffA); PG8_STAGE(PG8_SB(0, 1), cB + hstep, voffB); PG8_STAGE(PG8_SA(0, 1), cA + hstep, voffA);
        if (wr == 1) PG8_BAR;
        PG8_WAIT_V(4); PG8_BAR;
        PG8_STAGE(PG8_SB(1, 0), cB + kstep, voffB); PG8_STAGE(PG8_SA(1, 0), cA + kstep, voffA); PG8_STAGE(PG8_SB(1, 1), cB + hstep + kstep, voffB);
        PG8_WAIT_V(6); PG8_BAR;
    }
    for (;;) {
        const bool has_next = S.next(ui + 1, nxt);
        const char* nA = has_next ? (const char*)g.A + (size_t)nxt.pm * tstep : cA; const char* nB = has_next ? (const char*)g.Bt + (size_t)nxt.pn * tstep : cB;
        for (int t = 0; t < nt; t += 2) {
            const bool last = (t == nt - 2);
            const char* a1 = cA + (size_t)(t + 1) * kstep;
            const char* a2 = last ? nA : cA + (size_t)(t + 2) * kstep; const char* b2 = last ? nB : cB + (size_t)(t + 2) * kstep;
            const char* a3 = a2 + kstep; const char* b3 = b2 + kstep;
            if (last && has_next) S.a_ready(nxt);
            if constexpr (SP2) {
            PG8_LDB(B0, 0, 0); PG8_LDB(B1, 0, 1); PG8_SCHED; PG8_LDA(At, 0, 0); PG8_STAGE(PG8_SA(1, 1), a1 + hstep, voffA);
            PG8_WAIT_V(8); PG8_WAIT_L(0); PG8_BAR; PG8_MMA(0, 0, At, B0); PG8_MMA(0, 1, At, B1); PG8_BAR; PG8_SCHED;
            PG8_LDA(At, 0, 1); PG8_STAGE(PG8_SB(0, 0), b2, voffB); PG8_STAGE(PG8_SB(0, 1), b2 + hstep, voffB); PG8_STAGE(PG8_SA(0, 0), a2, voffA);
            PG8_WAIT_V(8); PG8_WAIT_L(0); PG8_BAR; PG8_MMA(1, 0, At, B0); PG8_MMA(1, 1, At, B1); PG8_BAR; PG8_SCHED;
            PG8_LDB(B0, 1, 0); PG8_LDB(B1, 1, 1); PG8_SCHED; PG8_LDA(At, 1, 0); PG8_STAGE(PG8_SA(0, 1), a2 + hstep, voffA);
            PG8_WAIT_V(8); PG8_WAIT_L(0); PG8_BAR; PG8_MMA(0, 0, At, B0); PG8_MMA(0, 1, At, B1); PG8_BAR; PG8_SCHED;
            PG8_LDA(At, 1, 1); PG8_STAGE(PG8_SB(1, 0), b3, voffB); PG8_STAGE(PG8_SB(1, 1), b3 + hstep, voffB); PG8_STAGE(PG8_SA(1, 0), a3, voffA);
            PG8_WAIT_V(8); PG8_WAIT_L(0); PG8_BAR; PG8_MMA(1, 0, At, B0); PG8_MMA(1, 1, At, B1); PG8_BAR; PG8_SCHED;
            } else {
            PG8_LDB(B0, 0, 0); PG8_SCHED; PG8_LDA(At, 0, 0); PG8_STAGE(PG8_SA(1, 1), a1 + hstep, voffA);
            PG8_WAIT_L(8); PG8_BAR; PG8_WAIT_L(0); PG8_MMA(0, 0, At, B0); PG8_BAR; PG8_SCHED;
            PG8_LDB(B1, 0, 1); PG8_STAGE(PG8_SB(0, 0), b2, voffB);
            PG8_BAR; PG8_WAIT_L(0); PG8_MMA(0, 1, At, B1); PG8_BAR;
            PG8_LDA(At, 0, 1); PG8_STAGE(PG8_SA(0, 0), a2, voffA);
            PG8_BAR; PG8_WAIT_L(0); PG8_MMA(1, 0, At, B0); PG8_BAR; PG8_SCHED;
            PG8_STAGE(PG8_SB(0, 1), b2 + hstep, voffB);
            PG8_WAIT_V(6); PG8_BAR; PG8_MMA(1, 1, At, B1); PG8_BAR;
            PG8_LDB(B0, 1, 0); PG8_SCHED; PG8_LDA(At, 1, 0); PG8_STAGE(PG8_SA(0, 1), a2 + hstep, voffA);
            PG8_WAIT_L(8); PG8_BAR; PG8_WAIT_L(0); PG8_MMA(0, 0, At, B0); PG8_BAR; PG8_SCHED;
            PG8_LDB(B1, 1, 1); PG8_STAGE(PG8_SB(1, 0), b3, voffB);
            PG8_BAR; PG8_WAIT_L(0); PG8_MMA(0, 1, At, B1); PG8_BAR;
            PG8_LDA(At, 1, 1); PG8_STAGE(PG8_SA(1, 0), a3, voffA);
            PG8_BAR; PG8_WAIT_L(0); PG8_MMA(1, 0, At, B0); PG8_BAR; PG8_SCHED;
            PG8_STAGE(PG8_SB(1, 1), b3 + hstep, voffB);
            PG8_WAIT_V(6); PG8_BAR; PG8_MMA(1, 1, At, B1); PG8_BAR;
            }
        }
        if constexpr (ALIGN_EPI) { if (wr == 0) PG8_BAR; }
        if constexpr (!Epi::AFTER_DRAIN) { E(acc, cur, wr, wc, fr, fq); S.done(cur); }
        if (!has_next) break;
#pragma unroll
        for (int a = 0; a < 2; ++a)
#pragma unroll
            for (int b = 0; b < 2; ++b)
#pragma unroll
                for (int m = 0; m < 4; ++m)
#pragma unroll
                    for (int n = 0; n < 2; ++n) acc[a][b][m][n] = (f32x4){0.f, 0.f, 0.f, 0.f};
        cur = nxt; cA = nA; cB = nB; ++ui;
        if constexpr (ALIGN_EPI) { if (wr == 1) PG8_BAR; }
    }
    PG8_WAIT_V(0);
    if constexpr (!ALIGN_EPI) { if (wr == 0) PG8_BAR; }
    PG8_BAR;
    if constexpr (Epi::AFTER_DRAIN) { E.fused(acc, cur, wr, wc, fr, fq, lds, wid, lane); S.done(cur); }
#undef PG8_SA
#undef PG8_SB
#undef PG8_STAGE
#undef PG8_LDA
#undef PG8_LDB
#undef PG8_MMA
#undef PG8_WAIT_V
#undef PG8_WAIT_L
#undef PG8_BAR
#undef PG8_SCHED
}
}

#ifndef MK_PER_PHASE
#define MK_PER_PHASE 0
#endif
using pg8::bf16_t; using pg8::bf16x8; using pg8::f32x4; using pg8::u32x4;
typedef float f32x16 __attribute__((ext_vector_type(16)));
typedef unsigned u32x2 __attribute__((ext_vector_type(2)));
#define LAS __attribute__((address_space(3)))
constexpr int M = 16384, D = 1024, SEQ = 8192, NTHR = 512, NPH = 12;
constexpr float EPS = 1e-6f;
constexpr size_t MiB = 1u << 20;
constexpr size_t WS_RSS0 = 0, WS_RSS1 = 65536, WS_VSUM = 131072, WS_VSQ = 196608, WS_RSS2 = 262144;
constexpr size_t WS_BAR = 512 * 1024, BAR_BYTES = 16384;
constexpr size_t WS_APOW = 1 * MiB, WS_A128 = 1 * MiB + 131072, WS_BBT = 1 * MiB + 262144, WS_CCT = 1 * MiB + 524288;
constexpr size_t WS_COS = 2 * MiB, WS_SIN = 6 * MiB, WS_CHS = 10 * MiB;
constexpr size_t WS_WINE = 16 * MiB, WS_WGLU = 28 * MiB, WS_WOUTE = 30 * MiB, WS_WINO = 34 * MiB, WS_WOUTO = 46 * MiB;
constexpr size_t WS_U = 52 * MiB, WS_CAT = 84 * MiB, WS_K = 148 * MiB, WS_V = 180 * MiB, WS_SZB = 212 * MiB, WS_END = 244 * MiB;
constexpr size_t WS_X1 = WS_K;
constexpr int LDS_BYTES = 143360;

struct Args { const float* in[22]; float* out; unsigned char* ws; int ph_lo, ph_hi; };

__device__ __forceinline__ unsigned f2bf(float f) { unsigned u = __builtin_bit_cast(unsigned, f); return (u + 0x7fffu + ((u >> 16) & 1u)) >> 16; }
__device__ __forceinline__ unsigned pk2(float lo, float hi) { return pg8::cvt_pk_bf16(lo, hi); }
__device__ __forceinline__ float bflo(unsigned w) { return __builtin_bit_cast(float, w << 16); }
__device__ __forceinline__ float bfhi(unsigned w) { return __builtin_bit_cast(float, w & 0xffff0000u); }
__device__ __forceinline__ float bf2f(bf16_t b) { return __builtin_bit_cast(float, (unsigned)b << 16); }
__device__ __forceinline__ float fast_rcp(float x) { return __builtin_amdgcn_rcpf(x); }
__device__ __forceinline__ float sigmoidf_(float t) { return fast_rcp(1.f + __builtin_amdgcn_exp2f(-1.4426950408889634f * t)); }
__device__ __forceinline__ float siluf_(float t) { return t * sigmoidf_(t); }
__device__ __forceinline__ float geluf_(float x) { const float u = 0.7978845608028654f * (x + 0.044715f * x * x * x); return x * sigmoidf_(2.f * u); }
__device__ __forceinline__ float wave_sum(float v) {
#pragma unroll
    for (int o = 1; o < 64; o <<= 1) v += __shfl_xor(v, o);
    return v;
}
__device__ __forceinline__ float lg_gamma(int h) { return h == 0 ? -0.04580368961312479f : (h == 1 ? -0.02272007650008353f : (h == 2 ? -0.011315313227834146f : -0.005646563141142063f)); }
__device__ __forceinline__ void sincos_d(double x, double& s, double& c) {
    double t = x * 0.15915494309189535; t -= __builtin_rint(t);
    const double qd = __builtin_rint(4.0 * t); const int q = (int)qd;
    const double r = (t - 0.25 * qd) * 6.283185307179586; const double r2 = r * r;
    double sp = -1.0 / 1307674368000.0; sp = sp * r2 + 1.0 / 6227020800.0; sp = sp * r2 - 1.0 / 39916800.0; sp = sp * r2 + 1.0 / 362880.0; sp = sp * r2 - 1.0 / 5040.0; sp = sp * r2 + 1.0 / 120.0; sp = sp * r2 - 1.0 / 6.0; sp = sp * r2 + 1.0;
    const double sr = sp * r;
    double cp = 1.0 / 20922789888000.0; cp = cp * r2 - 1.0 / 87178291200.0; cp = cp * r2 + 1.0 / 479001600.0; cp = cp * r2 - 1.0 / 3628800.0; cp = cp * r2 + 1.0 / 40320.0; cp = cp * r2 - 1.0 / 720.0; cp = cp * r2 + 1.0 / 24.0; cp = cp * r2 - 0.5; cp = cp * r2 + 1.0;
    const int qq = q & 3;
    if (qq == 0) { s = sr; c = cp; } else if (qq == 1) { s = cp; c = -sr; } else if (qq == 2) { s = -sr; c = -cp; } else { s = -cp; c = sr; }
}

#define EPI_ARGS const f32x4 (&acc)[2][2][4][2], const pg8::Unit& u, int wr, int wc, int fr, int fq
__device__ __forceinline__ void st8bf(bf16_t* p, const float (&v)[8]) { u32x4 w; w.x = pk2(v[0], v[1]); w.y = pk2(v[2], v[3]); w.z = pk2(v[4], v[5]); w.w = pk2(v[6], v[7]); *(u32x4*)p = w; }
__device__ __forceinline__ void ld8bf(const bf16_t* p, float (&v)[8]) { const u32x4 w = *(const u32x4*)p; v[0] = bflo(w.x); v[1] = bfhi(w.x); v[2] = bflo(w.y); v[3] = bfhi(w.y); v[4] = bflo(w.z); v[5] = bfhi(w.z); v[6] = bflo(w.w); v[7] = bfhi(w.w); }
__device__ __forceinline__ void ld8f(const float* p, float (&v)[8]) { const f32x4 a = *(const f32x4*)p, b = *(const f32x4*)(p + 4); v[0] = a.x; v[1] = a.y; v[2] = a.z; v[3] = a.w; v[4] = b.x; v[5] = b.y; v[6] = b.z; v[7] = b.w; }
__device__ __forceinline__ void st8f(float* p, const float (&v)[8]) { *(f32x4*)p = (f32x4){v[0], v[1], v[2], v[3]}; *(f32x4*)(p + 4) = (f32x4){v[4], v[5], v[6], v[7]}; }
#define ACC8(dst, ai, bj, m, sc) do { const f32x4 _a = acc[ai][bj][m][0], _b = acc[ai][bj][m][1]; dst[0] = _a.x * (sc); dst[1] = _a.y * (sc); dst[2] = _a.z * (sc); dst[3] = _a.w * (sc); dst[4] = _b.x * (sc); dst[5] = _b.y * (sc); dst[6] = _b.z * (sc); dst[7] = _b.w * (sc); } while (0)

struct Epi1 {
    static constexpr bool PERM = true, AFTER_DRAIN = false;
    const float* rss; bf16_t* U; bf16_t* CAT; bf16_t* Kb; bf16_t* Vb; bf16_t* SZB; const float* COS; const float* SIN;
    __device__ __forceinline__ void operator()(EPI_ARGS) const {
        const int seg = u.pn >> 2, cb = (u.pn & 3) * 256, colL = wc * 32 + 8 * fq;
        const int row0 = u.pm * 256 + wr * 64 + fr;
#pragma unroll
        for (int ai = 0; ai < 2; ++ai)
#pragma unroll
            for (int m = 0; m < 4; ++m) {
                const int row = row0 + ai * 128 + m * 16;
                const float rs = __builtin_amdgcn_rsqf(rss[row] * (1.f / 1024.f) + EPS);
                if (seg == 2 || seg == 3) {
                    float x1[8], x2[8], cs[8], sn[8], o1[8], o2[8];
                    const float sc = (seg == 3) ? rs * 0.0625f : rs;
                    ACC8(x1, ai, 0, m, sc); ACC8(x2, ai, 1, m, sc);
                    const int pos = row & (SEQ - 1);
                    ld8f(COS + (size_t)pos * 128 + colL, cs); ld8f(SIN + (size_t)pos * 128 + colL, sn);
#pragma unroll
                    for (int j = 0; j < 8; ++j) { o1[j] = x1[j] * cs[j] - x2[j] * sn[j]; o2[j] = x1[j] * sn[j] + x2[j] * cs[j]; }
                    bf16_t* dst = (seg == 2) ? CAT + (size_t)row * 2048 + 1024 + cb + colL : Kb + (size_t)row * 1024 + cb + colL;
                    st8bf(dst, o1); st8bf(dst + 128, o2);
                } else {
#pragma unroll
                    for (int bj = 0; bj < 2; ++bj) {
                        float v[8]; ACC8(v, ai, bj, m, rs);
                        const int col = cb + bj * 128 + colL;
                        if (seg == 1 || seg == 5) {
#pragma unroll
                            for (int j = 0; j < 8; ++j) v[j] = siluf_(v[j]);
                        }
                        bf16_t* dst = (seg == 0) ? U + (size_t)row * 1024 + col : (seg == 1) ? CAT + (size_t)row * 2048 + col : (seg == 4) ? Vb + (size_t)row * 1024 + col : SZB + (size_t)row * 1024 + col;
                        st8bf(dst, v);
                    }
                }
            }
    }
};
struct EpiGlu {
    static constexpr bool PERM = true, AFTER_DRAIN = false;
    const float* bglu; const bf16_t* Y1; bf16_t* CAT;
    __device__ __forceinline__ void operator()(EPI_ARGS) const {
        const int colL = wc * 32 + 8 * fq, row0 = u.pm * 256 + wr * 64 + fr;
#pragma unroll
        for (int bj = 0; bj < 2; ++bj) {
            const int col = u.pn * 256 + bj * 128 + colL;
            float bb[8]; ld8f(bglu + col, bb);
#pragma unroll
            for (int ai = 0; ai < 2; ++ai)
#pragma unroll
                for (int m = 0; m < 4; ++m) {
                    const int row = row0 + ai * 128 + m * 16;
                    float t[8], y[8], z[8]; ACC8(t, ai, bj, m, 1.f);
                    ld8bf(Y1 + (size_t)row * 1024 + col, y); ld8bf(CAT + (size_t)row * 2048 + col, z);
#pragma unroll
                    for (int j = 0; j < 8; ++j) t[j] = y[j] * sigmoidf_(t[j] + bb[j]) * z[j];
                    st8bf(CAT + (size_t)row * 2048 + col, t);
                }
        }
    }
};
struct EpiOut {
    static constexpr bool PERM = true, AFTER_DRAIN = false;
    const float* Xi; float* Xo; bf16_t* XG; const float* g; float* rss;
    __device__ __forceinline__ void operator()(EPI_ARGS) const {
        const int colL = wc * 32 + 8 * fq, row0 = u.pm * 256 + wr * 64 + fr;
#pragma unroll
        for (int ai = 0; ai < 2; ++ai)
#pragma unroll
            for (int m = 0; m < 4; ++m) {
                const int row = row0 + ai * 128 + m * 16; float ss = 0.f;
#pragma unroll
                for (int bj = 0; bj < 2; ++bj) {
                    const int col = u.pn * 256 + bj * 128 + colL;
                    float a[8], x[8]; ACC8(a, ai, bj, m, 1.f); ld8f(Xi + (size_t)row * 1024 + col, x);
#pragma unroll
                    for (int j = 0; j < 8; ++j) { x[j] += a[j]; ss += x[j] * x[j]; }
                    st8f(Xo + (size_t)row * 1024 + col, x);
                    if (XG) { float gg[8]; ld8f(g + col, gg);
#pragma unroll
                        for (int j = 0; j < 8; ++j) x[j] *= gg[j];
                        st8bf(XG + (size_t)row * 1024 + col, x); }
                }
                ss += __shfl_xor(ss, 16); ss += __shfl_xor(ss, 32);
                if (fq == 0) atomicAdd(rss + row, ss);
            }
    }
};
struct Epi7 {
    static constexpr bool PERM = true, AFTER_DRAIN = false;
    const float* rss; bf16_t* VB; float* vsum; float* vsq;
    __device__ __forceinline__ void operator()(EPI_ARGS) const {
        const int colL = wc * 32 + 8 * fq, row0 = u.pm * 256 + wr * 64 + fr;
#pragma unroll
        for (int ai = 0; ai < 2; ++ai)
#pragma unroll
            for (int m = 0; m < 4; ++m) {
                const int row = row0 + ai * 128 + m * 16; float s = 0.f, q = 0.f;
                const float rs = __builtin_amdgcn_rsqf(rss[row] * (1.f / 1024.f) + EPS);
#pragma unroll
                for (int bj = 0; bj < 2; ++bj) {
                    const int col = u.pn * 256 + bj * 128 + colL;
                    float v[8]; ACC8(v, ai, bj, m, rs);
#pragma unroll
                    for (int j = 0; j < 8; ++j) { v[j] = geluf_(v[j]); s += v[j]; q += v[j] * v[j]; }
                    st8bf(VB + (size_t)row * 2048 + col, v);
                }
                s += __shfl_xor(s, 16); s += __shfl_xor(s, 32); q += __shfl_xor(q, 16); q += __shfl_xor(q, 32);
                if (fq == 0) { atomicAdd(vsum + row, s); atomicAdd(vsq + row, q); }
            }
    }
};
struct Epi9 {
    static constexpr bool PERM = true, AFTER_DRAIN = false;
    const float* rss; const bf16_t* SB; bf16_t* Y;
    __device__ __forceinline__ void operator()(EPI_ARGS) const {
        const int colL = wc * 32 + 8 * fq, row0 = u.pm * 256 + wr * 64 + fr, col = u.pn * 128 + colL;
#pragma unroll
        for (int ai = 0; ai < 2; ++ai)
#pragma unroll
            for (int m = 0; m < 4; ++m) {
                const int row = row0 + ai * 128 + m * 16;
                const float rs = __builtin_amdgcn_rsqf(rss[row] * (1.f / 1024.f) + EPS);
                float uu[8], zz[8], s[8]; ACC8(uu, ai, 0, m, rs); ACC8(zz, ai, 1, m, rs); ld8bf(SB + (size_t)row * 2048 + col, s);
#pragma unroll
                for (int j = 0; j < 8; ++j) uu[j] = geluf_(uu[j]) * s[j] * siluf_(zz[j]);
                st8bf(Y + (size_t)row * 2048 + col, uu);
            }
    }
};

__device__ __forceinline__ void p0_transpose_item(const float* W, int K, int N, bf16_t* WT, int row_off, LAS float* scr, int kb, int nb, int lane) {
    const int k0 = 64 * kb, n0 = 32 * nb;
#pragma unroll 8
    for (int i = 0; i < 32; ++i) { const int kk = 2 * i + (lane >> 5); scr[kk * 33 + (lane & 31)] = W[(size_t)(k0 + kk) * N + n0 + (lane & 31)]; }
    asm volatile("s_waitcnt lgkmcnt(0)" ::: "memory");
    const int c = lane & 7;
#pragma unroll
    for (int j = 0; j < 4; ++j) { const int n = (lane >> 3) + 8 * j; const LAS float* s = scr + (8 * c) * 33 + n;
        u32x4 o; o.x = pk2(s[0 * 33], s[1 * 33]); o.y = pk2(s[2 * 33], s[3 * 33]); o.z = pk2(s[4 * 33], s[5 * 33]); o.w = pk2(s[6 * 33], s[7 * 33]);
        *(u32x4*)(WT + (size_t)(row_off + n0 + n) * K + k0 + 8 * c) = o; }
    asm volatile("s_waitcnt lgkmcnt(0)" ::: "memory");
}
__device__ __forceinline__ int wino_row(int n) {
    if (n < 2048) return 2048 + 256 * (n >> 7) + (n & 127);
    if (n < 4096) return n - 2048;
    const int z = n - 4096; return 2048 + 256 * (z >> 7) + 128 + (z & 127);
}

template <bool FINAL>
__device__ __forceinline__ void s5_item(int b, int c, int g, bf16_t* U, float* CHS, const float* APOW, const bf16_t* BBT, const bf16_t* CCT, const float* dsk, LAS unsigned char* wlds, int lane) {
    const int h = lane >> 5, r = lane & 31;
    const size_t row0 = (size_t)b * SEQ + (size_t)c * 128;
    bf16x8 bfrag[4];
#pragma unroll
    for (int nt = 0; nt < 4; ++nt) bfrag[nt] = *(const bf16x8*)(BBT + ((size_t)(g * 128 + nt * 32 + r) * 16 + 8 * h));
    float ar[2][4], ai_[2][4], cr[2], ci[2];
#pragma unroll
    for (int ph = 0; ph < 2; ++ph) {
        const int p = 32 * ph + r; const f32x4 w0 = *(const f32x4*)(APOW + (size_t)(g * 64 + p) * 8), w1 = *(const f32x4*)(APOW + (size_t)(g * 64 + p) * 8 + 4);
        ar[ph][0] = w0.x; ai_[ph][0] = w0.y; ar[ph][1] = w0.z; ai_[ph][1] = w0.w; ar[ph][2] = w1.x; ai_[ph][2] = w1.y; ar[ph][3] = w1.z; ai_[ph][3] = w1.w;
        if (FINAL) { const float* cp = CHS + ((size_t)((b * 64 + c) * 64 + g) * 64 + p) * 2; cr[ph] = cp[0]; ci[ph] = cp[1]; } else { cr[ph] = 0.f; ci[ph] = 0.f; }
    }
    bf16x8 cfrag[4];
    if (FINAL) {
#pragma unroll
        for (int ks = 0; ks < 4; ++ks) cfrag[ks] = *(const bf16x8*)(CCT + ((size_t)(g * 16 + (lane & 15)) * 128 + ks * 32 + 8 * (lane >> 4)));
    }
    const float dk = FINAL ? dsk[g * 16 + (lane & 15)] : 0.f;
    for (int sb = 0; sb < 4; ++sb) {
        const bf16x8 afrag = *(const bf16x8*)(U + (row0 + sb * 32 + r) * 1024 + g * 16 + 8 * h);
        f32x16 re[2], im[2];
        const f32x16 zero16 = {0.f, 0.f, 0.f, 0.f, 0.f, 0.f, 0.f, 0.f, 0.f, 0.f, 0.f, 0.f, 0.f, 0.f, 0.f, 0.f};
        re[0] = __builtin_amdgcn_mfma_f32_32x32x16_bf16(afrag, bfrag[0], zero16, 0, 0, 0);
        re[1] = __builtin_amdgcn_mfma_f32_32x32x16_bf16(afrag, bfrag[1], zero16, 0, 0, 0);
        im[0] = __builtin_amdgcn_mfma_f32_32x32x16_bf16(afrag, bfrag[2], zero16, 0, 0, 0);
        im[1] = __builtin_amdgcn_mfma_f32_32x32x16_bf16(afrag, bfrag[3], zero16, 0, 0, 0);
#pragma unroll
        for (int ph = 0; ph < 2; ++ph) {
            const float a1r = ar[ph][0], a1i = ai_[ph][0], a4r = ar[ph][3], a4i = ai_[ph][3];
#pragma unroll
            for (int q = 0; q < 4; ++q) {
#pragma unroll
                for (int j = 1; j < 4; ++j) { const int i = 4 * q + j; const float pr = re[ph][i - 1], pi = im[ph][i - 1];
                    re[ph][i] += a1r * pr - a1i * pi; im[ph][i] += a1r * pi + a1i * pr; }
            }
#pragma unroll
            for (int q = 0; q < 4; ++q) {
                const float Er = re[ph][4 * q + 3], Ei = im[ph][4 * q + 3];
                const float Xr = Er + a4r * cr[ph] - a4i * ci[ph], Xi = Ei + a4r * ci[ph] + a4i * cr[ph];
                const float Xor_ = __shfl_xor(Xr, 32), Xoi = __shfl_xor(Xi, 32);
                const float cinr = h ? Xor_ : cr[ph], cini = h ? Xoi : ci[ph];
                const float Yr = Er + a4r * cinr - a4i * cini, Yi = Ei + a4r * cini + a4i * cinr;
                const float Yor = __shfl_xor(Yr, 32), Yoi = __shfl_xor(Yi, 32);
                if (FINAL) {
#pragma unroll
                    for (int j = 0; j < 4; ++j) { const int i = 4 * q + j; re[ph][i] += ar[ph][j] * cinr - ai_[ph][j] * cini; im[ph][i] += ar[ph][j] * cini + ai_[ph][j] * cinr; }
                }
                cr[ph] = h ? Yr : Yor; ci[ph] = h ? Yi : Yoi;
            }
        }
        if (FINAL) {
#pragma unroll
            for (int ph = 0; ph < 2; ++ph)
#pragma unroll
                for (int i = 0; i < 16; ++i) { const int tok = (i & 3) + 8 * (i >> 2) + 4 * h; const int p = 32 * ph + r;
                    *(LAS unsigned*)(wlds + tok * 272 + 4 * p) = pk2(re[ph][i], im[ph][i]); }
            asm volatile("s_waitcnt lgkmcnt(0)" ::: "memory");
            f32x4 yacc[2] = {(f32x4){0.f, 0.f, 0.f, 0.f}, (f32x4){0.f, 0.f, 0.f, 0.f}};
#pragma unroll
            for (int mt = 0; mt < 2; ++mt)
#pragma unroll
                for (int ks = 0; ks < 4; ++ks) { const bf16x8 a = *(const LAS bf16x8*)(wlds + (mt * 16 + (lane & 15)) * 272 + (ks * 32 + 8 * (lane >> 4)) * 2);
                    yacc[mt] = __builtin_amdgcn_mfma_f32_16x16x32_bf16(a, cfrag[ks], yacc[mt], 0, 0, 0); }
            asm volatile("s_waitcnt lgkmcnt(0)" ::: "memory");
#pragma unroll
            for (int mt = 0; mt < 2; ++mt)
#pragma unroll
                for (int j = 0; j < 4; ++j) { const size_t row = row0 + sb * 32 + mt * 16 + 4 * (lane >> 4) + j; const bf16_t* pu = U + row * 1024 + g * 16 + (lane & 15);
                    const float y = yacc[mt][j] + dk * bf2f(*pu); U[row * 1024 + g * 16 + (lane & 15)] = (bf16_t)f2bf(geluf_(y)); }
        }
    }
    if (!FINAL && h == 0) {
#pragma unroll
        for (int ph = 0; ph < 2; ++ph) { float* cp = CHS + ((size_t)((b * 64 + c) * 64 + g) * 64 + 32 * ph + r) * 2; cp[0] = cr[ph]; cp[1] = ci[ph]; }
    }
}

__device__ __forceinline__ bf16x8 gather8(const LAS bf16_t* p, int pitch) {
    bf16x8 v;
#pragma unroll
    for (int j = 0; j < 8; ++j) v[j] = (short)p[j * pitch];
    return v;
}
#define MFMA32(a, b, c) __builtin_amdgcn_mfma_f32_32x32x16_bf16((a), (b), (c), 0, 0, 0)
#define ZERO16 ((f32x16){0.f, 0.f, 0.f, 0.f, 0.f, 0.f, 0.f, 0.f, 0.f, 0.f, 0.f, 0.f, 0.f, 0.f, 0.f, 0.f})

#define XB_TMO      128
#define XB_XCNT(j)  (256  + 64 * (j))
#define XB_XSUB(j)  (1280 + 64 * (j))
#define XB_XGEN(j)  (2304 + 64 * (j))
#define XB_TOP      3328
#define XB_TOPGEN   3392
#define XCD_BAR_WORDS 3456
#define XB_SPIN_CAP (1u << 18)

__device__ __forceinline__ unsigned xb_ld(unsigned* p)              { return __hip_atomic_load(p, __ATOMIC_RELAXED, __HIP_MEMORY_SCOPE_AGENT); }
__device__ __forceinline__ unsigned xb_add(unsigned* p, unsigned v) { return __hip_atomic_fetch_add(p, v, __ATOMIC_RELAXED, __HIP_MEMORY_SCOPE_AGENT); }
__device__ __forceinline__ unsigned xb_xcc_id() { return (unsigned)__builtin_amdgcn_s_getreg((3 << 11) | 20) & 0xFu; }
#define XB_SPIN(cond, bar) do { unsigned _sp = 0; while (cond) { __builtin_amdgcn_s_sleep(1); \
    if ((++_sp & 255u) == 0u) { if (xb_ld(&(bar)[XB_TMO])) break; if (_sp > XB_SPIN_CAP) { atomicAdd(&(bar)[XB_TMO], 1u); break; } } } } while (0)

struct XcdBarrier {
    unsigned* bar; unsigned x;
    volatile LAS unsigned* st;
};

__device__ __forceinline__ XcdBarrier xcd_barrier_post(unsigned* bar, volatile LAS unsigned* st) {
    XcdBarrier b; b.bar = bar; b.x = xb_xcc_id(); b.st = st;
    if (threadIdx.x == 0) (void)xb_add(&bar[XB_XCNT(b.x)], 1u);
    return b;
}
__device__ __forceinline__ void xcd_barrier_complete(unsigned* bar, unsigned x, unsigned& nloc, unsigned& nx) {
    const unsigned G = gridDim.x * gridDim.y * gridDim.z;
    unsigned sum, cnt, mine, sp = 0u;
    for (;;) {
        sum = 0u; cnt = 0u; mine = 0u;
#pragma unroll
        for (unsigned j = 0; j < 16; ++j) { const unsigned c = xb_ld(&bar[XB_XCNT(j)]); sum += c; cnt += (c > 0u) ? 1u : 0u; mine = (j == x) ? c : mine; }
        if (sum == G) break;
        __builtin_amdgcn_s_sleep(1);
        if ((++sp & 255u) == 0u) { if (xb_ld(&bar[XB_TMO])) break; if (sp > XB_SPIN_CAP) { atomicAdd(&bar[XB_TMO], 1u); break; } }
    }
    nloc = mine > 0u ? mine : 1u; nx = cnt > 0u ? cnt : 1u;
}

__device__ __forceinline__ void xcd_barrier(const XcdBarrier& b) {
    asm volatile("s_waitcnt vmcnt(0)" ::: "memory");
    __syncthreads();
    if (threadIdx.x == 0) {
        unsigned* bar = b.bar;
        __builtin_amdgcn_s_waitcnt(0);
        unsigned nloc = b.st[0], nx = b.st[1];
        if (nloc == 0u) { xcd_barrier_complete(bar, b.x, nloc, nx); b.st[0] = nloc; b.st[1] = nx; }
        const unsigned old = xb_add(&bar[XB_XSUB(b.x)], 1u);
        const unsigned gen = old / nloc;
        if (old + 1u == (gen + 1u) * nloc) {
            __builtin_amdgcn_fence(__ATOMIC_RELEASE, "agent");
            asm volatile("s_waitcnt vmcnt(0)" ::: "memory");
            const unsigned og = xb_add(&bar[XB_TOP], 1u);
            const unsigned tg = og / nx;
            if (og + 1u == (tg + 1u) * nx) xb_add(&bar[XB_TOPGEN], 1u);
            else XB_SPIN(xb_ld(&bar[XB_TOPGEN]) == tg, bar);
            __builtin_amdgcn_fence(__ATOMIC_ACQUIRE, "agent");
            xb_add(&bar[XB_XGEN(b.x)], 1u);
            asm volatile("s_waitcnt vmcnt(0)" ::: "memory");
        } else {
            XB_SPIN(xb_ld(&bar[XB_XGEN(b.x)]) == gen, bar);
            __builtin_amdgcn_fence(__ATOMIC_ACQUIRE, "agent");
            asm volatile("s_waitcnt vmcnt(0)" ::: "memory");
        }
    }
    __syncthreads();
}

__global__ void __launch_bounds__(NTHR, 2) mk_fwd(Args args) {
    extern __shared__ __attribute__((aligned(16))) unsigned char lds_raw[];
    LAS unsigned char* lds = (LAS unsigned char*)lds_raw;
    cg::grid_group grid = cg::this_grid();
    const int tid = threadIdx.x, lane = tid & 63, wid = __builtin_amdgcn_readfirstlane(tid >> 6);
    const int G = gridDim.x, bid = blockIdx.x;
    const int gw = bid * 8 + wid, NGW = G * 8;
    const int gtid = bid * NTHR + tid, NGT = G * NTHR;
    unsigned char* ws = args.ws;
    const float* x = args.in[0];
    float* RSS0 = (float*)(ws + WS_RSS0); float* RSS1 = (float*)(ws + WS_RSS1); float* VSUM = (float*)(ws + WS_VSUM); float* VSQ = (float*)(ws + WS_VSQ); float* RSS2 = (float*)(ws + WS_RSS2);
    float* APOW = (float*)(ws + WS_APOW); float* A128 = (float*)(ws + WS_A128); bf16_t* BBT = (bf16_t*)(ws + WS_BBT); bf16_t* CCT = (bf16_t*)(ws + WS_CCT);
    float* COS = (float*)(ws + WS_COS); float* SIN = (float*)(ws + WS_SIN); float* CHS = (float*)(ws + WS_CHS);
    bf16_t* WINE = (bf16_t*)(ws + WS_WINE); bf16_t* WGLU = (bf16_t*)(ws + WS_WGLU); bf16_t* WOUTE = (bf16_t*)(ws + WS_WOUTE); bf16_t* WINO = (bf16_t*)(ws + WS_WINO); bf16_t* WOUTO = (bf16_t*)(ws + WS_WOUTO);
    bf16_t* U = (bf16_t*)(ws + WS_U); bf16_t* CAT = (bf16_t*)(ws + WS_CAT); bf16_t* Kb = (bf16_t*)(ws + WS_K); bf16_t* Vb = (bf16_t*)(ws + WS_V); bf16_t* SZB = (bf16_t*)(ws + WS_SZB);
    float* X1 = (float*)(ws + WS_X1);
    bf16_t* XG0 = (bf16_t*)args.out;
    bf16_t* STATE = (bf16_t*)args.out;
    bf16_t* VB = (bf16_t*)args.out;
    const int lo = args.ph_lo, hi = args.ph_hi;
    volatile LAS unsigned* xst = (volatile LAS unsigned*)(lds + LDS_BYTES - 64);
    if (tid == 0) { xst[0] = 0u; xst[1] = 0u; }
    __syncthreads();
    const XcdBarrier xbar = xcd_barrier_post((unsigned*)(ws + WS_BAR), xst);
#ifndef PHMASK
#define PHMASK 0xFFF
#endif
#define IN(k) (((PHMASK >> (k)) & 1) && lo <= (k) && (k) < hi)
#define SEAM(k) do { if (IN(k) && IN((k) + 1)) { if ((k) == 0) grid.sync(); else xcd_barrier(xbar); } } while (0)
#ifndef PROBE_REP
#define PROBE_REP (-1)
#endif
#define PROBE_BEGIN(k) for (int pass = (PROBE_REP == (k)) ? 0 : 1; pass < 2; ++pass) { const bool dummy = (pass == 0); const size_t omask = dummy ? (size_t)2047 : ~(size_t)0; (void)omask;
#define PROBE_END if (pass == 0) grid.sync(); }
    bf16_t* DUMMY = (bf16_t*)(ws + WS_END);

    if (IN(0)) {
        LAS float* scr = (LAS float*)(lds + wid * 16384);
        constexpr int I_INE = 16 * 192, I_GLU = 16 * 32, I_OUTE = 32 * 32, I_INO = 16 * 192, I_OUTO = 32 * 32;
        constexpr int NIT = I_INE + I_GLU + I_OUTE + I_INO + I_OUTO;
        for (int it = gw; it < NIT; it += NGW) {
            int rr = it;
            if (rr < I_INE) { p0_transpose_item(args.in[2], 1024, 6144, WINE, 0, scr, rr / 192, rr % 192, lane); continue; } rr -= I_INE;
            if (rr < I_GLU) { p0_transpose_item(args.in[11], 1024, 1024, WGLU, 0, scr, rr / 32, rr % 32, lane); continue; } rr -= I_GLU;
            if (rr < I_OUTE) { p0_transpose_item(args.in[14], 2048, 1024, WOUTE, 0, scr, rr / 32, rr % 32, lane); continue; } rr -= I_OUTE;
            if (rr < I_INO) { const int nb = rr % 192; p0_transpose_item(args.in[16], 1024, 6144, WINO, wino_row(32 * nb) - 32 * nb, scr, rr / 192, nb, lane); continue; } rr -= I_INO;
            p0_transpose_item(args.in[20], 2048, 1024, WOUTO, 0, scr, rr / 32, rr % 32, lane);
        }
        for (int m = gw; m < M; m += NGW) {
            const f32x4* xr = (const f32x4*)(x + (size_t)m * D) + lane; const f32x4* gr = (const f32x4*)args.in[1] + lane;
            float s = 0.f; u32x2* o8 = (u32x2*)(XG0 + (size_t)m * D) + lane;
#pragma unroll
            for (int j = 0; j < 4; ++j) { const f32x4 v = xr[64 * j], gg = gr[64 * j]; s += (v.x * v.x + v.y * v.y) + (v.z * v.z + v.w * v.w);
                u32x2 w; w.x = pk2(v.x * gg.x, v.y * gg.y); w.y = pk2(v.z * gg.z, v.w * gg.w); o8[64 * j] = w; }
            s = wave_sum(s); if (lane == 0) RSS0[m] = s;
        }
        for (int e = gtid; e < SEQ * 128; e += NGT) { const int pos = e >> 7, i = e & 127;
            const double inv = exp(-(double)i * (9.210340371976184 / 128.0)); double s, c; sincos_d((double)pos * inv, s, c); COS[e] = (float)c; SIN[e] = (float)s; }
        for (int e = gtid; e < 4096; e += NGT) { const int g = e >> 6, p = e & 63;
            const double lr = fmin((double)args.in[3][e], -1e-4), li = (double)args.in[4][e], dt = exp((double)args.in[5][g]);
            const double mag = exp(lr * dt); double sn, cs; sincos_d(li * dt, sn, cs);
            const double abr = mag * cs, abi = mag * sn, den = lr * lr + li * li, nr = abr - 1.0, ni = abi;
            const double zr = (nr * lr + ni * li) / den, zi = (ni * lr - nr * li) / den;
            double pr = abr, pi = abi;
#pragma unroll
            for (int k = 0; k < 4; ++k) { APOW[e * 8 + 2 * k] = (float)pr; APOW[e * 8 + 2 * k + 1] = (float)pi; const double t = pr * abr - pi * abi; pi = pr * abi + pi * abr; pr = t; }
            double qr = abr, qi = abi;
#pragma unroll
            for (int k = 0; k < 7; ++k) { const double t = qr * qr - qi * qi; qi = 2.0 * qr * qi; qr = t; }
            A128[e * 2] = (float)qr; A128[e * 2 + 1] = (float)qi;
            const float* br = args.in[6] + (size_t)e * 16; const float* bi = args.in[7] + (size_t)e * 16;
#pragma unroll
            for (int k = 0; k < 16; ++k) { const double b_r = br[k], b_i = bi[k];
                BBT[(size_t)(g * 128 + p) * 16 + k] = (bf16_t)f2bf((float)(zr * b_r - zi * b_i)); BBT[(size_t)(g * 128 + 64 + p) * 16 + k] = (bf16_t)f2bf((float)(zr * b_i + zi * b_r)); }
#pragma unroll
            for (int hh = 0; hh < 16; ++hh) { const float c_r = args.in[8][(size_t)(g * 16 + hh) * 64 + p], c_i = args.in[9][(size_t)(g * 16 + hh) * 64 + p];
                CCT[(size_t)(g * 16 + hh) * 128 + 2 * p] = (bf16_t)f2bf(c_r); CCT[(size_t)(g * 16 + hh) * 128 + 2 * p + 1] = (bf16_t)f2bf(-c_i); }
        }
        for (int e = gtid; e < M; e += NGT) { RSS1[e] = 0.f; VSUM[e] = 0.f; VSQ[e] = 0.f; RSS2[e] = 0.f; }
        __syncthreads();
    }
    SEAM(0);
    if (IN(1)) {
        pg8::Gemm g{XG0, WINE, M, 6144, 1024}; pg8::StaticOrder S; S.init(M, 6144, G, bid);
        Epi1 E{RSS0, U, CAT, Kb, Vb, SZB, COS, SIN};
        pg8::gemm_phase<Epi1, pg8::StaticOrder, true, true>(lds, g, S, E);
    }
    SEAM(1);
    if (IN(2)) {
        for (int it = gw; it < 2 * 64 * 64; it += NGW) { const int g = it & 63, c = (it >> 6) & 63, b = it >> 12;
            s5_item<false>(b, c, g, U, CHS, APOW, BBT, CCT, args.in[10], lds + wid * 8704, lane); }
        __syncthreads();
        LAS bf16_t* Vs = (LAS bf16_t*)lds; LAS bf16_t* Ks = (LAS bf16_t*)(lds + 34816);
        const int wm = wid >> 1, wn = wid & 1, h5_ = lane >> 5, r_ = lane & 31;
        u32x4 pv[4], pk[4];
#define RA_LOAD(IT) do { const int kt_ = (IT) & 1, vt_ = ((IT) >> 1) & 1, hh_ = ((IT) >> 2) & 3, c_ = ((IT) >> 4) & 63, b_ = (IT) >> 10; const size_t rw0 = (size_t)b_ * SEQ + (size_t)c_ * 128; \
            _Pragma("unroll") for (int i = 0; i < 4; ++i) { const int idx = tid + NTHR * i, row = idx >> 4, ch = idx & 15; \
                pv[i] = *(const u32x4*)(Vb + (rw0 + row) * 1024 + hh_ * 256 + vt_ * 128 + ch * 8); pk[i] = *(const u32x4*)(Kb + (rw0 + row) * 1024 + hh_ * 256 + kt_ * 128 + ch * 8); } } while (0)
        if (bid < 2048) RA_LOAD(bid);
        for (int it = bid; it < 2048; it += G) {
            const int kt = it & 1, vt = (it >> 1) & 1, hh = (it >> 2) & 3, c = (it >> 4) & 63, b = it >> 10;
            const float lg = lg_gamma(hh);
            int h5 = h5_, r = r_; asm volatile("" : "+v"(h5), "+v"(r));
#pragma unroll
            for (int i = 0; i < 4; ++i) { const int idx = tid + NTHR * i, row = idx >> 4, ch = idx & 15;
                const float z = __builtin_amdgcn_exp2f((float)(127 - row) * lg); const u32x4 w = pv[i]; u32x4 o;
                o.x = pk2(bflo(w.x) * z, bfhi(w.x) * z); o.y = pk2(bflo(w.y) * z, bfhi(w.y) * z); o.z = pk2(bflo(w.z) * z, bfhi(w.z) * z); o.w = pk2(bflo(w.w) * z, bfhi(w.w) * z);
                *(LAS u32x4*)(Vs + row * 136 + ch * 8) = o; *(LAS u32x4*)(Ks + row * 136 + ch * 8) = pk[i]; }
            __syncthreads();
            if (it + G < 2048) RA_LOAD(it + G);
            f32x16 acc[2] = {ZERO16, ZERO16};
#pragma unroll 4
            for (int ks = 0; ks < 8; ++ks) { const int m0 = 16 * ks + 8 * h5;
                const bf16x8 a = gather8(Vs + m0 * 136 + 32 * wm + r, 136);
#pragma unroll
                for (int nt = 0; nt < 2; ++nt) { const bf16x8 bb = gather8(Ks + m0 * 136 + 64 * wn + 32 * nt + r, 136); acc[nt] = MFMA32(bb, a, acc[nt]); } }
            bf16_t* dst = STATE + ((size_t)((b * 64 + c) * 4 + hh) * 256 + vt * 128 + 32 * wm + r) * 256 + kt * 128 + 64 * wn + 4 * h5;
#pragma unroll
            for (int nt = 0; nt < 2; ++nt)
#pragma unroll
                for (int iq = 0; iq < 4; ++iq) { u32x2 w; w.x = pk2(acc[nt][4 * iq], acc[nt][4 * iq + 1]); w.y = pk2(acc[nt][4 * iq + 2], acc[nt][4 * iq + 3]); *(u32x2*)(dst + 32 * nt + 8 * iq) = w; }
            __syncthreads();
        }
#undef RA_LOAD
    }
    SEAM(2);
    if (IN(3)) {
        for (int e = gtid; e < 131072; e += NGT) { const int bh = e >> 14, idx4 = e & 16383, b = bh >> 2, hh = bh & 3;
            const float cd = __builtin_amdgcn_exp2f(128.f * lg_gamma(hh)); float s0 = 0.f, s1 = 0.f, s2 = 0.f, s3 = 0.f;
            u32x2* p = (u32x2*)(STATE + ((size_t)(b * 64) * 4 + hh) * 65536 + (size_t)idx4 * 4);
#pragma unroll 8
            for (int c = 0; c < 64; ++c) { u32x2* q = p + (size_t)c * (4 * 65536 / 4); const u32x2 w = *q;
                u32x2 o; o.x = pk2(s0, s1); o.y = pk2(s2, s3); *q = o;
                s0 = s0 * cd + bflo(w.x); s1 = s1 * cd + bfhi(w.x); s2 = s2 * cd + bflo(w.y); s3 = s3 * cd + bfhi(w.y); } }
        for (int e = gtid; e < 8192; e += NGT) { const int b = e >> 12, gp = e & 4095; const float ar = A128[gp * 2], ai = A128[gp * 2 + 1]; float cr = 0.f, ci = 0.f;
            for (int c = 0; c < 64; ++c) { float* q = CHS + ((size_t)(b * 64 + c) * 4096 + gp) * 2; const float lr_ = q[0], li_ = q[1]; q[0] = cr; q[1] = ci;
                const float t = ar * cr - ai * ci + lr_; ci = ar * ci + ai * cr + li_; cr = t; } }
    }
    SEAM(3);
    if (IN(4)) {
        for (int it = gw; it < 2 * 64 * 64; it += NGW) { const int g = it & 63, c = (it >> 6) & 63, b = it >> 12;
            s5_item<true>(b, c, g, U, CHS, APOW, BBT, CCT, args.in[10], lds + wid * 8704, lane); }
        __syncthreads();
        LAS bf16_t* Qs = (LAS bf16_t*)lds; LAS bf16_t* Ks = (LAS bf16_t*)(lds + 67584); LAS bf16_t* Ps = (LAS bf16_t*)(lds + 67584); LAS bf16_t* Xs = (LAS bf16_t*)(lds + 67584 + 34816);
        LAS float* red = (LAS float*)lds;
        const int wm = wid >> 1, wn = wid & 1, h5_ = lane >> 5, r_ = lane & 31;
        const float* gain = args.in[13];
#define OPQ() asm volatile("" : "+v"(h5), "+v"(r))
        for (int it = bid; it < 512; it += G) {
            const int hh = it & 3, c = (it >> 2) & 63, b = it >> 8;
            const size_t row0 = (size_t)b * SEQ + (size_t)c * 128; const float lg = lg_gamma(hh);
            int h5 = h5_, r = r_; OPQ();
#pragma unroll 4
            for (int i = 0; i < 8; ++i) { const int idx = tid + NTHR * i, row = idx >> 5, ch = idx & 31;
                *(LAS u32x4*)(Qs + row * 264 + ch * 8) = *(const u32x4*)(CAT + (row0 + row) * 2048 + 1024 + hh * 256 + ch * 8);
                *(LAS u32x4*)(Ks + row * 264 + ch * 8) = *(const u32x4*)(Kb + (row0 + row) * 1024 + hh * 256 + ch * 8); }
            __syncthreads();
            u32x4 pvv[4], pc[2];
#define RC_LOADV(VH) do { _Pragma("unroll") for (int i = 0; i < 4; ++i) { const int idx = tid + NTHR * i, row = idx >> 4, ch = idx & 15; pvv[i] = *(const u32x4*)(Vb + (row0 + row) * 1024 + hh * 256 + (VH) * 128 + ch * 8); } } while (0)
#define RC_STOREV() do { _Pragma("unroll") for (int i = 0; i < 4; ++i) { const int idx = tid + NTHR * i, row = idx >> 4, ch = idx & 15; *(LAS u32x4*)(Xs + row * 136 + ch * 8) = pvv[i]; } } while (0)
#define RC_LOADC(STP, KC) do { _Pragma("unroll") for (int i = 0; i < 2; ++i) { const int idx = tid + NTHR * i, row = idx >> 3, ch = idx & 7; pc[i] = *(const u32x4*)((STP) + (size_t)row * 256 + (KC) * 64 + ch * 8); } } while (0)
#define RC_STOREC() do { _Pragma("unroll") for (int i = 0; i < 2; ++i) { const int idx = tid + NTHR * i, row = idx >> 3, ch = idx & 7; *(LAS u32x4*)(Xs + row * 72 + ch * 8) = pc[i]; } } while (0)
            RC_LOADV(0);
            f32x16 sacc[2] = {ZERO16, ZERO16};
#pragma unroll 4
            for (int ks = 0; ks < 16; ++ks) { const int k0 = 16 * ks + 8 * h5;
                const bf16x8 a = *(const LAS bf16x8*)(Qs + (32 * wm + r) * 264 + k0);
#pragma unroll
                for (int nt = 0; nt < 2; ++nt) { const bf16x8 bb = *(const LAS bf16x8*)(Ks + (64 * wn + 32 * nt + r) * 264 + k0); sacc[nt] = MFMA32(bb, a, sacc[nt]); } }
            __syncthreads();
            OPQ();
            { const int n = 32 * wm + r;
#pragma unroll
              for (int nt = 0; nt < 2; ++nt)
#pragma unroll
                for (int iq = 0; iq < 4; ++iq) { const int m0 = 64 * wn + 32 * nt + 8 * iq + 4 * h5; float pvl[4];
#pragma unroll
                    for (int j = 0; j < 4; ++j) { const int mc = m0 + j; pvl[j] = (n >= mc) ? sacc[nt][4 * iq + j] * __builtin_amdgcn_exp2f(-(float)(mc + 1) * lg) : 0.f; }
                    u32x2 w; w.x = pk2(pvl[0], pvl[1]); w.y = pk2(pvl[2], pvl[3]); *(LAS u32x2*)(Ps + n * 136 + m0) = w; } }
            RC_STOREV();
            __syncthreads();
            f32x16 oacc[2][2] = {{ZERO16, ZERO16}, {ZERO16, ZERO16}};
#pragma unroll
            for (int vh = 0; vh < 2; ++vh) {
                OPQ();
                const bf16_t* st = STATE + ((size_t)((b * 64 + c) * 4 + hh) * 256 + vh * 128) * 256;
                RC_LOADC(st, 0);
#pragma unroll 2
                for (int ks = 0; ks < 8; ++ks) { const int m0 = 16 * ks + 8 * h5;
                    const bf16x8 a = *(const LAS bf16x8*)(Ps + (32 * wm + r) * 136 + m0);
#pragma unroll
                    for (int nt = 0; nt < 2; ++nt) { const bf16x8 bb = gather8(Xs + m0 * 136 + 64 * wn + 32 * nt + r, 136); oacc[vh][nt] = MFMA32(bb, a, oacc[vh][nt]); } }
#pragma unroll 1
                for (int kc = 0; kc < 4; ++kc) {
                    __syncthreads();
                    RC_STOREC();
                    __syncthreads();
                    if (kc < 3) RC_LOADC(st, kc + 1); else if (vh == 0) RC_LOADV(1);
#pragma unroll
                    for (int ks = 0; ks < 4; ++ks) { const int k0 = 16 * ks + 8 * h5;
                        const bf16x8 a = *(const LAS bf16x8*)(Qs + (32 * wm + r) * 264 + kc * 64 + k0);
#pragma unroll
                        for (int nt = 0; nt < 2; ++nt) { const bf16x8 bb = *(const LAS bf16x8*)(Xs + (64 * wn + 32 * nt + r) * 72 + k0); oacc[vh][nt] = MFMA32(bb, a, oacc[vh][nt]); } }
                }
                __syncthreads();
                if (vh == 0) { RC_STOREV(); __syncthreads(); }
            }
            OPQ();
            const int n = 32 * wm + r; const float xi = __builtin_amdgcn_exp2f((float)(n + 1) * lg);
            float s = 0.f, q = 0.f;
#pragma unroll
            for (int vh = 0; vh < 2; ++vh)
#pragma unroll
                for (int nt = 0; nt < 2; ++nt)
#pragma unroll
                    for (int i = 0; i < 16; ++i) { const float o = oacc[vh][nt][i] * xi; oacc[vh][nt][i] = o; s += o; q += o * o; }
            s += __shfl_xor(s, 32); q += __shfl_xor(q, 32);
            if (h5 == 0) { red[(wn * 128 + n) * 2] = s; red[(wn * 128 + n) * 2 + 1] = q; }
            __syncthreads();
            OPQ();
            { const float st_ = red[n * 2] + red[(128 + n) * 2], qt = red[n * 2 + 1] + red[(128 + n) * 2 + 1];
              const float mu = st_ * (1.f / 256.f), var = fmaxf(qt * (1.f / 256.f) - mu * mu, 0.f), rstd = __builtin_amdgcn_rsqf(var + EPS);
#pragma unroll
              for (int vh = 0; vh < 2; ++vh)
#pragma unroll
                for (int nt = 0; nt < 2; ++nt)
#pragma unroll
                    for (int iq = 0; iq < 4; ++iq) { const int col = hh * 256 + vh * 128 + 64 * wn + 32 * nt + 8 * iq + 4 * h5;
                        const f32x4 gv = *(const f32x4*)(gain + col); const u32x2 zz = *(const u32x2*)(SZB + (row0 + n) * 1024 + col);
                        const float y0 = (oacc[vh][nt][4 * iq] - mu) * rstd * gv.x * bflo(zz.x), y1 = (oacc[vh][nt][4 * iq + 1] - mu) * rstd * gv.y * bfhi(zz.x);
                        const float y2 = (oacc[vh][nt][4 * iq + 2] - mu) * rstd * gv.z * bflo(zz.y), y3 = (oacc[vh][nt][4 * iq + 3] - mu) * rstd * gv.w * bfhi(zz.y);
                        u32x2 w; w.x = pk2(y0, y1); w.y = pk2(y2, y3); *(u32x2*)(CAT + (row0 + n) * 2048 + 1024 + col) = w; } }
            __syncthreads();
        }
#undef RC_LOADV
#undef RC_STOREV
#undef RC_LOADC
#undef RC_STOREC
    }
    SEAM(4);
    if (IN(5)) {
        pg8::Gemm g{U, WGLU, M, 1024, 1024}; pg8::StaticOrder S; S.init(M, 1024, G, bid);
        EpiGlu E{args.in[12], U, CAT};
        pg8::gemm_phase<EpiGlu, pg8::StaticOrder, true, true>(lds, g, S, E);
    }
    SEAM(5);
    if (IN(6)) {
        pg8::Gemm g{CAT, WOUTE, M, 1024, 2048}; pg8::StaticOrder S; S.init(M, 1024, G, bid);
        EpiOut E{x, X1, U, args.in[15], RSS1};
        pg8::gemm_phase<EpiOut, pg8::StaticOrder, true, true>(lds, g, S, E);
    }
    SEAM(6);
    if (IN(7)) {
        pg8::Gemm g{U, WINO, M, 2048, 1024}; pg8::StaticOrder S; S.init(M, 2048, G, bid);
        Epi7 E{RSS1, VB, VSUM, VSQ};
        pg8::gemm_phase<Epi7, pg8::StaticOrder, true, true>(lds, g, S, E);
    }
    SEAM(7);
    if (IN(8)) {
        LAS bf16_t* Wsm = (LAS bf16_t*)lds; LAS bf16_t* Vs = (LAS bf16_t*)(lds + 34816);
        const int wm = wid >> 1, wn = wid & 1, h5_ = lane >> 5, r_ = lane & 31;
        const float* vgain = args.in[17]; const float* wsp = args.in[18]; const float* bsp = args.in[19];
        u32x4 pvv[4]; f32x4 pw[4][2], pg[2]; float psum[4], psq[4];
#define SG_LOAD(IT) do { const int ds_ = (IT) & 3, gg_ = ((IT) >> 2) & 3, c_ = ((IT) >> 4) & 63, b_ = (IT) >> 10; const size_t rw0 = (size_t)b_ * SEQ + (size_t)c_ * 128; const int cl0 = gg_ * 512 + ds_ * 128; \
            pg[0] = *(const f32x4*)(vgain + cl0 + (tid & 15) * 8); pg[1] = *(const f32x4*)(vgain + cl0 + (tid & 15) * 8 + 4); \
            _Pragma("unroll") for (int i = 0; i < 4; ++i) { const int idx = tid + NTHR * i, row = idx >> 4, ch = idx & 15; \
                const float* wp = wsp + ((size_t)gg_ * 128 + row) * 128 + ch * 8; pw[i][0] = *(const f32x4*)wp; pw[i][1] = *(const f32x4*)(wp + 4); \
                pvv[i] = *(const u32x4*)(VB + (rw0 + row) * 2048 + cl0 + ch * 8); psum[i] = VSUM[rw0 + row]; psq[i] = VSQ[rw0 + row]; } } while (0)
        if (bid < 2048) SG_LOAD(bid);
        for (int it = bid; it < 2048; it += G) {
            const int ds = it & 3, gg = (it >> 2) & 3, c = (it >> 4) & 63, b = it >> 10;
            const size_t row0 = (size_t)b * SEQ + (size_t)c * 128; const int col0 = gg * 512 + ds * 128;
            int h5 = h5_, r = r_; asm volatile("" : "+v"(h5), "+v"(r));
#pragma unroll
            for (int i = 0; i < 4; ++i) { const int idx = tid + NTHR * i, row = idx >> 4, ch = idx & 15;
                float w[8] = {pw[i][0].x, pw[i][0].y, pw[i][0].z, pw[i][0].w, pw[i][1].x, pw[i][1].y, pw[i][1].z, pw[i][1].w};
#pragma unroll
                for (int j = 0; j < 8; ++j) w[j] = (ch * 8 + j <= row) ? w[j] : 0.f;
                u32x4 o; o.x = pk2(w[0], w[1]); o.y = pk2(w[2], w[3]); o.z = pk2(w[4], w[5]); o.w = pk2(w[6], w[7]);
                *(LAS u32x4*)(Wsm + row * 136 + ch * 8) = o;
                const float mu = psum[i] * (1.f / 2048.f), var = fmaxf(psq[i] * (1.f / 2048.f) - mu * mu, 0.f), rstd = __builtin_amdgcn_rsqf(var + EPS);
                const u32x4 vv = pvv[i]; u32x4 o2;
                o2.x = pk2((bflo(vv.x) - mu) * rstd * pg[0].x, (bfhi(vv.x) - mu) * rstd * pg[0].y); o2.y = pk2((bflo(vv.y) - mu) * rstd * pg[0].z, (bfhi(vv.y) - mu) * rstd * pg[0].w);
                o2.z = pk2((bflo(vv.z) - mu) * rstd * pg[1].x, (bfhi(vv.z) - mu) * rstd * pg[1].y); o2.w = pk2((bflo(vv.w) - mu) * rstd * pg[1].z, (bfhi(vv.w) - mu) * rstd * pg[1].w);
                *(LAS u32x4*)(Vs + row * 136 + ch * 8) = o2; }
            __syncthreads();
            if (it + G < 2048) SG_LOAD(it + G);
            f32x16 acc[2] = {ZERO16, ZERO16};
            const int nks = 2 * wm + 2;
#pragma unroll 2
            for (int ks = 0; ks < nks; ++ks) { const int m0 = 16 * ks + 8 * h5;
                const bf16x8 a = *(const LAS bf16x8*)(Wsm + (32 * wm + r) * 136 + m0);
#pragma unroll
                for (int nt = 0; nt < 2; ++nt) { const bf16x8 bb = gather8(Vs + m0 * 136 + 64 * wn + 32 * nt + r, 136); acc[nt] = MFMA32(bb, a, acc[nt]); } }
            const int t = 32 * wm + r; const float bias = bsp[gg * 128 + t];
            bf16_t* dst = VB + (row0 + t) * 2048 + col0 + 64 * wn + 4 * h5;
#pragma unroll
            for (int nt = 0; nt < 2; ++nt)
#pragma unroll
                for (int iq = 0; iq < 4; ++iq) { u32x2 w; w.x = pk2(acc[nt][4 * iq] + bias, acc[nt][4 * iq + 1] + bias); w.y = pk2(acc[nt][4 * iq + 2] + bias, acc[nt][4 * iq + 3] + bias); *(u32x2*)(dst + 32 * nt + 8 * iq) = w; }
            __syncthreads();
        }
#undef SG_LOAD
    }
    SEAM(8);
    if (IN(9)) {
        pg8::Gemm g{U, WINO + (size_t)2048 * 1024, M, 4096, 1024}; pg8::StaticOrder S; S.init(M, 4096, G, bid);
        Epi9 E{RSS1, VB, CAT};
        pg8::gemm_phase<Epi9, pg8::StaticOrder, true, true>(lds, g, S, E);
    }
    SEAM(9);
    if (IN(10)) {
        pg8::Gemm g{CAT, WOUTO, M, 1024, 2048}; pg8::StaticOrder S; S.init(M, 1024, G, bid);
        EpiOut E{X1, X1, nullptr, nullptr, RSS2};
        pg8::gemm_phase<EpiOut, pg8::StaticOrder, true, true>(lds, g, S, E);
    }
    SEAM(10);
    if (IN(11)) {
        for (int m = gw; m < M; m += NGW) {
            const f32x4* xr = (const f32x4*)(X1 + (size_t)m * D) + lane; const f32x4* gr = (const f32x4*)args.in[21] + lane; f32x4* o = (f32x4*)(args.out + (size_t)m * D) + lane;
            const float rs = __builtin_amdgcn_rsqf(RSS2[m] * (1.f / 1024.f) + EPS);
#pragma unroll
            for (int j = 0; j < 4; ++j) { const f32x4 v = xr[64 * j], gg = gr[64 * j]; o[64 * j] = (f32x4){v.x * rs * gg.x, v.y * rs * gg.y, v.z * rs * gg.z, v.w * rs * gg.w}; }
        }
    }
#undef IN
#undef SEAM
}

extern "C" void kernel_launch(void* const* d_in, const int* in_sizes, int n_in, void* d_out, int out_size, void* d_ws, size_t ws_size, hipStream_t stream) {
    static int grid = 0;
    if (grid == 0) {
        if (n_in != 22 || out_size != M * D || ws_size < WS_END) { fprintf(stderr, "kernel_launch: unexpected shapes (n_in %d out %d ws %zu)\n", n_in, out_size, ws_size); grid = -1; return; }
        int dev = 0, cus = 0, per_cu = 0;
        hipGetDevice(&dev); hipDeviceGetAttribute(&cus, hipDeviceAttributeMultiprocessorCount, dev);
        if (hipFuncSetAttribute((const void*)mk_fwd, hipFuncAttributeMaxDynamicSharedMemorySize, LDS_BYTES) != hipSuccess) { fprintf(stderr, "kernel_launch: hipFuncSetAttribute failed\n"); grid = -1; return; }
        if (hipOccupancyMaxActiveBlocksPerMultiprocessor(&per_cu, (const void*)mk_fwd, NTHR, LDS_BYTES) != hipSuccess || per_cu < 1) { fprintf(stderr, "kernel_launch: occupancy query says %d\n", per_cu); grid = -1; return; }
        grid = cus * (per_cu > 1 ? 1 : per_cu);
    }
    if (grid < 0) return;
    if (hipMemsetAsync((char*)d_ws + WS_BAR, 0, BAR_BYTES, stream) != hipSuccess) { fprintf(stderr, "kernel_launch: memset failed\n"); return; }
    Args a{};
    for (int i = 0; i < 22; ++i) a.in[i] = (const float*)d_in[i];
    a.out = (float*)d_out; a.ws = (unsigned char*)d_ws;
#if MK_PER_PHASE
#ifdef PROBE_PREFIX
    for (int p = 0; p <= PROBE_PREFIX; ++p) { a.ph_lo = p; a.ph_hi = p + 1; hipLaunchKernelGGL(mk_fwd, dim3(grid), dim3(NTHR), LDS_BYTES, stream, a); }
#endif
    for (int p = 0; p < NPH; ++p) { a.ph_lo = p; a.ph_hi = p + 1; hipLaunchKernelGGL(mk_fwd, dim3(grid), dim3(NTHR), LDS_BYTES, stream, a); }
#else
    a.ph_lo = 0; a.ph_hi = NPH;
    void* kargs[] = {&a};
    hipError_t e = hipLaunchCooperativeKernel((const void*)mk_fwd, dim3(grid), dim3(NTHR), kargs, LDS_BYTES, stream);
    if (e != hipSuccess) fprintf(stderr, "kernel_launch: cooperative launch failed: %s (grid %d)\n", hipGetErrorString(e), grid);
#endif
}
```

```cpp
#include <hip/hip_runtime.h>
#include <hip/hip_cooperative_groups.h>
#include <cstdio>
#include <cstdint>
namespace cg = cooperative_groups;
namespace pg8 {
#define PG8_LAS __attribute__((address_space(3)))
typedef unsigned short bf16_t;
typedef short bf16x8 __attribute__((ext_vector_type(8)));
typedef float f32x4 __attribute__((ext_vector_type(4)));
typedef unsigned u32x4 __attribute__((ext_vector_type(4)));
constexpr int BM = 256, BK = 64, HALF = 128, HTB = HALF * BK * 2  , STAGE_BYTES = 8 * HTB, NXCD = 8, WGM = 8;

__host__ __device__ __forceinline__ int lds_byte(int r, int c) { const int st = (r >> 4) * 2 + (c >> 5), rr = r & 15, cc = c & 31, ob = rr * 64 + cc * 2; return st * 1024 + (ob ^ (((ob >> 9) & 1) << 5)); }
__host__ __device__ __forceinline__ void stage_rc(int b, int& R, int& C) { const int st = b / 1024, sb = b % 1024, swz = sb ^ (((sb >> 9) & 1) << 5); R = (st >> 1) * 16 + swz / 64; C = (st & 1) * 32 + (swz % 64) / 2; }
__host__ __device__ __forceinline__ int perm32(int rho) { const int n = rho >> 4, i = rho & 15; return 8 * (i >> 2) + 4 * n + (i & 3); }

struct Unit { int pm, pn; };
struct Gemm { const bf16_t* A; const bf16_t* Bt; int M, N, K; };

struct StaticOrder {
    int nM, nN, nwg, G, c;
    __host__ __device__ void init(int M, int N, int G_, int c_) { nM = M / BM; nN = N / BM; nwg = nM * nN; G = G_; c = c_; }
    __host__ __device__ bool next(int i, Unit& u) const {
        const long L = (long)i * G + c; if (L >= nwg) return false;
        int wgid = (int)L; { const int q = nwg / NXCD, r = nwg % NXCD, xcd = wgid % NXCD, off = wgid / NXCD; wgid = (xcd < r ? xcd * (q + 1) : r * (q + 1) + (xcd - r) * q) + off; }
        const int nig = WGM * nN, gid = wgid / nig, fm = gid * WGM, gsz = (nM - fm) < WGM ? (nM - fm) : WGM;
        u.pm = fm + ((wgid % nig) % gsz); u.pn = (wgid % nig) / gsz; return true;
    }
    __device__ __forceinline__ void a_ready(const Unit&) const {}
    __device__ __forceinline__ void done(const Unit&) const {}
};

__device__ __forceinline__ unsigned cvt_pk_bf16(float lo, float hi) { unsigned r; asm volatile("v_cvt_pk_bf16_f32 %0, %1, %2" : "=v"(r) : "v"(lo), "v"(hi)); return r; }
template <class Epi, class Sched, bool ALIGN_EPI = false, bool SP2 = false>
__device__ __forceinline__ void gemm_phase(PG8_LAS unsigned char* lds, const Gemm g, const Sched& S, const Epi& E) {
    const int tid = threadIdx.x, wid = __builtin_amdgcn_readfirstlane(tid >> 6), lane = tid & 63, wr = wid >> 2, wc = wid & 3, fr = lane & 15, fq = lane >> 4;
    const int K = g.K, nt = K / BK;
    unsigned voffA[2], voffB[2];
#pragma unroll
    for (int i = 0; i < 2; ++i) { int R, C; stage_rc(tid * 16 + i * 8192, R, C); const int Rb = Epi::PERM ? ((R & ~31) + perm32(R & 31)) : R;
        voffA[i] = (unsigned)(R * K + C) * 2u; voffB[i] = (unsigned)(Rb * K + C) * 2u; }
    const size_t kstep = (size_t)(BK * 2);
    const size_t hstep = (size_t)HALF * K * 2;
    const size_t tstep = 2 * hstep;
    const unsigned ldsw = (unsigned)wid * 1024u;
    const int aoff = lds_byte(wr * 64 + fr, fq * 8), boff = lds_byte(wc * 32 + fr, fq * 8);
#define PG8_SA(b, h) (((b) * 2 + (h)) * HTB)
#define PG8_SB(b, h) ((4 + (b) * 2 + (h)) * HTB)
#define PG8_STAGE(bufoff, gbase, voff) do { _Pragma("unroll") for (int _i = 0; _i < 2; ++_i) \
        __builtin_amdgcn_global_load_lds((const unsigned*)((const char*)(gbase) + (voff)[_i]), (PG8_LAS unsigned*)(lds + (bufoff) + ldsw + _i * 8192), 16, 0, 0); } while (0)
#define PG8_LDA(dst, b, h) do { _Pragma("unroll") for (int m = 0; m < 4; ++m) _Pragma("unroll") for (int k = 0; k < 2; ++k) dst[m][k] = *(const PG8_LAS bf16x8*)(lds + PG8_SA(b, h) + aoff + m * 2048 + k * 1024); } while (0)
#define PG8_LDB(dst, b, h) do { _Pragma("unroll") for (int n = 0; n < 2; ++n) _Pragma("unroll") for (int k = 0; k < 2; ++k) dst[n][k] = *(const PG8_LAS bf16x8*)(lds + PG8_SB(b, h) + boff + n * 2048 + k * 1024); } while (0)
#define PG8_MMA(ai, bj, At, Bt) do { __builtin_amdgcn_s_setprio(1); _Pragma("unroll") for (int m = 0; m < 4; ++m) _Pragma("unroll") for (int n = 0; n < 2; ++n) _Pragma("unroll") for (int k = 0; k < 2; ++k) \
        acc[ai][bj][m][n] = __builtin_amdgcn_mfma_f32_16x16x32_bf16(Bt[n][k], At[m][k], acc[ai][bj][m][n], 0, 0, 0); __builtin_amdgcn_s_setprio(0); } while (0)
#define PG8_WAIT_V(n) asm volatile("s_waitcnt vmcnt(" #n ")" ::: "memory")
#define PG8_WAIT_L(n) asm volatile("s_waitcnt lgkmcnt(" #n ")" ::: "memory")
#define PG8_BAR __builtin_amdgcn_s_barrier()
#define PG8_SCHED __builtin_amdgcn_sched_barrier(0)
    Unit cur, nxt; int ui = 0;
    if (!S.next(0, cur)) return;
    f32x4 acc[2][2][4][2];
#pragma unroll
    for (int a = 0; a < 2; ++a)
#pragma unroll
        for (int b = 0; b < 2; ++b)
#pragma unroll
            for (int m = 0; m < 4; ++m)
#pragma unroll
                for (int n = 0; n < 2; ++n) acc[a][b][m][n] = (f32x4){0.f, 0.f, 0.f, 0.f};
    bf16x8 At[4][2], B0[2][2], B1[2][2];
    const char* cA = (const char*)g.A + (size_t)cur.pm * tstep; const char* cB = (const char*)g.Bt + (size_t)cur.pn * tstep;
    S.a_ready(cur);
    if constexpr (SP2) {
        PG8_STAGE(PG8_SB(0, 0), cB, voffB); PG8_STAGE(PG8_SB(0, 1), cB + hstep, voffB); PG8_STAGE(PG8_SA(0, 0), cA, voffA); PG8_STAGE(PG8_SA(0, 1), cA + hstep, voffA);
        if (wr == 1) PG8_BAR;
        PG8_WAIT_V(2); PG8_BAR;
        PG8_STAGE(PG8_SB(1, 0), cB + kstep, voffB); PG8_STAGE(PG8_SA(1, 0), cA + kstep, voffA); PG8_STAGE(PG8_SB(1, 1), cB + hstep + kstep, voffB);
        PG8_WAIT_V(6); PG8_BAR;
    } else {
        PG8_STAGE(PG8_SB(0, 0), cB, voffB); PG8_STAGE(PG8_SA(0, 0), cA, voffA); PG8_STAGE(PG8_SB(0, 1), cB + hstep, voffB); PG8_STAGE(PG8_SA(0, 1), cA + hstep, voffA);
        if (wr == 1) PG8_BAR;
        PG8_WAIT_V(4); PG8_BAR;
        PG8_STAGE(PG8_SB(1, 0), cB + kstep, voffB); PG8_STAGE(PG8_SA(1, 0), cA + kstep, voffA); PG8_STAGE(PG8_SB(1, 1), cB + hstep + kstep, voffB);
        PG8_WAIT_V(6); PG8_BAR;
    }
    for (;;) {
        const bool has_next = S.next(ui + 1, nxt);
        const char* nA = has_next ? (const char*)g.A + (size_t)nxt.pm * tstep : cA; const char* nB = has_next ? (const char*)g.Bt + (size_t)nxt.pn * tstep : cB;
        for (int t = 0; t < nt; t += 2) {
            const bool last = (t == nt - 2);
            const char* a1 = cA + (size_t)(t + 1) * kstep;
            const char* a2 = last ? nA : cA + (size_t)(t + 2) * kstep; const char* b2 = last ? nB : cB + (size_t)(t + 2) * kstep;
            const char* a3 = a2 + kstep; const char* b3 = b2 + kstep;
            if (last && has_next) S.a_ready(nxt);
            if constexpr (SP2) {
            PG8_LDB(B0, 0, 0); PG8_LDB(B1, 0, 1); PG8_SCHED; PG8_LDA(At, 0, 0); PG8_STAGE(PG8_SA(1, 1), a1 + hstep, voffA);
            PG8_WAIT_V(8); PG8_WAIT_L(0); PG8_BAR; PG8_MMA(0, 0, At, B0); PG8_MMA(0, 1, At, B1); PG8_BAR; PG8_SCHED;
            PG8_LDA(At, 0, 1); PG8_STAGE(PG8_SB(0, 0), b2, voffB); PG8_STAGE(PG8_SB(0, 1), b2 + hstep, voffB); PG8_STAGE(PG8_SA(0, 0), a2, voffA);
            PG8_WAIT_V(8); PG8_WAIT_L(0); PG8_BAR; PG8_MMA(1, 0, At, B0); PG8_MMA(1, 1, At, B1); PG8_BAR; PG8_SCHED;
            PG8_LDB(B0, 1, 0); PG8_LDB(B1, 1, 1); PG8_SCHED; PG8_LDA(At, 1, 0); PG8_STAGE(PG8_SA(0, 1), a2 + hstep, voffA);
            PG8_WAIT_V(8); PG8_WAIT_L(0); PG8_BAR; PG8_MMA(0, 0, At, B0); PG8_MMA(0, 1, At, B1); PG8_BAR; PG8_SCHED;
            PG8_LDA(At, 1, 1); PG8_STAGE(PG8_SB(1, 0), b3, voffB); PG8_STAGE(PG8_SB(1, 1), b3 + hstep, voffB); PG8_STAGE(PG8_SA(1, 0), a3, voffA);
            PG8_WAIT_V(8); PG8_WAIT_L(0); PG8_BAR; PG8_MMA(1, 0, At, B0); PG8_MMA(1, 1, At, B1); PG8_BAR; PG8_SCHED;
            } else {
            PG8_LDB(B0, 0, 0); PG8_SCHED; PG8_LDA(At, 0, 0); PG8_STAGE(PG8_SA(1, 1), a1 + hstep, voffA);
            PG8_WAIT_L(8); PG8_BAR; PG8_WAIT_L(0); PG8_MMA(0, 0, At, B0); PG8_BAR; PG8_SCHED;
            PG8_LDB(B1, 0, 1); PG8_STAGE(PG8_SB(0, 0), b2, voffB);
            PG8_BAR; PG8_WAIT_L(0); PG8_MMA(0, 1, At, B1); PG8_BAR;
            PG8_LDA(At, 0, 1); PG8_STAGE(PG8_SA(0, 0), a2, voffA);
            PG8_BAR; PG8_WAIT_L(0); PG8_MMA(1, 0, At, B0); PG8_BAR; PG8_SCHED;
            PG8_STAGE(PG8_SB(0, 1), b2 + hstep, voffB);
            PG8_WAIT_V(6); PG8_BAR; PG8_MMA(1, 1, At, B1); PG8_BAR;
            PG8_LDB(B0, 1, 0); PG8_SCHED; PG8_LDA(At, 1, 0); PG8_STAGE(PG8_SA(0, 1), a2 + hstep, voffA);
            PG8_WAIT_L(8); PG8_BAR; PG8_WAIT_L(0); PG8_MMA(0, 0, At, B0); PG8_BAR; PG8_SCHED;
            PG8_LDB(B1, 1, 1); PG8_STAGE(PG8_SB(1, 0), b3, voffB);
            PG8_BAR; PG8_WAIT_L(0); PG8_MMA(0, 1, At, B1); PG8_BAR;
            PG8_LDA(At, 1, 1); PG8_STAGE(PG8_SA(1, 0), a3, voffA);
            PG8_BAR; PG8_WAIT_L(0); PG8_MMA(1, 0, At, B0); PG8_BAR; PG8_SCHED;
            PG8_STAGE(PG8_SB(1, 1), b3 + hstep, voffB);
            PG8_WAIT_V(6); PG8_BAR; PG8_MMA(1, 1, At, B1); PG8_BAR;
            }
        }
        if constexpr (ALIGN_EPI) { if (wr == 0) PG8_BAR; }
        if constexpr (!Epi::AFTER_DRAIN) { E(acc, cur, wr, wc, fr, fq); S.done(cur); }
        if (!has_next) break;
#pragma unroll
        for (int a = 0; a < 2; ++a)
#pragma unroll
            for (int b = 0; b < 2; ++b)
#pragma unroll
                for (int m = 0; m < 4; ++m)
#pragma unroll
                    for (int n = 0; n < 2; ++n) acc[a][b][m][n] = (f32x4){0.f, 0.f, 0.f, 0.f};
        cur = nxt; cA = nA; cB = nB; ++ui;
        if constexpr (ALIGN_EPI) { if (wr == 1) PG8_BAR; }
    }
    PG8_WAIT_V(0);
    if constexpr (!ALIGN_EPI) { if (wr == 0) PG8_BAR; }
    PG8_BAR;
    if constexpr (Epi::AFTER_DRAIN) { E.fused(acc, cur, wr, wc, fr, fq, lds, wid, lane); S.done(cur); }
#undef PG8_SA
#undef PG8_SB
#undef PG8_STAGE
#undef PG8_LDA
#undef PG8_LDB
#undef PG8_MMA
#undef PG8_WAIT_V
#undef PG8_WAIT_L
#undef PG8_BAR
#undef PG8_SCHED
}
}

#ifndef MK_PER_PHASE
#define MK_PER_PHASE 0
#endif
using pg8::bf16_t; using pg8::bf16x8; using pg8::f32x4; using pg8::u32x4;
typedef float f32x16 __attribute__((ext_vector_type(16)));
typedef unsigned u32x2 __attribute__((ext_vector_type(2)));
#define LAS __attribute__((address_space(3)))
constexpr int M = 16384, D = 1024, SEQ = 8192, NTHR = 512, NPH = 12;
constexpr float EPS = 1e-6f;
constexpr size_t MiB = 1u << 20;
constexpr size_t WS_RSS0 = 0, WS_RSS1 = 65536, WS_VSUM = 131072, WS_VSQ = 196608, WS_RSS2 = 262144;
constexpr size_t WS_BAR = 512 * 1024, BAR_BYTES = 16384;
constexpr size_t WS_APOW = 1 * MiB, WS_A128 = 1 * MiB + 131072, WS_BBT = 1 * MiB + 262144, WS_CCT = 1 * MiB + 524288;
constexpr size_t WS_COS = 2 * MiB, WS_SIN = 6 * MiB, WS_CHS = 10 * MiB;
constexpr size_t WS_WINE = 16 * MiB, WS_WGLU = 28 * MiB, WS_WOUTE = 30 * MiB, WS_WINO = 34 * MiB, WS_WOUTO = 46 * MiB;
constexpr size_t WS_U = 52 * MiB, WS_CAT = 84 * MiB, WS_K = 148 * MiB, WS_V = 180 * MiB, WS_SZB = 212 * MiB, WS_END = 244 * MiB;
constexpr size_t WS_X1 = WS_K;
constexpr int LDS_BYTES = 143360;

struct Args { const float* in[22]; float* out; unsigned char* ws; int ph_lo, ph_hi; };

__device__ __forceinline__ unsigned f2bf(float f) { unsigned u = __builtin_bit_cast(unsigned, f); return (u + 0x7fffu + ((u >> 16) & 1u)) >> 16; }
__device__ __forceinline__ unsigned pk2(float lo, float hi) { return pg8::cvt_pk_bf16(lo, hi); }
__device__ __forceinline__ float bflo(unsigned w) { return __builtin_bit_cast(float, w << 16); }
__device__ __forceinline__ float bfhi(unsigned w) { return __builtin_bit_cast(float, w & 0xffff0000u); }
__device__ __forceinline__ float bf2f(bf16_t b) { return __builtin_bit_cast(float, (unsigned)b << 16); }
__device__ __forceinline__ float fast_rcp(float x) { return __builtin_amdgcn_rcpf(x); }
__device__ __forceinline__ float sigmoidf_(float t) { return fast_rcp(1.f + __builtin_amdgcn_exp2f(-1.4426950408889634f * t)); }
__device__ __forceinline__ float siluf_(float t) { return t * sigmoidf_(t); }
__device__ __forceinline__ float geluf_(float x) { const float u = 0.7978845608028654f * (x + 0.044715f * x * x * x); return x * sigmoidf_(2.f * u); }
__device__ __forceinline__ float wave_sum(float v) {
#pragma unroll
    for (int o = 1; o < 64; o <<= 1) v += __shfl_xor(v, o);
    return v;
}
__device__ __forceinline__ float lg_gamma(int h) { return h == 0 ? -0.04580368961312479f : (h == 1 ? -0.02272007650008353f : (h == 2 ? -0.011315313227834146f : -0.005646563141142063f)); }
__device__ __forceinline__ void sincos_d(double x, double& s, double& c) {
    double t = x * 0.15915494309189535; t -= __builtin_rint(t);
    const double qd = __builtin_rint(4.0 * t); const int q = (int)qd;
    const double r = (t - 0.25 * qd) * 6.283185307179586; const double r2 = r * r;
    double sp = -1.0 / 1307674368000.0; sp = sp * r2 + 1.0 / 6227020800.0; sp = sp * r2 - 1.0 / 39916800.0; sp = sp * r2 + 1.0 / 362880.0; sp = sp * r2 - 1.0 / 5040.0; sp = sp * r2 + 1.0 / 120.0; sp = sp * r2 - 1.0 / 6.0; sp = sp * r2 + 1.0;
    const double sr = sp * r;
    double cp = 1.0 / 20922789888000.0; cp = cp * r2 - 1.0 / 87178291200.0; cp = cp * r2 + 1.0 / 479001600.0; cp = cp * r2 - 1.0 / 3628800.0; cp = cp * r2 + 1.0 / 40320.0; cp = cp * r2 - 1.0 / 720.0; cp = cp * r2 + 1.0 / 24.0; cp = cp * r2 - 0.5; cp = cp * r2 + 1.0;
    const int qq = q & 3;
    if (qq == 0) { s = sr; c = cp; } else if (qq == 1) { s = cp; c = -sr; } else if (qq == 2) { s = -sr; c = -cp; } else { s = -cp; c = sr; }
}

#define EPI_ARGS const f32x4 (&acc)[2][2][4][2], const pg8::Unit& u, int wr, int wc, int fr, int fq
__device__ __forceinline__ void st8bf(bf16_t* p, const float (&v)[8]) { u32x4 w; w.x = pk2(v[0], v[1]); w.y = pk2(v[2], v[3]); w.z = pk2(v[4], v[5]); w.w = pk2(v[6], v[7]); *(u32x4*)p = w; }
__device__ __forceinline__ void ld8bf(const bf16_t* p, float (&v)[8]) { const u32x4 w = *(const u32x4*)p; v[0] = bflo(w.x); v[1] = bfhi(w.x); v[2] = bflo(w.y); v[3] = bfhi(w.y); v[4] = bflo(w.z); v[5] = bfhi(w.z); v[6] = bflo(w.w); v[7] = bfhi(w.w); }
__device__ __forceinline__ void ld8f(const float* p, float (&v)[8]) { const f32x4 a = *(const f32x4*)p, b = *(const f32x4*)(p + 4); v[0] = a.x; v[1] = a.y; v[2] = a.z; v[3] = a.w; v[4] = b.x; v[5] = b.y; v[6] = b.z; v[7] = b.w; }
__device__ __forceinline__ void st8f(float* p, const float (&v)[8]) { *(f32x4*)p = (f32x4){v[0], v[1], v[2], v[3]}; *(f32x4*)(p + 4) = (f32x4){v[4], v[5], v[6], v[7]}; }
#define ACC8(dst, ai, bj, m, sc) do { const f32x4 _a = acc[ai][bj][m][0], _b = acc[ai][bj][m][1]; dst[0] = _a.x * (sc); dst[1] = _a.y * (sc); dst[2] = _a.z * (sc); dst[3] = _a.w * (sc); dst[4] = _b.x * (sc); dst[5] = _b.y * (sc); dst[6] = _b.z * (sc); dst[7] = _b.w * (sc); } while (0)

struct Epi1 {
    static constexpr bool PERM = true, AFTER_DRAIN = false;
    const float* rss; bf16_t* U; bf16_t* CAT; bf16_t* Kb; bf16_t* Vb; bf16_t* SZB; const float* COS; const float* SIN;
    __device__ __forceinline__ void operator()(EPI_ARGS) const {
        const int seg = u.pn >> 2, cb = (u.pn & 3) * 256, colL = wc * 32 + 8 * fq;
        const int row0 = u.pm * 256 + wr * 64 + fr;
#pragma unroll
        for (int ai = 0; ai < 2; ++ai)
#pragma unroll
            for (int m = 0; m < 4; ++m) {
                const int row = row0 + ai * 128 + m * 16;
                const float rs = __builtin_amdgcn_rsqf(rss[row] * (1.f / 1024.f) + EPS);
                if (seg == 2 || seg == 3) {
                    float x1[8], x2[8], cs[8], sn[8], o1[8], o2[8];
                    const float sc = (seg == 3) ? rs * 0.0625f : rs;
                    ACC8(x1, ai, 0, m, sc); ACC8(x2, ai, 1, m, sc);
                    const int pos = row & (SEQ - 1);
                    ld8f(COS + (size_t)pos * 128 + colL, cs); ld8f(SIN + (size_t)pos * 128 + colL, sn);
#pragma unroll
                    for (int j = 0; j < 8; ++j) { o1[j] = x1[j] * cs[j] - x2[j] * sn[j]; o2[j] = x1[j] * sn[j] + x2[j] * cs[j]; }
                    bf16_t* dst = (seg == 2) ? CAT + (size_t)row * 2048 + 1024 + cb + colL : Kb + (size_t)row * 1024 + cb + colL;
                    st8bf(dst, o1); st8bf(dst + 128, o2);
                } else {
#pragma unroll
                    for (int bj = 0; bj < 2; ++bj) {
                        float v[8]; ACC8(v, ai, bj, m, rs);
                        const int col = cb + bj * 128 + colL;
                        if (seg == 1 || seg == 5) {
#pragma unroll
                            for (int j = 0; j < 8; ++j) v[j] = siluf_(v[j]);
                        }
                        bf16_t* dst = (seg == 0) ? U + (size_t)row * 1024 + col : (seg == 1) ? CAT + (size_t)row * 2048 + col : (seg == 4) ? Vb + (size_t)row * 1024 + col : SZB + (size_t)row * 1024 + col;
                        st8bf(dst, v);
                    }
                }
            }
    }
};
struct EpiGlu {
    static constexpr bool PERM = true, AFTER_DRAIN = false;
    const float* bglu; const bf16_t* Y1; bf16_t* CAT;
    __device__ __forceinline__ void operator()(EPI_ARGS) const {
        const int colL = wc * 32 + 8 * fq, row0 = u.pm * 256 + wr * 64 + fr;
#pragma unroll
        for (int bj = 0; bj < 2; ++bj) {
            const int col = u.pn * 256 + bj * 128 + colL;
            float bb[8]; ld8f(bglu + col, bb);
#pragma unroll
            for (int ai = 0; ai < 2; ++ai)
#pragma unroll
                for (int m = 0; m < 4; ++m) {
                    const int row = row0 + ai * 128 + m * 16;
                    float t[8], y[8], z[8]; ACC8(t, ai, bj, m, 1.f);
                    ld8bf(Y1 + (size_t)row * 1024 + col, y); ld8bf(CAT + (size_t)row * 2048 + col, z);
#pragma unroll
                    for (int j = 0; j < 8; ++j) t[j] = y[j] * sigmoidf_(t[j] + bb[j]) * z[j];
                    st8bf(CAT + (size_t)row * 2048 + col, t);
                }
        }
    }
};
struct EpiOut {
    static constexpr bool PERM = true, AFTER_DRAIN = false;
    const float* Xi; float* Xo; bf16_t* XG; const float* g; float* rss;
    __device__ __forceinline__ void operator()(EPI_ARGS) const {
        const int colL = wc * 32 + 8 * fq, row0 = u.pm * 256 + wr * 64 + fr;
#pragma unroll
        for (int ai = 0; ai < 2; ++ai)
#pragma unroll
            for (int m = 0; m < 4; ++m) {
                const int row = row0 + ai * 128 + m * 16; float ss = 0.f;
#pragma unroll
                for (int bj = 0; bj < 2; ++bj) {
                    const int col = u.pn * 256 + bj * 128 + colL;
                    float a[8], x[8]; ACC8(a, ai, bj, m, 1.f); ld8f(Xi + (size_t)row * 1024 + col, x);
#pragma unroll
                    for (int j = 0; j < 8; ++j) { x[j] += a[j]; ss += x[j] * x[j]; }
                    st8f(Xo + (size_t)row * 1024 + col, x);
                    if (XG) { float gg[8]; ld8f(g + col, gg);
#pragma unroll
                        for (int j = 0; j < 8; ++j) x[j] *= gg[j];
                        st8bf(XG + (size_t)row * 1024 + col, x); }
                }
                ss += __shfl_xor(ss, 16); ss += __shfl_xor(ss, 32);
                if (fq == 0) atomicAdd(rss + row, ss);
            }
    }
};
struct Epi7 {
    static constexpr bool PERM = true, AFTER_DRAIN = false;
    const float* rss; bf16_t* VB; float* vsum; float* vsq;
    __device__ __forceinline__ void operator()(EPI_ARGS) const {
        const int colL = wc * 32 + 8 * fq, row0 = u.pm * 256 + wr * 64 + fr;
#pragma unroll
        for (int ai = 0; ai < 2; ++ai)
#pragma unroll
            for (int m = 0; m < 4; ++m) {
                const int row = row0 + ai * 128 + m * 16; float s = 0.f, q = 0.f;
                const float rs = __builtin_amdgcn_rsqf(rss[row] * (1.f / 1024.f) + EPS);
#pragma unroll
                for (int bj = 0; bj < 2; ++bj) {
                    const int col = u.pn * 256 + bj * 128 + colL;
                    float v[8]; ACC8(v, ai, bj, m, rs);
#pragma unroll
                    for (int j = 0; j < 8; ++j) { v[j] = geluf_(v[j]); s += v[j]; q += v[j] * v[j]; }
                    st8bf(VB + (size_t)row * 2048 + col, v);
                }
                s += __shfl_xor(s, 16); s += __shfl_xor(s, 32); q += __shfl_xor(q, 16); q += __shfl_xor(q, 32);
                if (fq == 0) { atomicAdd(vsum + row, s); atomicAdd(vsq + row, q); }
            }
    }
};
struct Epi9 {
    static constexpr bool PERM = true, AFTER_DRAIN = false;
    const float* rss; const bf16_t* SB; bf16_t* Y;
    __device__ __forceinline__ void operator()(EPI_ARGS) const {
        const int colL = wc * 32 + 8 * fq, row0 = u.pm * 256 + wr * 64 + fr, col = u.pn * 128 + colL;
#pragma unroll
        for (int ai = 0; ai < 2; ++ai)
#pragma unroll
            for (int m = 0; m < 4; ++m) {
                const int row = row0 + ai * 128 + m * 16;
                const float rs = __builtin_amdgcn_rsqf(rss[row] * (1.f / 1024.f) + EPS);
                float uu[8], zz[8], s[8]; ACC8(uu, ai, 0, m, rs); ACC8(zz, ai, 1, m, rs); ld8bf(SB + (size_t)row * 2048 + col, s);
#pragma unroll
                for (int j = 0; j < 8; ++j) uu[j] = geluf_(uu[j]) * s[j] * siluf_(zz[j]);
                st8bf(Y + (size_t)row * 2048 + col, uu);
            }
    }
};

__device__ __forceinline__ void p0_transpose_item(const float* W, int K, int N, bf16_t* WT, int row_off, LAS float* scr, int kb, int nb, int lane) {
    const int k0 = 64 * kb, n0 = 32 * nb;
#pragma unroll 8
    for (int i = 0; i < 32; ++i) { const int kk = 2 * i + (lane >> 5); scr[kk * 33 + (lane & 31)] = W[(size_t)(k0 + kk) * N + n0 + (lane & 31)]; }
    asm volatile("s_waitcnt lgkmcnt(0)" ::: "memory");
    const int c = lane & 7;
#pragma unroll
    for (int j = 0; j < 4; ++j) { const int n = (lane >> 3) + 8 * j; const LAS float* s = scr + (8 * c) * 33 + n;
        u32x4 o; o.x = pk2(s[0 * 33], s[1 * 33]); o.y = pk2(s[2 * 33], s[3 * 33]); o.z = pk2(s[4 * 33], s[5 * 33]); o.w = pk2(s[6 * 33], s[7 * 33]);
        *(u32x4*)(WT + (size_t)(row_off + n0 + n) * K + k0 + 8 * c) = o; }
    asm volatile("s_waitcnt lgkmcnt(0)" ::: "memory");
}
__device__ __forceinline__ int wino_row(int n) {
    if (n < 2048) return 2048 + 256 * (n >> 7) + (n & 127);
    if (n < 4096) return n - 2048;
    const int z = n - 4096; return 2048 + 256 * (z >> 7) + 128 + (z & 127);
}

template <bool FINAL>
__device__ __forceinline__ void s5_item(int b, int c, int g, bf16_t* U, float* CHS, const float* APOW, const bf16_t* BBT, const bf16_t* CCT, const float* dsk, LAS unsigned char* wlds, int lane) {
    const int h = lane >> 5, r = lane & 31;
    const size_t row0 = (size_t)b * SEQ + (size_t)c * 128;
    bf16x8 bfrag[4];
#pragma unroll
    for (int nt = 0; nt < 4; ++nt) bfrag[nt] = *(const bf16x8*)(BBT + ((size_t)(g * 128 + nt * 32 + r) * 16 + 8 * h));
    float ar[2][4], ai_[2][4], cr[2], ci[2];
#pragma unroll
    for (int ph = 0; ph < 2; ++ph) {
        const int p = 32 * ph + r; const f32x4 w0 = *(const f32x4*)(APOW + (size_t)(g * 64 + p) * 8), w1 = *(const f32x4*)(APOW + (size_t)(g * 64 + p) * 8 + 4);
        ar[ph][0] = w0.x; ai_[ph][0] = w0.y; ar[ph][1] = w0.z; ai_[ph][1] = w0.w; ar[ph][2] = w1.x; ai_[ph][2] = w1.y; ar[ph][3] = w1.z; ai_[ph][3] = w1.w;
        if (FINAL) { const float* cp = CHS + ((size_t)((b * 64 + c) * 64 + g) * 64 + p) * 2; cr[ph] = cp[0]; ci[ph] = cp[1]; } else { cr[ph] = 0.f; ci[ph] = 0.f; }
    }
    bf16x8 cfrag[4];
    if (FINAL) {
#pragma unroll
        for (int ks = 0; ks < 4; ++ks) cfrag[ks] = *(const bf16x8*)(CCT + ((size_t)(g * 16 + (lane & 15)) * 128 + ks * 32 + 8 * (lane >> 4)));
    }
    const float dk = FINAL ? dsk[g * 16 + (lane & 15)] : 0.f;
    for (int sb = 0; sb < 4; ++sb) {
        const bf16x8 afrag = *(const bf16x8*)(U + (row0 + sb * 32 + r) * 1024 + g * 16 + 8 * h);
        f32x16 re[2], im[2];
        const f32x16 zero16 = {0.f, 0.f, 0.f, 0.f, 0.f, 0.f, 0.f, 0.f, 0.f, 0.f, 0.f, 0.f, 0.f, 0.f, 0.f, 0.f};
        re[0] = __builtin_amdgcn_mfma_f32_32x32x16_bf16(afrag, bfrag[0], zero16, 0, 0, 0);
        re[1] = __builtin_amdgcn_mfma_f32_32x32x16_bf16(afrag, bfrag[1], zero16, 0, 0, 0);
        im[0] = __builtin_amdgcn_mfma_f32_32x32x16_bf16(afrag, bfrag[2], zero16, 0, 0, 0);
        im[1] = __builtin_amdgcn_mfma_f32_32x32x16_bf16(afrag, bfrag[3], zero16, 0, 0, 0);
#pragma unroll
        for (int ph = 0; ph < 2; ++ph) {
            const float a1r = ar[ph][0], a1i = ai_[ph][0], a4r = ar[ph][3], a4i = ai_[ph][3];
#pragma unroll
            for (int q = 0; q < 4; ++q) {
#pragma unroll
                for (int j = 1; j < 4; ++j) { const int i = 4 * q + j; const float pr = re[ph][i - 1], pi = im[ph][i - 1];
                    re[ph][i] += a1r * pr - a1i * pi; im[ph][i] += a1r * pi + a1i * pr; }
            }
#pragma unroll
            for (int q = 0; q < 4; ++q) {
                const float Er = re[ph][4 * q + 3], Ei = im[ph][4 * q + 3];
                const float Xr = Er + a4r * cr[ph] - a4i * ci[ph], Xi = Ei + a4r * ci[ph] + a4i * cr[ph];
                const float Xor_ = __shfl_xor(Xr, 32), Xoi = __shfl_xor(Xi, 32);
                const float cinr = h ? Xor_ : cr[ph], cini = h ? Xoi : ci[ph];
                const float Yr = Er + a4r * cinr - a4i * cini, Yi = Ei + a4r * cini + a4i * cinr;
                const float Yor = __shfl_xor(Yr, 32), Yoi = __shfl_xor(Yi, 32);
                if (FINAL) {
#pragma unroll
                    for (int j = 0; j < 4; ++j) { const int i = 4 * q + j; re[ph][i] += ar[ph][j] * cinr - ai_[ph][j] * cini; im[ph][i] += ar[ph][j] * cini + ai_[ph][j] * cinr; }
                }
                cr[ph] = h ? Yr : Yor; ci[ph] = h ? Yi : Yoi;
            }
        }
        if (FINAL) {
#pragma unroll
            for (int ph = 0; ph < 2; ++ph)
#pragma unroll
                for (int i = 0; i < 16; ++i) { const int tok = (i & 3) + 8 * (i >> 2) + 4 * h; const int p = 32 * ph + r;
                    *(LAS unsigned*)(wlds + tok * 272 + 4 * p) = pk2(re[ph][i], im[ph][i]); }
            asm volatile("s_waitcnt lgkmcnt(0)" ::: "memory");
            f32x4 yacc[2] = {(f32x4){0.f, 0.f, 0.f, 0.f}, (f32x4){0.f, 0.f, 0.f, 0.f}};
#pragma unroll
            for (int mt = 0; mt < 2; ++mt)
#pragma unroll
                for (int ks = 0; ks < 4; ++ks) { const bf16x8 a = *(const LAS bf16x8*)(wlds + (mt * 16 + (lane & 15)) * 272 + (ks * 32 + 8 * (lane >> 4)) * 2);
                    yacc[mt] = __builtin_amdgcn_mfma_f32_16x16x32_bf16(a, cfrag[ks], yacc[mt], 0, 0, 0); }
            asm volatile("s_waitcnt lgkmcnt(0)" ::: "memory");
#pragma unroll
            for (int mt = 0; mt < 2; ++mt)
#pragma unroll
                for (int j = 0; j < 4; ++j) { const size_t row = row0 + sb * 32 + mt * 16 + 4 * (lane >> 4) + j; const bf16_t* pu = U + row * 1024 + g * 16 + (lane & 15);
                    const float y = yacc[mt][j] + dk * bf2f(*pu); U[row * 1024 + g * 16 + (lane & 15)] = (bf16_t)f2bf(geluf_(y)); }
        }
    }
    if (!FINAL && h == 0) {
#pragma unroll
        for (int ph = 0; ph < 2; ++ph) { float* cp = CHS + ((size_t)((b * 64 + c) * 64 + g) * 64 + 32 * ph + r) * 2; cp[0] = cr[ph]; cp[1] = ci[ph]; }
    }
}

__device__ __forceinline__ bf16x8 gather8(const LAS bf16_t* p, int pitch) {
    bf16x8 v;
#pragma unroll
    for (int j = 0; j < 8; ++j) v[j] = (short)p[j * pitch];
    return v;
}
#define MFMA32(a, b, c) __builtin_amdgcn_mfma_f32_32x32x16_bf16((a), (b), (c), 0, 0, 0)
#define ZERO16 ((f32x16){0.f, 0.f, 0.f, 0.f, 0.f, 0.f, 0.f, 0.f, 0.f, 0.f, 0.f, 0.f, 0.f, 0.f, 0.f, 0.f})

#define XB_TMO      128
#define XB_XCNT(j)  (256  + 64 * (j))
#define XB_XSUB(j)  (1280 + 64 * (j))
#define XB_XGEN(j)  (2304 + 64 * (j))
#define XB_TOP      3328
#define XB_TOPGEN   3392
#define XCD_BAR_WORDS 3456
#define XB_SPIN_CAP (1u << 18)

__device__ __forceinline__ unsigned xb_ld(unsigned* p)              { return __hip_atomic_load(p, __ATOMIC_RELAXED, __HIP_MEMORY_SCOPE_AGENT); }
__device__ __forceinline__ unsigned xb_add(unsigned* p, unsigned v) { return __hip_atomic_fetch_add(p, v, __ATOMIC_RELAXED, __HIP_MEMORY_SCOPE_AGENT); }
__device__ __forceinline__ unsigned xb_xcc_id() { return (unsigned)__builtin_amdgcn_s_getreg((3 << 11) | 20) & 0xFu; }
#define XB_SPIN(cond, bar) do { unsigned _sp = 0; while (cond) { __builtin_amdgcn_s_sleep(1); \
    if ((++_sp & 255u) == 0u) { if (xb_ld(&(bar)[XB_TMO])) break; if (_sp > XB_SPIN_CAP) { atomicAdd(&(bar)[XB_TMO], 1u); break; } } } } while (0)

struct XcdBarrier {
    unsigned* bar; unsigned x;
    volatile LAS unsigned* st;
};

__device__ __forceinline__ XcdBarrier xcd_barrier_post(unsigned* bar, volatile LAS unsigned* st) {
    XcdBarrier b; b.bar = bar; b.x = xb_xcc_id(); b.st = st;
    if (threadIdx.x == 0) (void)xb_add(&bar[XB_XCNT(b.x)], 1u);
    return b;
}
__device__ __forceinline__ void xcd_barrier_complete(unsigned* bar, unsigned x, unsigned& nloc, unsigned& nx) {
    const unsigned G = gridDim.x * gridDim.y * gridDim.z;
    unsigned sum, cnt, mine, sp = 0u;
    for (;;) {
        sum = 0u; cnt = 0u; mine = 0u;
#pragma unroll
        for (unsigned j = 0; j < 16; ++j) { const unsigned c = xb_ld(&bar[XB_XCNT(j)]); sum += c; cnt += (c > 0u) ? 1u : 0u; mine = (j == x) ? c : mine; }
        if (sum == G) break;
        __builtin_amdgcn_s_sleep(1);
        if ((++sp & 255u) == 0u) { if (xb_ld(&bar[XB_TMO])) break; if (sp > XB_SPIN_CAP) { atomicAdd(&bar[XB_TMO], 1u); break; } }
    }
    nloc = mine > 0u ? mine : 1u; nx = cnt > 0u ? cnt : 1u;
}

__device__ __forceinline__ void xcd_barrier(const XcdBarrier& b) {
    asm volatile("s_waitcnt vmcnt(0)" ::: "memory");
    __syncthreads();
    if (threadIdx.x == 0) {
        unsigned* bar = b.bar;
        __builtin_amdgcn_s_waitcnt(0);
        unsigned nloc = b.st[0], nx = b.st[1];
        if (nloc == 0u) { xcd_barrier_complete(bar, b.x, nloc, nx); b.st[0] = nloc; b.st[1] = nx; }
        const unsigned old = xb_add(&bar[XB_XSUB(b.x)], 1u);
        const unsigned gen = old / nloc;
        if (old + 1u == (gen + 1u) * nloc) {
            __builtin_amdgcn_fence(__ATOMIC_RELEASE, "agent");
            asm volatile("s_waitcnt vmcnt(0)" ::: "memory");
            const unsigned og = xb_add(&bar[XB_TOP], 1u);
            const unsigned tg = og / nx;
            if (og + 1u == (tg + 1u) * nx) xb_add(&bar[XB_TOPGEN], 1u);
            else XB_SPIN(xb_ld(&bar[XB_TOPGEN]) == tg, bar);
            __builtin_amdgcn_fence(__ATOMIC_ACQUIRE, "agent");
            xb_add(&bar[XB_XGEN(b.x)], 1u);
            asm volatile("s_waitcnt vmcnt(0)" ::: "memory");
        } else {
            XB_SPIN(xb_ld(&bar[XB_XGEN(b.x)]) == gen, bar);
            __builtin_amdgcn_fence(__ATOMIC_ACQUIRE, "agent");
            asm volatile("s_waitcnt vmcnt(0)" ::: "memory");
        }
    }
    __syncthreads();
}

__global__ void __launch_bounds__(NTHR, 2) mk_fwd(Args args) {
    extern __shared__ __attribute__((aligned(16))) unsigned char lds_raw[];
    LAS unsigned char* lds = (LAS unsigned char*)lds_raw;
    cg::grid_group grid = cg::this_grid();
    const int tid = threadIdx.x, lane = tid & 63, wid = __builtin_amdgcn_readfirstlane(tid >> 6);
    const int G = gridDim.x, bid = blockIdx.x;
    const int gw = bid * 8 + wid, NGW = G * 8;
    const int gtid = bid * NTHR + tid, NGT = G * NTHR;
    unsigned char* ws = args.ws;
    const float* x = args.in[0];
    float* RSS0 = (float*)(ws + WS_RSS0); float* RSS1 = (float*)(ws + WS_RSS1); float* VSUM = (float*)(ws + WS_VSUM); float* VSQ = (float*)(ws + WS_VSQ); float* RSS2 = (float*)(ws + WS_RSS2);
    float* APOW = (float*)(ws + WS_APOW); float* A128 = (float*)(ws + WS_A128); bf16_t* BBT = (bf16_t*)(ws + WS_BBT); bf16_t* CCT = (bf16_t*)(ws + WS_CCT);
    float* COS = (float*)(ws + WS_COS); float* SIN = (float*)(ws + WS_SIN); float* CHS = (float*)(ws + WS_CHS);
    bf16_t* WINE = (bf16_t*)(ws + WS_WINE); bf16_t* WGLU = (bf16_t*)(ws + WS_WGLU); bf16_t* WOUTE = (bf16_t*)(ws + WS_WOUTE); bf16_t* WINO = (bf16_t*)(ws + WS_WINO); bf16_t* WOUTO = (bf16_t*)(ws + WS_WOUTO);
    bf16_t* U = (bf16_t*)(ws + WS_U); bf16_t* CAT = (bf16_t*)(ws + WS_CAT); bf16_t* Kb = (bf16_t*)(ws + WS_K); bf16_t* Vb = (bf16_t*)(ws + WS_V); bf16_t* SZB = (bf16_t*)(ws + WS_SZB);
    float* X1 = (float*)(ws + WS_X1);
    bf16_t* XG0 = (bf16_t*)args.out;
    bf16_t* STATE = (bf16_t*)args.out;
    bf16_t* VB = (bf16_t*)args.out;
    const int lo = args.ph_lo, hi = args.ph_hi;
    volatile LAS unsigned* xst = (volatile LAS unsigned*)(lds + LDS_BYTES - 64);
    if (tid == 0) { xst[0] = 0u; xst[1] = 0u; }
    __syncthreads();
    const XcdBarrier xbar = xcd_barrier_post((unsigned*)(ws + WS_BAR), xst);
#ifndef PHMASK
#define PHMASK 0xFFF
#endif
#define IN(k) (((PHMASK >> (k)) & 1) && lo <= (k) && (k) < hi)
#define SEAM(k) do { if (IN(k) && IN((k) + 1)) { if ((k) == 0) grid.sync(); else xcd_barrier(xbar); } } while (0)
#ifndef PROBE_REP
#define PROBE_REP (-1)
#endif
#define PROBE_BEGIN(k) for (int pass = (PROBE_REP == (k)) ? 0 : 1; pass < 2; ++pass) { const bool dummy = (pass == 0); const size_t omask = dummy ? (size_t)2047 : ~(size_t)0; (void)omask;
#define PROBE_END if (pass == 0) grid.sync(); }
    bf16_t* DUMMY = (bf16_t*)(ws + WS_END);

    if (IN(0)) {
        LAS float* scr = (LAS float*)(lds + wid * 16384);
        constexpr int I_INE = 16 * 192, I_GLU = 16 * 32, I_OUTE = 32 * 32, I_INO = 16 * 192, I_OUTO = 32 * 32;
        constexpr int NIT = I_INE + I_GLU + I_OUTE + I_INO + I_OUTO;
        for (int it = gw; it < NIT; it += NGW) {
            int rr = it;
            if (rr < I_INE) { p0_transpose_item(args.in[2], 1024, 6144, WINE, 0, scr, rr / 192, rr % 192, lane); continue; } rr -= I_INE;
            if (rr < I_GLU) { p0_transpose_item(args.in[11], 1024, 1024, WGLU, 0, scr, rr / 32, rr % 32, lane); continue; } rr -= I_GLU;
            if (rr < I_OUTE) { p0_transpose_item(args.in[14], 2048, 1024, WOUTE, 0, scr, rr / 32, rr % 32, lane); continue; } rr -= I_OUTE;
            if (rr < I_INO) { const int nb = rr % 192; p0_transpose_item(args.in[16], 1024, 6144, WINO, wino_row(32 * nb) - 32 * nb, scr, rr / 192, nb, lane); continue; } rr -= I_INO;
            p0_transpose_item(args.in[20], 2048, 1024, WOUTO, 0, scr, rr / 32, rr % 32, lane);
        }
        for (int m = gw; m < M; m += NGW) {
            const f32x4* xr = (const f32x4*)(x + (size_t)m * D) + lane; const f32x4* gr = (const f32x4*)args.in[1] + lane;
            float s = 0.f; u32x2* o8 = (u32x2*)(XG0 + (size_t)m * D) + lane;
#pragma unroll
            for (int j = 0; j < 4; ++j) { const f32x4 v = xr[64 * j], gg = gr[64 * j]; s += (v.x * v.x + v.y * v.y) + (v.z * v.z + v.w * v.w);
                u32x2 w; w.x = pk2(v.x * gg.x, v.y * gg.y); w.y = pk2(v.z * gg.z, v.w * gg.w); o8[64 * j] = w; }
            s = wave_sum(s); if (lane == 0) RSS0[m] = s;
        }
        for (int e = gtid; e < SEQ * 128; e += NGT) { const int pos = e >> 7, i = e & 127;
            const double inv = exp(-(double)i * (9.210340371976184 / 128.0)); double s, c; sincos_d((double)pos * inv, s, c); COS[e] = (float)c; SIN[e] = (float)s; }
        for (int e = gtid; e < 4096; e += NGT) { const int g = e >> 6, p = e & 63;
            const double lr = fmin((double)args.in[3][e], -1e-4), li = (double)args.in[4][e], dt = exp((double)args.in[5][g]);
            const double mag = exp(lr * dt); double sn, cs; sincos_d(li * dt, sn, cs);
            const double abr = mag * cs, abi = mag * sn, den = lr * lr + li * li, nr = abr - 1.0, ni = abi;
            const double zr = (nr * lr + ni * li) / den, zi = (ni * lr - nr * li) / den;
            double pr = abr, pi = abi;
#pragma unroll
            for (int k = 0; k < 4; ++k) { APOW[e * 8 + 2 * k] = (float)pr; APOW[e * 8 + 2 * k + 1] = (float)pi; const double t = pr * abr - pi * abi; pi = pr * abi + pi * abr; pr = t; }
            double qr = abr, qi = abi;
#pragma unroll
            for (int k = 0; k < 7; ++k) { const double t = qr * qr - qi * qi; qi = 2.0 * qr * qi; qr = t; }
            A128[e * 2] = (float)qr; A128[e * 2 + 1] = (float)qi;
            const float* br = args.in[6] + (size_t)e * 16; const float* bi = args.in[7] + (size_t)e * 16;
#pragma unroll
            for (int k = 0; k < 16; ++k) { const double b_r = br[k], b_i = bi[k];
                BBT[(size_t)(g * 128 + p) * 16 + k] = (bf16_t)f2bf((float)(zr * b_r - zi * b_i)); BBT[(size_t)(g * 128 + 64 + p) * 16 + k] = (bf16_t)f2bf((float)(zr * b_i + zi * b_r)); }
#pragma unroll
            for (int hh = 0; hh < 16; ++hh) { const float c_r = args.in[8][(size_t)(g * 16 + hh) * 64 + p], c_i = args.in[9][(size_t)(g * 16 + hh) * 64 + p];
                CCT[(size_t)(g * 16 + hh) * 128 + 2 * p] = (bf16_t)f2bf(c_r); CCT[(size_t)(g * 16 + hh) * 128 + 2 * p + 1] = (bf16_t)f2bf(-c_i); }
        }
        for (int e = gtid; e < M; e += NGT) { RSS1[e] = 0.f; VSUM[e] = 0.f; VSQ[e] = 0.f; RSS2[e] = 0.f; }
        __syncthreads();
    }
    SEAM(0);
    if (IN(1)) {
        pg8::Gemm g{XG0, WINE, M, 6144, 1024}; pg8::StaticOrder S; S.init(M, 6144, G, bid);
        Epi1 E{RSS0, U, CAT, Kb, Vb, SZB, COS, SIN};
        pg8::gemm_phase<Epi1, pg8::StaticOrder, true, true>(lds, g, S, E);
    }
    SEAM(1);
    if (IN(2)) {
        for (int it = gw; it < 2 * 64 * 64; it += NGW) { const int g = it & 63, c = (it >> 6) & 63, b = it >> 12;
            s5_item<false>(b, c, g, U, CHS, APOW, BBT, CCT, args.in[10], lds + wid * 8704, lane); }
        __syncthreads();
        LAS bf16_t* Vs = (LAS bf16_t*)lds; LAS bf16_t* Ks = (LAS bf16_t*)(lds + 34816);
        const int wm = wid >> 1, wn = wid & 1, h5_ = lane >> 5, r_ = lane & 31;
        u32x4 pv[4], pk[4];
#define RA_LOAD(IT) do { const int kt_ = (IT) & 1, vt_ = ((IT) >> 1) & 1, hh_ = ((IT) >> 2) & 3, c_ = ((IT) >> 4) & 63, b_ = (IT) >> 10; const size_t rw0 = (size_t)b_ * SEQ + (size_t)c_ * 128; \
            _Pragma("unroll") for (int i = 0; i < 4; ++i) { const int idx = tid + NTHR * i, row = idx >> 4, ch = idx & 15; \
                pv[i] = *(const u32x4*)(Vb + (rw0 + row) * 1024 + hh_ * 256 + vt_ * 128 + ch * 8); pk[i] = *(const u32x4*)(Kb + (rw0 + row) * 1024 + hh_ * 256 + kt_ * 128 + ch * 8); } } while (0)
        if (bid < 2048) RA_LOAD(bid);
        for (int it = bid; it < 2048; it += G) {
            const int kt = it & 1, vt = (it >> 1) & 1, hh = (it >> 2) & 3, c = (it >> 4) & 63, b = it >> 10;
            const float lg = lg_gamma(hh);
            int h5 = h5_, r = r_; asm volatile("" : "+v"(h5), "+v"(r));
#pragma unroll
            for (int i = 0; i < 4; ++i) { const int idx = tid + NTHR * i, row = idx >> 4, ch = idx & 15;
                const float z = __builtin_amdgcn_exp2f((float)(127 - row) * lg); const u32x4 w = pv[i]; u32x4 o;
                o.x = pk2(bflo(w.x) * z, bfhi(w.x) * z); o.y = pk2(bflo(w.y) * z, bfhi(w.y) * z); o.z = pk2(bflo(w.z) * z, bfhi(w.z) * z); o.w = pk2(bflo(w.w) * z, bfhi(w.w) * z);
                *(LAS u32x4*)(Vs + row * 136 + ch * 8) = o; *(LAS u32x4*)(Ks + row * 136 + ch * 8) = pk[i]; }
            __syncthreads();
            if (it + G < 2048) RA_LOAD(it + G);
            f32x16 acc[2] = {ZERO16, ZERO16};
#pragma unroll 4
            for (int ks = 0; ks < 8; ++ks) { const int m0 = 16 * ks + 8 * h5;
                const bf16x8 a = gather8(Vs + m0 * 136 + 32 * wm + r, 136);
#pragma unroll
                for (int nt = 0; nt < 2; ++nt) { const bf16x8 bb = gather8(Ks + m0 * 136 + 64 * wn + 32 * nt + r, 136); acc[nt] = MFMA32(bb, a, acc[nt]); } }
            bf16_t* dst = STATE + ((size_t)((b * 64 + c) * 4 + hh) * 256 + vt * 128 + 32 * wm + r) * 256 + kt * 128 + 64 * wn + 4 * h5;
#pragma unroll
            for (int nt = 0; nt < 2; ++nt)
#pragma unroll
                for (int iq = 0; iq < 4; ++iq) { u32x2 w; w.x = pk2(acc[nt][4 * iq], acc[nt][4 * iq + 1]); w.y = pk2(acc[nt][4 * iq + 2], acc[nt][4 * iq + 3]); *(u32x2*)(dst + 32 * nt + 8 * iq) = w; }
            __syncthreads();
        }
#undef RA_LOAD
    }
    SEAM(2);
    if (IN(3)) {
        for (int e = gtid; e < 131072; e += NGT) { const int bh = e >> 14, idx4 = e & 16383, b = bh >> 2, hh = bh & 3;
            const float cd = __builtin_amdgcn_exp2f(128.f * lg_gamma(hh)); float s0 = 0.f, s1 = 0.f, s2 = 0.f, s3 = 0.f;
            u32x2* p = (u32x2*)(STATE + ((size_t)(b * 64) * 4 + hh) * 65536 + (size_t)idx4 * 4);
#pragma unroll 8
            for (int c = 0; c < 64; ++c) { u32x2* q = p + (size_t)c * (4 * 65536 / 4); const u32x2 w = *q;
                u32x2 o; o.x = pk2(s0, s1); o.y = pk2(s2, s3); *q = o;
                s0 = s0 * cd + bflo(w.x); s1 = s1 * cd + bfhi(w.x); s2 = s2 * cd + bflo(w.y); s3 = s3 * cd + bfhi(w.y); } }
        for (int e = gtid; e < 8192; e += NGT) { const int b = e >> 12, gp = e & 4095; const float ar = A128[gp * 2], ai = A128[gp * 2 + 1]; float cr = 0.f, ci = 0.f;
            for (int c = 0; c < 64; ++c) { float* q = CHS + ((size_t)(b * 64 + c) * 4096 + gp) * 2; const float lr_ = q[0], li_ = q[1]; q[0] = cr; q[1] = ci;
                const float t = ar * cr - ai * ci + lr_; ci = ar * ci + ai * cr + li_; cr = t; } }
    }
    SEAM(3);
    if (IN(4)) {
        for (int it = gw; it < 2 * 64 * 64; it += NGW) { const int g = it & 63, c = (it >> 6) & 63, b = it >> 12;
            s5_item<true>(b, c, g, U, CHS, APOW, BBT, CCT, args.in[10], lds + wid * 8704, lane); }
        __syncthreads();
        LAS bf16_t* Qs = (LAS bf16_t*)lds; LAS bf16_t* Ks = (LAS bf16_t*)(lds + 67584); LAS bf16_t* Ps = (LAS bf16_t*)(lds + 67584); LAS bf16_t* Xs = (LAS bf16_t*)(lds + 67584 + 34816);
        LAS float* red = (LAS float*)lds;
        const int wm = wid >> 1, wn = wid & 1, h5_ = lane >> 5, r_ = lane & 31;
        const float* gain = args.in[13];
#define OPQ() asm volatile("" : "+v"(h5), "+v"(r))
        for (int it = bid; it < 512; it += G) {
            const int hh = it & 3, c = (it >> 2) & 63, b = it >> 8;
            const size_t row0 = (size_t)b * SEQ + (size_t)c * 128; const float lg = lg_gamma(hh);
            int h5 = h5_, r = r_; OPQ();
#pragma unroll 4
            for (int i = 0; i < 8; ++i) { const int idx = tid + NTHR * i, row = idx >> 5, ch = idx & 31;
                *(LAS u32x4*)(Qs + row * 264 + ch * 8) = *(const u32x4*)(CAT + (row0 + row) * 2048 + 1024 + hh * 256 + ch * 8);
                *(LAS u32x4*)(Ks + row * 264 + ch * 8) = *(const u32x4*)(Kb + (row0 + row) * 1024 + hh * 256 + ch * 8); }
            __syncthreads();
            u32x4 pvv[4], pc[4];
#define RC_LOADV(VH) do { _Pragma("unroll") for (int i = 0; i < 4; ++i) { const int idx = tid + NTHR * i, row = idx >> 4, ch = idx & 15; pvv[i] = *(const u32x4*)(Vb + (row0 + row) * 1024 + hh * 256 + (VH) * 128 + ch * 8); } } while (0)
#define RC_STOREV() do { _Pragma("unroll") for (int i = 0; i < 4; ++i) { const int idx = tid + NTHR * i, row = idx >> 4, ch = idx & 15; *(LAS u32x4*)(Xs + row * 136 + ch * 8) = pvv[i]; } } while (0)
#define RC_LOADC(STP, KC) do { _Pragma("unroll") for (int i = 0; i < 4; ++i) { const int idx = tid + NTHR * i, row = idx >> 4, ch = idx & 15; pc[i] = *(const u32x4*)((STP) + (size_t)row * 256 + (KC) * 128 + ch * 8); } } while (0)
#define RC_STOREC() do { _Pragma("unroll") for (int i = 0; i < 4; ++i) { const int idx = tid + NTHR * i, row = idx >> 4, ch = idx & 15; *(LAS u32x4*)(Xs + row * 136 + ch * 8) = pc[i]; } } while (0)
            RC_LOADV(0);
            f32x16 sacc[2] = {ZERO16, ZERO16};
#pragma unroll 4
            for (int ks = 0; ks < 16; ++ks) { const int k0 = 16 * ks + 8 * h5;
                const bf16x8 a = *(const LAS bf16x8*)(Qs + (32 * wm + r) * 264 + k0);
#pragma unroll
                for (int nt = 0; nt < 2; ++nt) { const bf16x8 bb = *(const LAS bf16x8*)(Ks + (64 * wn + 32 * nt + r) * 264 + k0); sacc[nt] = MFMA32(bb, a, sacc[nt]); } }
            __syncthreads();
            OPQ();
            { const int n = 32 * wm + r;
#pragma unroll
              for (int nt = 0; nt < 2; ++nt)
#pragma unroll
                for (int iq = 0; iq < 4; ++iq) { const int m0 = 64 * wn + 32 * nt + 8 * iq + 4 * h5; float pvl[4];
#pragma unroll
                    for (int j = 0; j < 4; ++j) { const int mc = m0 + j; pvl[j] = (n >= mc) ? sacc[nt][4 * iq + j] * __builtin_amdgcn_exp2f(-(float)(mc + 1) * lg) : 0.f; }
                    u32x2 w; w.x = pk2(pvl[0], pvl[1]); w.y = pk2(pvl[2], pvl[3]); *(LAS u32x2*)(Ps + n * 136 + m0) = w; } }
            RC_STOREV();
            __syncthreads();
            f32x16 oacc[2][2] = {{ZERO16, ZERO16}, {ZERO16, ZERO16}};
#pragma unroll
            for (int vh = 0; vh < 2; ++vh) {
                OPQ();
                const bf16_t* st = STATE + ((size_t)((b * 64 + c) * 4 + hh) * 256 + vh * 128) * 256;
                RC_LOADC(st, 0);
#pragma unroll 2
                for (int ks = 0; ks < 8; ++ks) { const int m0 = 16 * ks + 8 * h5;
                    const bf16x8 a = *(const LAS bf16x8*)(Ps + (32 * wm + r) * 136 + m0);
#pragma unroll
                    for (int nt = 0; nt < 2; ++nt) { const bf16x8 bb = gather8(Xs + m0 * 136 + 64 * wn + 32 * nt + r, 136); oacc[vh][nt] = MFMA32(bb, a, oacc[vh][nt]); } }
#pragma unroll 1
                for (int kc = 0; kc < 2; ++kc) {
                    __syncthreads();
                    RC_STOREC();
                    __syncthreads();
                    if (kc < 1) RC_LOADC(st, kc + 1); else if (vh == 0) RC_LOADV(1);
#pragma unroll 4
                    for (int ks = 0; ks < 8; ++ks) { const int k0 = 16 * ks + 8 * h5;
                        const bf16x8 a = *(const LAS bf16x8*)(Qs + (32 * wm + r) * 264 + kc * 128 + k0);
#pragma unroll
                        for (int nt = 0; nt < 2; ++nt) { const bf16x8 bb = *(const LAS bf16x8*)(Xs + (64 * wn + 32 * nt + r) * 136 + k0); oacc[vh][nt] = MFMA32(bb, a, oacc[vh][nt]); } }
                }
                __syncthreads();
                if (vh == 0) { RC_STOREV(); __syncthreads(); }
            }
            OPQ();
            const int n = 32 * wm + r; const float xi = __builtin_amdgcn_exp2f((float)(n + 1) * lg);
            float s = 0.f, q = 0.f;
#pragma unroll
            for (int vh = 0; vh < 2; ++vh)
#pragma unroll
                for (int nt = 0; nt < 2; ++nt)
#pragma unroll
                    for (int i = 0; i < 16; ++i) { const float o = oacc[vh][nt][i] * xi; oacc[vh][nt][i] = o; s += o; q += o * o; }
            s += __shfl_xor(s, 32); q += __shfl_xor(q, 32);
            if (h5 == 0) { red[(wn * 128 + n) * 2] = s; red[(wn * 128 + n) * 2 + 1] = q; }
            __syncthreads();
            OPQ();
            { const float st_ = red[n * 2] + red[(128 + n) * 2], qt = red[n * 2 + 1] + red[(128 + n) * 2 + 1];
              const float mu = st_ * (1.f / 256.f), var = fmaxf(qt * (1.f / 256.f) - mu * mu, 0.f), rstd = __builtin_amdgcn_rsqf(var + EPS);
#pragma unroll
              for (int vh = 0; vh < 2; ++vh)
#pragma unroll
                for (int nt = 0; nt < 2; ++nt)
#pragma unroll
                    for (int iq = 0; iq < 4; ++iq) { const int col = hh * 256 + vh * 128 + 64 * wn + 32 * nt + 8 * iq + 4 * h5;
                        const f32x4 gv = *(const f32x4*)(gain + col); const u32x2 zz = *(const u32x2*)(SZB + (row0 + n) * 1024 + col);
                        const float y0 = (oacc[vh][nt][4 * iq] - mu) * rstd * gv.x * bflo(zz.x), y1 = (oacc[vh][nt][4 * iq + 1] - mu) * rstd * gv.y * bfhi(zz.x);
                        const float y2 = (oacc[vh][nt][4 * iq + 2] - mu) * rstd * gv.z * bflo(zz.y), y3 = (oacc[vh][nt][4 * iq + 3] - mu) * rstd * gv.w * bfhi(zz.y);
                        u32x2 w; w.x = pk2(y0, y1); w.y = pk2(y2, y3); *(u32x2*)(CAT + (row0 + n) * 2048 + 1024 + col) = w; } }
            __syncthreads();
        }
#undef RC_LOADV
#undef RC_STOREV
#undef RC_LOADC
#undef RC_STOREC
    }
    SEAM(4);
    if (IN(5)) {
        pg8::Gemm g{U, WGLU, M, 1024, 1024}; pg8::StaticOrder S; S.init(M, 1024, G, bid);
        EpiGlu E{args.in[12], U, CAT};
        pg8::gemm_phase<EpiGlu, pg8::StaticOrder, true, true>(lds, g, S, E);
    }
    SEAM(5);
    if (IN(6)) {
        pg8::Gemm g{CAT, WOUTE, M, 1024, 2048}; pg8::StaticOrder S; S.init(M, 1024, G, bid);
        EpiOut E{x, X1, U, args.in[15], RSS1};
        pg8::gemm_phase<EpiOut, pg8::StaticOrder, true, true>(lds, g, S, E);
    }
    SEAM(6);
    if (IN(7)) {
        pg8::Gemm g{U, WINO, M, 2048, 1024}; pg8::StaticOrder S; S.init(M, 2048, G, bid);
        Epi7 E{RSS1, VB, VSUM, VSQ};
        pg8::gemm_phase<Epi7, pg8::StaticOrder, true, true>(lds, g, S, E);
    }
    SEAM(7);
    if (IN(8)) {
        LAS bf16_t* Wsm = (LAS bf16_t*)lds; LAS bf16_t* Vs = (LAS bf16_t*)(lds + 34816);
        const int wm = wid >> 1, wn = wid & 1, h5_ = lane >> 5, r_ = lane & 31;
        const float* vgain = args.in[17]; const float* wsp = args.in[18]; const float* bsp = args.in[19];
        u32x4 pvv[4]; f32x4 pw[4][2], pg[2]; float psum[4], psq[4];
#define SG_LOAD(IT) do { const int ds_ = (IT) & 3, gg_ = ((IT) >> 2) & 3, c_ = ((IT) >> 4) & 63, b_ = (IT) >> 10; const size_t rw0 = (size_t)b_ * SEQ + (size_t)c_ * 128; const int cl0 = gg_ * 512 + ds_ * 128; \
            pg[0] = *(const f32x4*)(vgain + cl0 + (tid & 15) * 8); pg[1] = *(const f32x4*)(vgain + cl0 + (tid & 15) * 8 + 4); \
            _Pragma("unroll") for (int i = 0; i < 4; ++i) { const int idx = tid + NTHR * i, row = idx >> 4, ch = idx & 15; \
                const float* wp = wsp + ((size_t)gg_ * 128 + row) * 128 + ch * 8; pw[i][0] = *(const f32x4*)wp; pw[i][1] = *(const f32x4*)(wp + 4); \
                pvv[i] = *(const u32x4*)(VB + (rw0 + row) * 2048 + cl0 + ch * 8); psum[i] = VSUM[rw0 + row]; psq[i] = VSQ[rw0 + row]; } } while (0)
        if (bid < 2048) SG_LOAD(bid);
        for (int it = bid; it < 2048; it += G) {
            const int ds = it & 3, gg = (it >> 2) & 3, c = (it >> 4) & 63, b = it >> 10;
            const size_t row0 = (size_t)b * SEQ + (size_t)c * 128; const int col0 = gg * 512 + ds * 128;
            int h5 = h5_, r = r_; asm volatile("" : "+v"(h5), "+v"(r));
#pragma unroll
            for (int i = 0; i < 4; ++i) { const int idx = tid + NTHR * i, row = idx >> 4, ch = idx & 15;
                float w[8] = {pw[i][0].x, pw[i][0].y, pw[i][0].z, pw[i][0].w, pw[i][1].x, pw[i][1].y, pw[i][1].z, pw[i][1].w};
#pragma unroll
                for (int j = 0; j < 8; ++j) w[j] = (ch * 8 + j <= row) ? w[j] : 0.f;
                u32x4 o; o.x = pk2(w[0], w[1]); o.y = pk2(w[2], w[3]); o.z = pk2(w[4], w[5]); o.w = pk2(w[6], w[7]);
                *(LAS u32x4*)(Wsm + row * 136 + ch * 8) = o;
                const float mu = psum[i] * (1.f / 2048.f), var = fmaxf(psq[i] * (1.f / 2048.f) - mu * mu, 0.f), rstd = __builtin_amdgcn_rsqf(var + EPS);
                const u32x4 vv = pvv[i]; u32x4 o2;
                o2.x = pk2((bflo(vv.x) - mu) * rstd * pg[0].x, (bfhi(vv.x) - mu) * rstd * pg[0].y); o2.y = pk2((bflo(vv.y) - mu) * rstd * pg[0].z, (bfhi(vv.y) - mu) * rstd * pg[0].w);
                o2.z = pk2((bflo(vv.z) - mu) * rstd * pg[1].x, (bfhi(vv.z) - mu) * rstd * pg[1].y); o2.w = pk2((bflo(vv.w) - mu) * rstd * pg[1].z, (bfhi(vv.w) - mu) * rstd * pg[1].w);
                *(LAS u32x4*)(Vs + row * 136 + ch * 8) = o2; }
            __syncthreads();
            if (it + G < 2048) SG_LOAD(it + G);
            f32x16 acc[2] = {ZERO16, ZERO16};
            const int nks = 2 * wm + 2;
#pragma unroll 2
            for (int ks = 0; ks < nks; ++ks) { const int m0 = 16 * ks + 8 * h5;
                const bf16x8 a = *(const LAS bf16x8*)(Wsm + (32 * wm + r) * 136 + m0);
#pragma unroll
                for (int nt = 0; nt < 2; ++nt) { const bf16x8 bb = gather8(Vs + m0 * 136 + 64 * wn + 32 * nt + r, 136); acc[nt] = MFMA32(bb, a, acc[nt]); } }
            const int t = 32 * wm + r; const float bias = bsp[gg * 128 + t];
            bf16_t* dst = VB + (row0 + t) * 2048 + col0 + 64 * wn + 4 * h5;
#pragma unroll
            for (int nt = 0; nt < 2; ++nt)
#pragma unroll
                for (int iq = 0; iq < 4; ++iq) { u32x2 w; w.x = pk2(acc[nt][4 * iq] + bias, acc[nt][4 * iq + 1] + bias); w.y = pk2(acc[nt][4 * iq + 2] + bias, acc[nt][4 * iq + 3] + bias); *(u32x2*)(dst + 32 * nt + 8 * iq) = w; }
            __syncthreads();
        }
#undef SG_LOAD
    }
    SEAM(8);
    if (IN(9)) {
        pg8::Gemm g{U, WINO + (size_t)2048 * 1024, M, 4096, 1024}; pg8::StaticOrder S; S.init(M, 4096, G, bid);
        Epi9 E{RSS1, VB, CAT};
        pg8::gemm_phase<Epi9, pg8::StaticOrder, true, true>(lds, g, S, E);
    }
    SEAM(9);
    if (IN(10)) {
        pg8::Gemm g{CAT, WOUTO, M, 1024, 2048}; pg8::StaticOrder S; S.init(M, 1024, G, bid);
        EpiOut E{X1, X1, nullptr, nullptr, RSS2};
        pg8::gemm_phase<EpiOut, pg8::StaticOrder, true, true>(lds, g, S, E);
    }
    SEAM(10);
    if (IN(11)) {
        const f32x4* gr = (const f32x4*)args.in[21] + lane; f32x4 gg[4];
#pragma unroll
        for (int j = 0; j < 4; ++j) gg[j] = gr[64 * j];
        for (int m = gw; m < M; m += 4 * NGW) {
            f32x4 v[4][4]; float rs[4];
#pragma unroll
            for (int k = 0; k < 4; ++k) { const int mm = m + k * NGW; if (mm < M) { const f32x4* xr = (const f32x4*)(X1 + (size_t)mm * D) + lane; rs[k] = RSS2[mm];
#pragma unroll
                for (int j = 0; j < 4; ++j) v[k][j] = __builtin_nontemporal_load(xr + 64 * j); } }
#pragma unroll
            for (int k = 0; k < 4; ++k) { const int mm = m + k * NGW; if (mm < M) { f32x4* o = (f32x4*)(args.out + (size_t)mm * D) + lane; const float r = __builtin_amdgcn_rsqf(rs[k] * (1.f / 1024.f) + EPS);
#pragma unroll
                for (int j = 0; j < 4; ++j) { const f32x4 x_ = v[k][j]; __builtin_nontemporal_store((f32x4){x_.x * r * gg[j].x, x_.y * r * gg[j].y, x_.z * r * gg[j].z, x_.w * r * gg[j].w}, o + 64 * j); } } }
        }
    }
#undef IN
#undef SEAM
}

extern "C" void kernel_launch(void* const* d_in, const int* in_sizes, int n_in, void* d_out, int out_size, void* d_ws, size_t ws_size, hipStream_t stream) {
    static int grid = 0;
    if (grid == 0) {
        if (n_in != 22 || out_size != M * D || ws_size < WS_END) { fprintf(stderr, "kernel_launch: unexpected shapes (n_in %d out %d ws %zu)\n", n_in, out_size, ws_size); grid = -1; return; }
        int dev = 0, cus = 0, per_cu = 0;
        hipGetDevice(&dev); hipDeviceGetAttribute(&cus, hipDeviceAttributeMultiprocessorCount, dev);
        if (hipFuncSetAttribute((const void*)mk_fwd, hipFuncAttributeMaxDynamicSharedMemorySize, LDS_BYTES) != hipSuccess) { fprintf(stderr, "kernel_launch: hipFuncSetAttribute failed\n"); grid = -1; return; }
        if (hipOccupancyMaxActiveBlocksPerMultiprocessor(&per_cu, (const void*)mk_fwd, NTHR, LDS_BYTES) != hipSuccess || per_cu < 1) { fprintf(stderr, "kernel_launch: occupancy query says %d\n", per_cu); grid = -1; return; }
        grid = cus * (per_cu > 1 ? 1 : per_cu);
    }
    if (grid < 0) return;
    if (hipMemsetAsync((char*)d_ws + WS_BAR, 0, BAR_BYTES, stream) != hipSuccess) { fprintf(stderr, "kernel_launch: memset failed\n"); return; }
    Args a{};
    for (int i = 0; i < 22; ++i) a.in[i] = (const float*)d_in[i];
    a.out = (float*)d_out; a.ws = (unsigned char*)d_ws;
#if MK_PER_PHASE
#ifdef PROBE_PREFIX
    for (int p = 0; p <= PROBE_PREFIX; ++p) { a.ph_lo = p; a.ph_hi = p + 1; hipLaunchKernelGGL(mk_fwd, dim3(grid), dim3(NTHR), LDS_BYTES, stream, a); }
#endif
    for (int p = 0; p < NPH; ++p) { a.ph_lo = p; a.ph_hi = p + 1; hipLaunchKernelGGL(mk_fwd, dim3(grid), dim3(NTHR), LDS_BYTES, stream, a); }
#else
    a.ph_lo = 0; a.ph_hi = NPH;
    void* kargs[] = {&a};
    hipError_t e = hipLaunchCooperativeKernel((const void*)mk_fwd, dim3(grid), dim3(NTHR), kargs, LDS_BYTES, stream);
    if (e != hipSuccess) fprintf(stderr, "kernel_launch: cooperative launch failed: %s (grid %d)\n", hipGetErrorString(e), grid);
#endif
}
```

```cpp
#include <hip/hip_runtime.h>
#include <hip/hip_cooperative_groups.h>
#include <cstdio>
#include <cstdint>
namespace cg = cooperative_groups;
namespace pg8 {
#define PG8_LAS __attribute__((address_space(3)))
typedef unsigned short bf16_t;
typedef short bf16x8 __attribute__((ext_vector_type(8)));
typedef float f32x4 __attribute__((ext_vector_type(4)));
typedef unsigned u32x4 __attribute__((ext_vector_type(4)));
constexpr int BM = 256, BK = 64, HALF = 128, HTB = HALF * BK * 2  , STAGE_BYTES = 8 * HTB, NXCD = 8, WGM = 8;

__host__ __device__ __forceinline__ int lds_byte(int r, int c) { const int st = (r >> 4) * 2 + (c >> 5), rr = r & 15, cc = c & 31, ob = rr * 64 + cc * 2; return st * 1024 + (ob ^ (((ob >> 9) & 1) << 5)); }
__host__ __device__ __forceinline__ void stage_rc(int b, int& R, int& C) { const int st = b / 1024, sb = b % 1024, swz = sb ^ (((sb >> 9) & 1) << 5); R = (st >> 1) * 16 + swz / 64; C = (st & 1) * 32 + (swz % 64) / 2; }
__host__ __device__ __forceinline__ int perm32(int rho) { const int n = rho >> 4, i = rho & 15; return 8 * (i >> 2) + 4 * n + (i & 3); }

struct Unit { int pm, pn; };
struct Gemm { const bf16_t* A; const bf16_t* Bt; int M, N, K; };

struct StaticOrder {
    int nM, nN, nwg, G, c;
    __host__ __device__ void init(int M, int N, int G_, int c_) { nM = M / BM; nN = N / BM; nwg = nM * nN; G = G_; c = c_; }
    __host__ __device__ bool next(int i, Unit& u) const {
        const long L = (long)i * G + c; if (L >= nwg) return false;
        int wgid = (int)L; { const int q = nwg / NXCD, r = nwg % NXCD, xcd = wgid % NXCD, off = wgid / NXCD; wgid = (xcd < r ? xcd * (q + 1) : r * (q + 1) + (xcd - r) * q) + off; }
        const int nig = WGM * nN, gid = wgid / nig, fm = gid * WGM, gsz = (nM - fm) < WGM ? (nM - fm) : WGM;
        u.pm = fm + ((wgid % nig) % gsz); u.pn = (wgid % nig) / gsz; return true;
    }
    __device__ __forceinline__ void a_ready(const Unit&) const {}
    __device__ __forceinline__ void done(const Unit&) const {}
};

__device__ __forceinline__ unsigned cvt_pk_bf16(float lo, float hi) { unsigned r; asm volatile("v_cvt_pk_bf16_f32 %0, %1, %2" : "=v"(r) : "v"(lo), "v"(hi)); return r; }
template <class Epi, class Sched, bool ALIGN_EPI = false, bool SP2 = false>
__device__ __forceinline__ void gemm_phase(PG8_LAS unsigned char* lds, const Gemm g, const Sched& S, const Epi& E) {
    const int tid = threadIdx.x, wid = __builtin_amdgcn_readfirstlane(tid >> 6), lane = tid & 63, wr = wid >> 2, wc = wid & 3, fr = lane & 15, fq = lane >> 4;
    const int K = g.K, nt = K / BK;
    unsigned voffA[2], voffB[2];
#pragma unroll
    for (int i = 0; i < 2; ++i) { int R, C; stage_rc(tid * 16 + i * 8192, R, C); const int Rb = Epi::PERM ? ((R & ~31) + perm32(R & 31)) : R;
        voffA[i] = (unsigned)(R * K + C) * 2u; voffB[i] = (unsigned)(Rb * K + C) * 2u; }
    const size_t kstep = (size_t)(BK * 2);
    const size_t hstep = (size_t)HALF * K * 2;
    const size_t tstep = 2 * hstep;
    const unsigned ldsw = (unsigned)wid * 1024u;
    const int aoff = lds_byte(wr * 64 + fr, fq * 8), boff = lds_byte(wc * 32 + fr, fq * 8);
#define PG8_SA(b, h) (((b) * 2 + (h)) * HTB)
#define PG8_SB(b, h) ((4 + (b) * 2 + (h)) * HTB)
#define PG8_STAGE(bufoff, gbase, voff) do { _Pragma("unroll") for (int _i = 0; _i < 2; ++_i) \
        __builtin_amdgcn_global_load_lds((const unsigned*)((const char*)(gbase) + (voff)[_i]), (PG8_LAS unsigned*)(lds + (bufoff) + ldsw + _i * 8192), 16, 0, 0); } while (0)
#define PG8_LDA(dst, b, h) do { _Pragma("unroll") for (int m = 0; m < 4; ++m) _Pragma("unroll") for (int k = 0; k < 2; ++k) dst[m][k] = *(const PG8_LAS bf16x8*)(lds + PG8_SA(b, h) + aoff + m * 2048 + k * 1024); } while (0)
#define PG8_LDB(dst, b, h) do { _Pragma("unroll") for (int n = 0; n < 2; ++n) _Pragma("unroll") for (int k = 0; k < 2; ++k) dst[n][k] = *(const PG8_LAS bf16x8*)(lds + PG8_SB(b, h) + boff + n * 2048 + k * 1024); } while (0)
#define PG8_MMA(ai, bj, At, Bt) do { __builtin_amdgcn_s_setprio(1); _Pragma("unroll") for (int m = 0; m < 4; ++m) _Pragma("unroll") for (int n = 0; n < 2; ++n) _Pragma("unroll") for (int k = 0; k < 2; ++k) \
        acc[ai][bj][m][n] = __builtin_amdgcn_mfma_f32_16x16x32_bf16(Bt[n][k], At[m][k], acc[ai][bj][m][n], 0, 0, 0); __builtin_amdgcn_s_setprio(0); } while (0)
#define PG8_WAIT_V(n) asm volatile("s_waitcnt vmcnt(" #n ")" ::: "memory")
#define PG8_WAIT_L(n) asm volatile("s_waitcnt lgkmcnt(" #n ")" ::: "memory")
#define PG8_BAR __builtin_amdgcn_s_barrier()
#define PG8_SCHED __builtin_amdgcn_sched_barrier(0)
    Unit cur, nxt; int ui = 0;
    if (!S.next(0, cur)) return;
    f32x4 acc[2][2][4][2];
#pragma unroll
    for (int a = 0; a < 2; ++a)
#pragma unroll
        for (int b = 0; b < 2; ++b)
#pragma unroll
            for (int m = 0; m < 4; ++m)
#pragma unroll
                for (int n = 0; n < 2; ++n) acc[a][b][m][n] = (f32x4){0.f, 0.f, 0.f, 0.f};
    bf16x8 At[4][2], B0[2][2], B1[2][2];
    const char* cA = (const char*)g.A + (size_t)cur.pm * tstep; const char* cB = (const char*)g.Bt + (size_t)cur.pn * tstep;
    S.a_ready(cur);
    if constexpr (SP2) {
        PG8_STAGE(PG8_SB(0, 0), cB, voffB); PG8_STAGE(PG8_SB(0, 1), cB + hstep, voffB); PG8_STAGE(PG8_SA(0, 0), cA, voffA); PG8_STAGE(PG8_SA(0, 1), cA + hstep, voffA);
        if (wr == 1) PG8_BAR;
        PG8_WAIT_V(2); PG8_BAR;
        PG8_STAGE(PG8_SB(1, 0), cB + kstep, voffB); PG8_STAGE(PG8_SA(1, 0), cA + kstep, voffA); PG8_STAGE(PG8_SB(1, 1), cB + hstep + kstep, voffB);
        PG8_WAIT_V(6); PG8_BAR;
    } else {
        PG8_STAGE(PG8_SB(0, 0), cB, voffB); PG8_STAGE(PG8_SA(0, 0), cA, voffA); PG8_STAGE(PG8_SB(0, 1), cB + hstep, voffB); PG8_STAGE(PG8_SA(0, 1), cA + hstep, voffA);
        if (wr == 1) PG8_BAR;
        PG8_WAIT_V(4); PG8_BAR;
        PG8_STAGE(PG8_SB(1, 0), cB + kstep, voffB); PG8_STAGE(PG8_SA(1, 0), cA + kstep, voffA); PG8_STAGE(PG8_SB(1, 1), cB + hstep + kstep, voffB);
        PG8_WAIT_V(6); PG8_BAR;
    }
    for (;;) {
        const bool has_next = S.next(ui + 1, nxt);
        const char* nA = has_next ? (const char*)g.A + (size_t)nxt.pm * tstep : cA; const char* nB = has_next ? (const char*)g.Bt + (size_t)nxt.pn * tstep : cB;
        for (int t = 0; t < nt; t += 2) {
            const bool last = (t == nt - 2);
            const char* a1 = cA + (size_t)(t + 1) * kstep;
            const char* a2 = last ? nA : cA + (size_t)(t + 2) * kstep; const char* b2 = last ? nB : cB + (size_t)(t + 2) * kstep;
            const char* a3 = a2 + kstep; const char* b3 = b2 + kstep;
            if (last && has_next) S.a_ready(nxt);
            if constexpr (SP2) {
            PG8_LDB(B0, 0, 0); PG8_LDB(B1, 0, 1); PG8_SCHED; PG8_LDA(At, 0, 0); PG8_STAGE(PG8_SA(1, 1), a1 + hstep, voffA);
            PG8_WAIT_V(8); PG8_WAIT_L(0); PG8_BAR; PG8_MMA(0, 0, At, B0); PG8_MMA(0, 1, At, B1); PG8_BAR; PG8_SCHED;
            PG8_LDA(At, 0, 1); PG8_STAGE(PG8_SB(0, 0), b2, voffB); PG8_STAGE(PG8_SB(0, 1), b2 + hstep, voffB); PG8_STAGE(PG8_SA(0, 0), a2, voffA);
            PG8_WAIT_V(8); PG8_WAIT_L(0); PG8_BAR; PG8_MMA(1, 0, At, B0); PG8_MMA(1, 1, At, B1); PG8_BAR; PG8_SCHED;
            PG8_LDB(B0, 1, 0); PG8_LDB(B1, 1, 1); PG8_SCHED; PG8_LDA(At, 1, 0); PG8_STAGE(PG8_SA(0, 1), a2 + hstep, voffA);
            PG8_WAIT_V(8); PG8_WAIT_L(0); PG8_BAR; PG8_MMA(0, 0, At, B0); PG8_MMA(0, 1, At, B1); PG8_BAR; PG8_SCHED;
            PG8_LDA(At, 1, 1); PG8_STAGE(PG8_SB(1, 0), b3, voffB); PG8_STAGE(PG8_SB(1, 1), b3 + hstep, voffB); PG8_STAGE(PG8_SA(1, 0), a3, voffA);
            PG8_WAIT_V(8); PG8_WAIT_L(0); PG8_BAR; PG8_MMA(1, 0, At, B0); PG8_MMA(1, 1, At, B1); PG8_BAR; PG8_SCHED;
            } else {
            PG8_LDB(B0, 0, 0); PG8_SCHED; PG8_LDA(At, 0, 0); PG8_STAGE(PG8_SA(1, 1), a1 + hstep, voffA);
            PG8_WAIT_L(8); PG8_BAR; PG8_WAIT_L(0); PG8_MMA(0, 0, At, B0); PG8_BAR; PG8_SCHED;
            PG8_LDB(B1, 0, 1); PG8_STAGE(PG8_SB(0, 0), b2, voffB);
            PG8_BAR; PG8_WAIT_L(0); PG8_MMA(0, 1, At, B1); PG8_BAR;
            PG8_LDA(At, 0, 1); PG8_STAGE(PG8_SA(0, 0), a2, voffA);
            PG8_BAR; PG8_WAIT_L(0); PG8_MMA(1, 0, At, B0); PG8_BAR; PG8_SCHED;
            PG8_STAGE(PG8_SB(0, 1), b2 + hstep, voffB);
            PG8_WAIT_V(6); PG8_BAR; PG8_MMA(1, 1, At, B1); PG8_BAR;
            PG8_LDB(B0, 1, 0); PG8_SCHED; PG8_LDA(At, 1, 0); PG8_STAGE(PG8_SA(0, 1), a2 + hstep, voffA);
            PG8_WAIT_L(8); PG8_BAR; PG8_WAIT_L(0); PG8_MMA(0, 0, At, B0); PG8_BAR; PG8_SCHED;
            PG8_LDB(B1, 1, 1); PG8_STAGE(PG8_SB(1, 0), b3, voffB);
            PG8_BAR; PG8_WAIT_L(0); PG8_MMA(0, 1, At, B1); PG8_BAR;
            PG8_LDA(At, 1, 1); PG8_STAGE(PG8_SA(1, 0), a3, voffA);
            PG8_BAR; PG8_WAIT_L(0); PG8_MMA(1, 0, At, B0); PG8_BAR; PG8_SCHED;
            PG8_STAGE(PG8_SB(1, 1), b3 + hstep, voffB);
            PG8_WAIT_V(6); PG8_BAR; PG8_MMA(1, 1, At, B1); PG8_BAR;
            }
        }
        if constexpr (ALIGN_EPI) { if (wr == 0) PG8_BAR; }
        if constexpr (!Epi::AFTER_DRAIN) { E(acc, cur, wr, wc, fr, fq); S.done(cur); }
        if (!has_next) break;
#pragma unroll
        for (int a = 0; a < 2; ++a)
#pragma unroll
            for (int b = 0; b < 2; ++b)
#pragma unroll
                for (int m = 0; m < 4; ++m)
#pragma unroll
                    for (int n = 0; n < 2; ++n) acc[a][b][m][n] = (f32x4){0.f, 0.f, 0.f, 0.f};
        cur = nxt; cA = nA; cB = nB; ++ui;
        if constexpr (ALIGN_EPI) { if (wr == 1) PG8_BAR; }
    }
    PG8_WAIT_V(0);
    if constexpr (!ALIGN_EPI) { if (wr == 0) PG8_BAR; }
    PG8_BAR;
    if constexpr (Epi::AFTER_DRAIN) { E.fused(acc, cur, wr, wc, fr, fq, lds, wid, lane); S.done(cur); }
#undef PG8_SA
#undef PG8_SB
#undef PG8_STAGE
#undef PG8_LDA
#undef PG8_LDB
#undef PG8_MMA
#undef PG8_WAIT_V
#undef PG8_WAIT_L
#undef PG8_BAR
#undef PG8_SCHED
}
}

#ifndef MK_PER_PHASE
#define MK_PER_PHASE 0
#endif
using pg8::bf16_t; using pg8::bf16x8; using pg8::f32x4; using pg8::u32x4;
typedef float f32x16 __attribute__((ext_vector_type(16)));
typedef unsigned u32x2 __attribute__((ext_vector_type(2)));
#define LAS __attribute__((address_space(3)))
constexpr int M = 16384, D = 1024, SEQ = 8192, NTHR = 512, NPH = 12;
constexpr float EPS = 1e-6f;
constexpr size_t MiB = 1u << 20;
constexpr size_t WS_RSS0 = 0, WS_RSS1 = 65536, WS_VSUM = 131072, WS_VSQ = 196608, WS_RSS2 = 262144;
constexpr size_t WS_BAR = 512 * 1024, BAR_BYTES = 16384;
constexpr size_t WS_APOW = 1 * MiB, WS_A128 = 1 * MiB + 131072, WS_BBT = 1 * MiB + 262144, WS_CCT = 1 * MiB + 524288;
constexpr size_t WS_COS = 2 * MiB, WS_SIN = 6 * MiB, WS_CHS = 10 * MiB;
constexpr size_t WS_WINE = 16 * MiB, WS_WGLU = 28 * MiB, WS_WOUTE = 30 * MiB, WS_WINO = 34 * MiB, WS_WOUTO = 46 * MiB;
constexpr size_t WS_U = 52 * MiB, WS_CAT = 84 * MiB, WS_K = 148 * MiB, WS_V = 180 * MiB, WS_SZB = 212 * MiB, WS_END = 244 * MiB;
constexpr size_t WS_X1 = WS_K;
constexpr int LDS_BYTES = 143360;

struct Args { const float* in[22]; float* out; unsigned char* ws; int ph_lo, ph_hi; };

__device__ __forceinline__ unsigned f2bf(float f) { unsigned u = __builtin_bit_cast(unsigned, f); return (u + 0x7fffu + ((u >> 16) & 1u)) >> 16; }
__device__ __forceinline__ unsigned pk2(float lo, float hi) { return pg8::cvt_pk_bf16(lo, hi); }
__device__ __forceinline__ float bflo(unsigned w) { return __builtin_bit_cast(float, w << 16); }
__device__ __forceinline__ float bfhi(unsigned w) { return __builtin_bit_cast(float, w & 0xffff0000u); }
__device__ __forceinline__ float bf2f(bf16_t b) { return __builtin_bit_cast(float, (unsigned)b << 16); }
__device__ __forceinline__ float fast_rcp(float x) { return __builtin_amdgcn_rcpf(x); }
__device__ __forceinline__ float sigmoidf_(float t) { return fast_rcp(1.f + __builtin_amdgcn_exp2f(-1.4426950408889634f * t)); }
__device__ __forceinline__ float siluf_(float t) { return t * sigmoidf_(t); }
__device__ __forceinline__ float geluf_(float x) { const float u = 0.7978845608028654f * (x + 0.044715f * x * x * x); return x * sigmoidf_(2.f * u); }
__device__ __forceinline__ float wave_sum(float v) {
#pragma unroll
    for (int o = 1; o < 64; o <<= 1) v += __shfl_xor(v, o);
    return v;
}
__device__ __forceinline__ float lg_gamma(int h) { return h == 0 ? -0.04580368961312479f : (h == 1 ? -0.02272007650008353f : (h == 2 ? -0.011315313227834146f : -0.005646563141142063f)); }
__device__ __forceinline__ void sincos_d(double x, double& s, double& c) {
    double t = x * 0.15915494309189535; t -= __builtin_rint(t);
    const double qd = __builtin_rint(4.0 * t); const int q = (int)qd;
    const double r = (t - 0.25 * qd) * 6.283185307179586; const double r2 = r * r;
    double sp = -1.0 / 1307674368000.0; sp = sp * r2 + 1.0 / 6227020800.0; sp = sp * r2 - 1.0 / 39916800.0; sp = sp * r2 + 1.0 / 362880.0; sp = sp * r2 - 1.0 / 5040.0; sp = sp * r2 + 1.0 / 120.0; sp = sp * r2 - 1.0 / 6.0; sp = sp * r2 + 1.0;
    const double sr = sp * r;
    double cp = 1.0 / 20922789888000.0; cp = cp * r2 - 1.0 / 87178291200.0; cp = cp * r2 + 1.0 / 479001600.0; cp = cp * r2 - 1.0 / 3628800.0; cp = cp * r2 + 1.0 / 40320.0; cp = cp * r2 - 1.0 / 720.0; cp = cp * r2 + 1.0 / 24.0; cp = cp * r2 - 0.5; cp = cp * r2 + 1.0;
    const int qq = q & 3;
    if (qq == 0) { s = sr; c = cp; } else if (qq == 1) { s = cp; c = -sr; } else if (qq == 2) { s = -sr; c = -cp; } else { s = -cp; c = sr; }
}

#define EPI_ARGS const f32x4 (&acc)[2][2][4][2], const pg8::Unit& u, int wr, int wc, int fr, int fq
__device__ __forceinline__ void st8bf(bf16_t* p, const float (&v)[8]) { u32x4 w; w.x = pk2(v[0], v[1]); w.y = pk2(v[2], v[3]); w.z = pk2(v[4], v[5]); w.w = pk2(v[6], v[7]); *(u32x4*)p = w; }
__device__ __forceinline__ void ld8bf(const bf16_t* p, float (&v)[8]) { const u32x4 w = *(const u32x4*)p; v[0] = bflo(w.x); v[1] = bfhi(w.x); v[2] = bflo(w.y); v[3] = bfhi(w.y); v[4] = bflo(w.z); v[5] = bfhi(w.z); v[6] = bflo(w.w); v[7] = bfhi(w.w); }
__device__ __forceinline__ void ld8f(const float* p, float (&v)[8]) { const f32x4 a = *(const f32x4*)p, b = *(const f32x4*)(p + 4); v[0] = a.x; v[1] = a.y; v[2] = a.z; v[3] = a.w; v[4] = b.x; v[5] = b.y; v[6] = b.z; v[7] = b.w; }
__device__ __forceinline__ void st8f(float* p, const float (&v)[8]) { *(f32x4*)p = (f32x4){v[0], v[1], v[2], v[3]}; *(f32x4*)(p + 4) = (f32x4){v[4], v[5], v[6], v[7]}; }
#define ACC8(dst, ai, bj, m, sc) do { const f32x4 _a = acc[ai][bj][m][0], _b = acc[ai][bj][m][1]; dst[0] = _a.x * (sc); dst[1] = _a.y * (sc); dst[2] = _a.z * (sc); dst[3] = _a.w * (sc); dst[4] = _b.x * (sc); dst[5] = _b.y * (sc); dst[6] = _b.z * (sc); dst[7] = _b.w * (sc); } while (0)

struct Epi1 {
    static constexpr bool PERM = true, AFTER_DRAIN = false;
    const float* rss; bf16_t* U; bf16_t* CAT; bf16_t* Kb; bf16_t* Vb; bf16_t* SZB; const float* COS; const float* SIN;
    __device__ __forceinline__ void operator()(EPI_ARGS) const {
        const int seg = u.pn >> 2, cb = (u.pn & 3) * 256, colL = wc * 32 + 8 * fq;
        const int row0 = u.pm * 256 + wr * 64 + fr;
        float rsv[2][4];
#pragma unroll
        for (int ai = 0; ai < 2; ++ai)
#pragma unroll
            for (int m = 0; m < 4; ++m) rsv[ai][m] = rss[row0 + ai * 128 + m * 16];
        if (seg == 2 || seg == 3) {
#pragma unroll
            for (int aim = 0; aim < 4; ++aim) { const int ai = aim >> 1, mlo = (aim & 1) * 2;
                f32x4 cv[4][2], sv[4][2];
#pragma unroll
                for (int m = mlo; m < mlo + 2; ++m) { const int pos = (row0 + ai * 128 + m * 16) & (SEQ - 1); const float* pc = COS + (size_t)pos * 128 + colL; const float* ps = SIN + (size_t)pos * 128 + colL;
                    cv[m][0] = *(const f32x4*)pc; cv[m][1] = *(const f32x4*)(pc + 4); sv[m][0] = *(const f32x4*)ps; sv[m][1] = *(const f32x4*)(ps + 4); }
#pragma unroll
                for (int m = mlo; m < mlo + 2; ++m) {
                    const int row = row0 + ai * 128 + m * 16;
                    const float rs = __builtin_amdgcn_rsqf(rsv[ai][m] * (1.f / 1024.f) + EPS);
                    float x1[8], x2[8], o1[8], o2[8];
                    const float sc = (seg == 3) ? rs * 0.0625f : rs;
                    ACC8(x1, ai, 0, m, sc); ACC8(x2, ai, 1, m, sc);
                    const float cs[8] = {cv[m][0].x, cv[m][0].y, cv[m][0].z, cv[m][0].w, cv[m][1].x, cv[m][1].y, cv[m][1].z, cv[m][1].w};
                    const float sn[8] = {sv[m][0].x, sv[m][0].y, sv[m][0].z, sv[m][0].w, sv[m][1].x, sv[m][1].y, sv[m][1].z, sv[m][1].w};
#pragma unroll
                    for (int j = 0; j < 8; ++j) { o1[j] = x1[j] * cs[j] - x2[j] * sn[j]; o2[j] = x1[j] * sn[j] + x2[j] * cs[j]; }
                    bf16_t* dst = (seg == 2) ? CAT + (size_t)row * 2048 + 1024 + cb + colL : Kb + (size_t)row * 1024 + cb + colL;
                    st8bf(dst, o1); st8bf(dst + 128, o2);
                }
            }
        } else {
#pragma unroll
            for (int ai = 0; ai < 2; ++ai)
#pragma unroll
                for (int m = 0; m < 4; ++m) {
                    const int row = row0 + ai * 128 + m * 16;
                    const float rs = __builtin_amdgcn_rsqf(rsv[ai][m] * (1.f / 1024.f) + EPS);
#pragma unroll
                    for (int bj = 0; bj < 2; ++bj) {
                        float v[8]; ACC8(v, ai, bj, m, rs);
                        const int col = cb + bj * 128 + colL;
                        if (seg == 1 || seg == 5) {
#pragma unroll
                            for (int j = 0; j < 8; ++j) v[j] = siluf_(v[j]);
                        }
                        bf16_t* dst = (seg == 0) ? U + (size_t)row * 1024 + col : (seg == 1) ? CAT + (size_t)row * 2048 + col : (seg == 4) ? Vb + (size_t)row * 1024 + col : SZB + (size_t)row * 1024 + col;
                        st8bf(dst, v);
                    }
                }
        }
    }
};
struct EpiGlu {
    static constexpr bool PERM = true, AFTER_DRAIN = false;
    const float* bglu; const bf16_t* Y1; bf16_t* CAT;
    __device__ __forceinline__ void operator()(EPI_ARGS) const {
        const int colL = wc * 32 + 8 * fq, row0 = u.pm * 256 + wr * 64 + fr;
#pragma unroll
        for (int bj = 0; bj < 2; ++bj) {
            const int col = u.pn * 256 + bj * 128 + colL;
            float bb[8]; ld8f(bglu + col, bb);
#pragma unroll
            for (int ai = 0; ai < 2; ++ai) {
            u32x4 yy[2][4], zz[2][4];
#pragma unroll
                for (int m = 0; m < 4; ++m) { const int row = row0 + ai * 128 + m * 16; yy[ai][m] = *(const u32x4*)(Y1 + (size_t)row * 1024 + col); zz[ai][m] = *(const u32x4*)(CAT + (size_t)row * 2048 + col); }
#pragma unroll
                for (int m = 0; m < 4; ++m) {
                    const int row = row0 + ai * 128 + m * 16;
                    float t[8]; ACC8(t, ai, bj, m, 1.f);
                    const u32x4 y = yy[ai][m], z = zz[ai][m];
                    const float yf[8] = {bflo(y.x), bfhi(y.x), bflo(y.y), bfhi(y.y), bflo(y.z), bfhi(y.z), bflo(y.w), bfhi(y.w)};
                    const float zf[8] = {bflo(z.x), bfhi(z.x), bflo(z.y), bfhi(z.y), bflo(z.z), bfhi(z.z), bflo(z.w), bfhi(z.w)};
#pragma unroll
                    for (int j = 0; j < 8; ++j) t[j] = yf[j] * sigmoidf_(t[j] + bb[j]) * zf[j];
                    st8bf(CAT + (size_t)row * 2048 + col, t);
                }
            }
        }
    }
};
struct EpiOut {
    static constexpr bool PERM = true, AFTER_DRAIN = false;
    const float* Xi; float* Xo; bf16_t* XG; const float* g; float* rss;
    __device__ __forceinline__ void operator()(EPI_ARGS) const {
        const int colL = wc * 32 + 8 * fq, row0 = u.pm * 256 + wr * 64 + fr;
        float gg[2][8];
        if (XG) { ld8f(g + u.pn * 256 + colL, gg[0]); ld8f(g + u.pn * 256 + 128 + colL, gg[1]); }
#pragma unroll
        for (int aim = 0; aim < 4; ++aim) { const int ai = aim >> 1, mlo = (aim & 1) * 2;
            f32x4 xv[4][2][2];
#pragma unroll
            for (int m = mlo; m < mlo + 2; ++m)
#pragma unroll
                for (int bj = 0; bj < 2; ++bj) { const float* p = Xi + (size_t)(row0 + ai * 128 + m * 16) * 1024 + u.pn * 256 + bj * 128 + colL; xv[m][bj][0] = *(const f32x4*)p; xv[m][bj][1] = *(const f32x4*)(p + 4); }
#pragma unroll
            for (int m = mlo; m < mlo + 2; ++m) {
                const int row = row0 + ai * 128 + m * 16; float ss = 0.f;
#pragma unroll
                for (int bj = 0; bj < 2; ++bj) {
                    const int col = u.pn * 256 + bj * 128 + colL;
                    float a[8]; ACC8(a, ai, bj, m, 1.f);
                    float x[8] = {xv[m][bj][0].x, xv[m][bj][0].y, xv[m][bj][0].z, xv[m][bj][0].w, xv[m][bj][1].x, xv[m][bj][1].y, xv[m][bj][1].z, xv[m][bj][1].w};
#pragma unroll
                    for (int j = 0; j < 8; ++j) { x[j] += a[j]; ss += x[j] * x[j]; }
                    st8f(Xo + (size_t)row * 1024 + col, x);
                    if (XG) {
#pragma unroll
                        for (int j = 0; j < 8; ++j) x[j] *= gg[bj][j];
                        st8bf(XG + (size_t)row * 1024 + col, x); }
                }
                ss += __shfl_xor(ss, 16); ss += __shfl_xor(ss, 32);
                if (fq == 0) atomicAdd(rss + row, ss);
            }
        }
    }
};
struct Epi7 {
    static constexpr bool PERM = true, AFTER_DRAIN = false;
    const float* rss; bf16_t* VB; float* vsum; float* vsq;
    __device__ __forceinline__ void operator()(EPI_ARGS) const {
        const int colL = wc * 32 + 8 * fq, row0 = u.pm * 256 + wr * 64 + fr;
        float rsv[2][4];
#pragma unroll
        for (int ai = 0; ai < 2; ++ai)
#pragma unroll
            for (int m = 0; m < 4; ++m) rsv[ai][m] = rss[row0 + ai * 128 + m * 16];
#pragma unroll
        for (int ai = 0; ai < 2; ++ai)
#pragma unroll
            for (int m = 0; m < 4; ++m) {
                const int row = row0 + ai * 128 + m * 16; float s = 0.f, q = 0.f;
                const float rs = __builtin_amdgcn_rsqf(rsv[ai][m] * (1.f / 1024.f) + EPS);
#pragma unroll
                for (int bj = 0; bj < 2; ++bj) {
                    const int col = u.pn * 256 + bj * 128 + colL;
                    float v[8]; ACC8(v, ai, bj, m, rs);
#pragma unroll
                    for (int j = 0; j < 8; ++j) { v[j] = geluf_(v[j]); s += v[j]; q += v[j] * v[j]; }
                    st8bf(VB + (size_t)row * 2048 + col, v);
                }
                s += __shfl_xor(s, 16); s += __shfl_xor(s, 32); q += __shfl_xor(q, 16); q += __shfl_xor(q, 32);
                if (fq == 0) { atomicAdd(vsum + row, s); atomicAdd(vsq + row, q); }
            }
    }
};
struct Epi9 {
    static constexpr bool PERM = true, AFTER_DRAIN = false;
    const float* rss; const bf16_t* SB; bf16_t* Y;
    __device__ __forceinline__ void operator()(EPI_ARGS) const {
        const int colL = wc * 32 + 8 * fq, row0 = u.pm * 256 + wr * 64 + fr, col = u.pn * 128 + colL;
        float rsv[2][4]; u32x4 sv[2][4];
#pragma unroll
        for (int ai = 0; ai < 2; ++ai)
#pragma unroll
            for (int m = 0; m < 4; ++m) { const int row = row0 + ai * 128 + m * 16; rsv[ai][m] = rss[row]; sv[ai][m] = *(const u32x4*)(SB + (size_t)row * 2048 + col); }
#pragma unroll
        for (int ai = 0; ai < 2; ++ai)
#pragma unroll
            for (int m = 0; m < 4; ++m) {
                const int row = row0 + ai * 128 + m * 16;
                const float rs = __builtin_amdgcn_rsqf(rsv[ai][m] * (1.f / 1024.f) + EPS);
                float uu[8], zz[8]; ACC8(uu, ai, 0, m, rs); ACC8(zz, ai, 1, m, rs);
                const u32x4 w = sv[ai][m]; const float s[8] = {bflo(w.x), bfhi(w.x), bflo(w.y), bfhi(w.y), bflo(w.z), bfhi(w.z), bflo(w.w), bfhi(w.w)};
#pragma unroll
                for (int j = 0; j < 8; ++j) uu[j] = geluf_(uu[j]) * s[j] * siluf_(zz[j]);
                st8bf(Y + (size_t)row * 2048 + col, uu);
            }
    }
};

__device__ __forceinline__ void p0_transpose_item(const float* W, int K, int N, bf16_t* WT, int row_off, LAS float* scr, int kb, int nb, int lane) {
    const int k0 = 64 * kb, n0 = 32 * nb;
#pragma unroll 8
    for (int i = 0; i < 32; ++i) { const int kk = 2 * i + (lane >> 5); scr[kk * 33 + (lane & 31)] = W[(size_t)(k0 + kk) * N + n0 + (lane & 31)]; }
    asm volatile("s_waitcnt lgkmcnt(0)" ::: "memory");
    const int c = lane & 7;
#pragma unroll
    for (int j = 0; j < 4; ++j) { const int n = (lane >> 3) + 8 * j; const LAS float* s = scr + (8 * c) * 33 + n;
        u32x4 o; o.x = pk2(s[0 * 33], s[1 * 33]); o.y = pk2(s[2 * 33], s[3 * 33]); o.z = pk2(s[4 * 33], s[5 * 33]); o.w = pk2(s[6 * 33], s[7 * 33]);
        *(u32x4*)(WT + (size_t)(row_off + n0 + n) * K + k0 + 8 * c) = o; }
    asm volatile("s_waitcnt lgkmcnt(0)" ::: "memory");
}
__device__ __forceinline__ int wino_row(int n) {
    if (n < 2048) return 2048 + 256 * (n >> 7) + (n & 127);
    if (n < 4096) return n - 2048;
    const int z = n - 4096; return 2048 + 256 * (z >> 7) + 128 + (z & 127);
}

template <bool FINAL>
__device__ __forceinline__ void s5_item(int b, int c, int g, bf16_t* U, float* CHS, const float* APOW, const bf16_t* BBT, const bf16_t* CCT, const float* dsk, LAS unsigned char* wlds, int lane) {
    const int h = lane >> 5, r = lane & 31;
    const size_t row0 = (size_t)b * SEQ + (size_t)c * 128;
    bf16x8 bfrag[4];
#pragma unroll
    for (int nt = 0; nt < 4; ++nt) bfrag[nt] = *(const bf16x8*)(BBT + ((size_t)(g * 128 + nt * 32 + r) * 16 + 8 * h));
    float ar[2][4], ai_[2][4], cr[2], ci[2];
#pragma unroll
    for (int ph = 0; ph < 2; ++ph) {
        const int p = 32 * ph + r; const f32x4 w0 = *(const f32x4*)(APOW + (size_t)(g * 64 + p) * 8), w1 = *(const f32x4*)(APOW + (size_t)(g * 64 + p) * 8 + 4);
        ar[ph][0] = w0.x; ai_[ph][0] = w0.y; ar[ph][1] = w0.z; ai_[ph][1] = w0.w; ar[ph][2] = w1.x; ai_[ph][2] = w1.y; ar[ph][3] = w1.z; ai_[ph][3] = w1.w;
        if (FINAL) { const float* cp = CHS + ((size_t)((b * 64 + c) * 64 + g) * 64 + p) * 2; cr[ph] = cp[0]; ci[ph] = cp[1]; } else { cr[ph] = 0.f; ci[ph] = 0.f; }
    }
    bf16x8 cfrag[4];
    if (FINAL) {
#pragma unroll
        for (int ks = 0; ks < 4; ++ks) cfrag[ks] = *(const bf16x8*)(CCT + ((size_t)(g * 16 + (lane & 15)) * 128 + ks * 32 + 8 * (lane >> 4)));
    }
    const float dk = FINAL ? dsk[g * 16 + (lane & 15)] : 0.f;
    for (int sb = 0; sb < 4; ++sb) {
        const bf16x8 afrag = *(const bf16x8*)(U + (row0 + sb * 32 + r) * 1024 + g * 16 + 8 * h);
        f32x16 re[2], im[2];
        const f32x16 zero16 = {0.f, 0.f, 0.f, 0.f, 0.f, 0.f, 0.f, 0.f, 0.f, 0.f, 0.f, 0.f, 0.f, 0.f, 0.f, 0.f};
        re[0] = __builtin_amdgcn_mfma_f32_32x32x16_bf16(afrag, bfrag[0], zero16, 0, 0, 0);
        re[1] = __builtin_amdgcn_mfma_f32_32x32x16_bf16(afrag, bfrag[1], zero16, 0, 0, 0);
        im[0] = __builtin_amdgcn_mfma_f32_32x32x16_bf16(afrag, bfrag[2], zero16, 0, 0, 0);
        im[1] = __builtin_amdgcn_mfma_f32_32x32x16_bf16(afrag, bfrag[3], zero16, 0, 0, 0);
#pragma unroll
        for (int ph = 0; ph < 2; ++ph) {
            const float a1r = ar[ph][0], a1i = ai_[ph][0], a4r = ar[ph][3], a4i = ai_[ph][3];
#pragma unroll
            for (int q = 0; q < 4; ++q) {
#pragma unroll
                for (int j = 1; j < 4; ++j) { const int i = 4 * q + j; const float pr = re[ph][i - 1], pi = im[ph][i - 1];
                    re[ph][i] += a1r * pr - a1i * pi; im[ph][i] += a1r * pi + a1i * pr; }
            }
#pragma unroll
            for (int q = 0; q < 4; ++q) {
                const float Er = re[ph][4 * q + 3], Ei = im[ph][4 * q + 3];
                const float Xr = Er + a4r * cr[ph] - a4i * ci[ph], Xi = Ei + a4r * ci[ph] + a4i * cr[ph];
                const float Xor_ = __shfl_xor(Xr, 32), Xoi = __shfl_xor(Xi, 32);
                const float cinr = h ? Xor_ : cr[ph], cini = h ? Xoi : ci[ph];
                const float Yr = Er + a4r * cinr - a4i * cini, Yi = Ei + a4r * cini + a4i * cinr;
                const float Yor = __shfl_xor(Yr, 32), Yoi = __shfl_xor(Yi, 32);
                if (FINAL) {
#pragma unroll
                    for (int j = 0; j < 4; ++j) { const int i = 4 * q + j; re[ph][i] += ar[ph][j] * cinr - ai_[ph][j] * cini; im[ph][i] += ar[ph][j] * cini + ai_[ph][j] * cinr; }
                }
                cr[ph] = h ? Yr : Yor; ci[ph] = h ? Yi : Yoi;
            }
        }
        if (FINAL) {
#pragma unroll
            for (int ph = 0; ph < 2; ++ph)
#pragma unroll
                for (int i = 0; i < 16; ++i) { const int tok = (i & 3) + 8 * (i >> 2) + 4 * h; const int p = 32 * ph + r;
                    *(LAS unsigned*)(wlds + tok * 272 + 4 * p) = pk2(re[ph][i], im[ph][i]); }
            asm volatile("s_waitcnt lgkmcnt(0)" ::: "memory");
            f32x4 yacc[2] = {(f32x4){0.f, 0.f, 0.f, 0.f}, (f32x4){0.f, 0.f, 0.f, 0.f}};
#pragma unroll
            for (int mt = 0; mt < 2; ++mt)
#pragma unroll
                for (int ks = 0; ks < 4; ++ks) { const bf16x8 a = *(const LAS bf16x8*)(wlds + (mt * 16 + (lane & 15)) * 272 + (ks * 32 + 8 * (lane >> 4)) * 2);
                    yacc[mt] = __builtin_amdgcn_mfma_f32_16x16x32_bf16(a, cfrag[ks], yacc[mt], 0, 0, 0); }
            asm volatile("s_waitcnt lgkmcnt(0)" ::: "memory");
#pragma unroll
            for (int mt = 0; mt < 2; ++mt)
#pragma unroll
                for (int j = 0; j < 4; ++j) { const size_t row = row0 + sb * 32 + mt * 16 + 4 * (lane >> 4) + j; const bf16_t* pu = U + row * 1024 + g * 16 + (lane & 15);
                    const float y = yacc[mt][j] + dk * bf2f(*pu); U[row * 1024 + g * 16 + (lane & 15)] = (bf16_t)f2bf(geluf_(y)); }
        }
    }
    if (!FINAL && h == 0) {
#pragma unroll
        for (int ph = 0; ph < 2; ++ph) { float* cp = CHS + ((size_t)((b * 64 + c) * 64 + g) * 64 + 32 * ph + r) * 2; cp[0] = cr[ph]; cp[1] = ci[ph]; }
    }
}

__device__ __forceinline__ bf16x8 gather8(const LAS bf16_t* p, int pitch) {
    bf16x8 v;
#pragma unroll
    for (int j = 0; j < 8; ++j) v[j] = (short)p[j * pitch];
    return v;
}
#define MFMA32(a, b, c) __builtin_amdgcn_mfma_f32_32x32x16_bf16((a), (b), (c), 0, 0, 0)
#define ZERO16 ((f32x16){0.f, 0.f, 0.f, 0.f, 0.f, 0.f, 0.f, 0.f, 0.f, 0.f, 0.f, 0.f, 0.f, 0.f, 0.f, 0.f})

#define XB_TMO      128
#define XB_XCNT(j)  (256  + 64 * (j))
#define XB_XSUB(j)  (1280 + 64 * (j))
#define XB_XGEN(j)  (2304 + 64 * (j))
#define XB_TOP      3328
#define XB_TOPGEN   3392
#define XCD_BAR_WORDS 3456
#define XB_SPIN_CAP (1u << 18)

__device__ __forceinline__ unsigned xb_ld(unsigned* p)              { return __hip_atomic_load(p, __ATOMIC_RELAXED, __HIP_MEMORY_SCOPE_AGENT); }
__device__ __forceinline__ unsigned xb_add(unsigned* p, unsigned v) { return __hip_atomic_fetch_add(p, v, __ATOMIC_RELAXED, __HIP_MEMORY_SCOPE_AGENT); }
__device__ __forceinline__ unsigned xb_xcc_id() { return (unsigned)__builtin_amdgcn_s_getreg((3 << 11) | 20) & 0xFu; }
#define XB_SPIN(cond, bar) do { unsigned _sp = 0; while (cond) { __builtin_amdgcn_s_sleep(1); \
    if ((++_sp & 255u) == 0u) { if (xb_ld(&(bar)[XB_TMO])) break; if (_sp > XB_SPIN_CAP) { atomicAdd(&(bar)[XB_TMO], 1u); break; } } } } while (0)

struct XcdBarrier {
    unsigned* bar; unsigned x;
    volatile LAS unsigned* st;
};

__device__ __forceinline__ XcdBarrier xcd_barrier_post(unsigned* bar, volatile LAS unsigned* st) {
    XcdBarrier b; b.bar = bar; b.x = xb_xcc_id(); b.st = st;
    if (threadIdx.x == 0) (void)xb_add(&bar[XB_XCNT(b.x)], 1u);
    return b;
}
__device__ __forceinline__ void xcd_barrier_complete(unsigned* bar, unsigned x, unsigned& nloc, unsigned& nx) {
    const unsigned G = gridDim.x * gridDim.y * gridDim.z;
    unsigned sum, cnt, mine, sp = 0u;
    for (;;) {
        sum = 0u; cnt = 0u; mine = 0u;
#pragma unroll
        for (unsigned j = 0; j < 16; ++j) { const unsigned c = xb_ld(&bar[XB_XCNT(j)]); sum += c; cnt += (c > 0u) ? 1u : 0u; mine = (j == x) ? c : mine; }
        if (sum == G) break;
        __builtin_amdgcn_s_sleep(1);
        if ((++sp & 255u) == 0u) { if (xb_ld(&bar[XB_TMO])) break; if (sp > XB_SPIN_CAP) { atomicAdd(&bar[XB_TMO], 1u); break; } }
    }
    nloc = mine > 0u ? mine : 1u; nx = cnt > 0u ? cnt : 1u;
}

__device__ __forceinline__ void xcd_barrier(const XcdBarrier& b) {
    asm volatile("s_waitcnt vmcnt(0)" ::: "memory");
    __syncthreads();
    if (threadIdx.x == 0) {
        unsigned* bar = b.bar;
        __builtin_amdgcn_s_waitcnt(0);
        unsigned nloc = b.st[0], nx = b.st[1];
        if (nloc == 0u) { xcd_barrier_complete(bar, b.x, nloc, nx); b.st[0] = nloc; b.st[1] = nx; }
        const unsigned old = xb_add(&bar[XB_XSUB(b.x)], 1u);
        const unsigned gen = old / nloc;
        if (old + 1u == (gen + 1u) * nloc) {
            __builtin_amdgcn_fence(__ATOMIC_RELEASE, "agent");
            asm volatile("s_waitcnt vmcnt(0)" ::: "memory");
            const unsigned og = xb_add(&bar[XB_TOP], 1u);
            const unsigned tg = og / nx;
            if (og + 1u == (tg + 1u) * nx) xb_add(&bar[XB_TOPGEN], 1u);
            else XB_SPIN(xb_ld(&bar[XB_TOPGEN]) == tg, bar);
            __builtin_amdgcn_fence(__ATOMIC_ACQUIRE, "agent");
            xb_add(&bar[XB_XGEN(b.x)], 1u);
            asm volatile("s_waitcnt vmcnt(0)" ::: "memory");
        } else {
            XB_SPIN(xb_ld(&bar[XB_XGEN(b.x)]) == gen, bar);
            __builtin_amdgcn_fence(__ATOMIC_ACQUIRE, "agent");
            asm volatile("s_waitcnt vmcnt(0)" ::: "memory");
        }
    }
    __syncthreads();
}

__global__ void __launch_bounds__(NTHR, 2) mk_fwd(Args args) {
    extern __shared__ __attribute__((aligned(16))) unsigned char lds_raw[];
    LAS unsigned char* lds = (LAS unsigned char*)lds_raw;
    cg::grid_group grid = cg::this_grid();
    const int tid = threadIdx.x, lane = tid & 63, wid = __builtin_amdgcn_readfirstlane(tid >> 6);
    const int G = gridDim.x, bid = blockIdx.x;
    const int gw = bid * 8 + wid, NGW = G * 8;
    const int gtid = bid * NTHR + tid, NGT = G * NTHR;
    unsigned char* ws = args.ws;
    const float* x = args.in[0];
    float* RSS0 = (float*)(ws + WS_RSS0); float* RSS1 = (float*)(ws + WS_RSS1); float* VSUM = (float*)(ws + WS_VSUM); float* VSQ = (float*)(ws + WS_VSQ); float* RSS2 = (float*)(ws + WS_RSS2);
    float* APOW = (float*)(ws + WS_APOW); float* A128 = (float*)(ws + WS_A128); bf16_t* BBT = (bf16_t*)(ws + WS_BBT); bf16_t* CCT = (bf16_t*)(ws + WS_CCT);
    float* COS = (float*)(ws + WS_COS); float* SIN = (float*)(ws + WS_SIN); float* CHS = (float*)(ws + WS_CHS);
    bf16_t* WINE = (bf16_t*)(ws + WS_WINE); bf16_t* WGLU = (bf16_t*)(ws + WS_WGLU); bf16_t* WOUTE = (bf16_t*)(ws + WS_WOUTE); bf16_t* WINO = (bf16_t*)(ws + WS_WINO); bf16_t* WOUTO = (bf16_t*)(ws + WS_WOUTO);
    bf16_t* U = (bf16_t*)(ws + WS_U); bf16_t* CAT = (bf16_t*)(ws + WS_CAT); bf16_t* Kb = (bf16_t*)(ws + WS_K); bf16_t* Vb = (bf16_t*)(ws + WS_V); bf16_t* SZB = (bf16_t*)(ws + WS_SZB);
    float* X1 = (float*)(ws + WS_X1);
    bf16_t* XG0 = (bf16_t*)args.out;
    bf16_t* STATE = (bf16_t*)args.out;
    bf16_t* VB = (bf16_t*)args.out;
    const int lo = args.ph_lo, hi = args.ph_hi;
    volatile LAS unsigned* xst = (volatile LAS unsigned*)(lds + LDS_BYTES - 64);
    if (tid == 0) { xst[0] = 0u; xst[1] = 0u; }
    __syncthreads();
    const XcdBarrier xbar = xcd_barrier_post((unsigned*)(ws + WS_BAR), xst);
#ifndef PHMASK
#define PHMASK 0xFFF
#endif
#define IN(k) (((PHMASK >> (k)) & 1) && lo <= (k) && (k) < hi)
#define SEAM(k) do { if (IN(k) && IN((k) + 1)) { if ((k) == 0) grid.sync(); else xcd_barrier(xbar); } } while (0)
#ifndef PROBE_REP
#define PROBE_REP (-1)
#endif
#define PROBE_BEGIN(k) for (int pass = (PROBE_REP == (k)) ? 0 : 1; pass < 2; ++pass) { const bool dummy = (pass == 0); const size_t omask = dummy ? (size_t)2047 : ~(size_t)0; (void)omask;
#define PROBE_END if (pass == 0) grid.sync(); }
    bf16_t* DUMMY = (bf16_t*)(ws + WS_END);

    if (IN(0)) {
        LAS float* scr = (LAS float*)(lds + wid * 16384);
        constexpr int I_INE = 16 * 192, I_GLU = 16 * 32, I_OUTE = 32 * 32, I_INO = 16 * 192, I_OUTO = 32 * 32;
        constexpr int NIT = I_INE + I_GLU + I_OUTE + I_INO + I_OUTO;
        for (int it = gw; it < NIT; it += NGW) {
            int rr = it;
            if (rr < I_INE) { p0_transpose_item(args.in[2], 1024, 6144, WINE, 0, scr, rr / 192, rr % 192, lane); continue; } rr -= I_INE;
            if (rr < I_GLU) { p0_transpose_item(args.in[11], 1024, 1024, WGLU, 0, scr, rr / 32, rr % 32, lane); continue; } rr -= I_GLU;
            if (rr < I_OUTE) { p0_transpose_item(args.in[14], 2048, 1024, WOUTE, 0, scr, rr / 32, rr % 32, lane); continue; } rr -= I_OUTE;
            if (rr < I_INO) { const int nb = rr % 192; p0_transpose_item(args.in[16], 1024, 6144, WINO, wino_row(32 * nb) - 32 * nb, scr, rr / 192, nb, lane); continue; } rr -= I_INO;
            p0_transpose_item(args.in[20], 2048, 1024, WOUTO, 0, scr, rr / 32, rr % 32, lane);
        }
        for (int m = gw; m < M; m += NGW) {
            const f32x4* xr = (const f32x4*)(x + (size_t)m * D) + lane; const f32x4* gr = (const f32x4*)args.in[1] + lane;
            float s = 0.f; u32x2* o8 = (u32x2*)(XG0 + (size_t)m * D) + lane;
#pragma unroll
            for (int j = 0; j < 4; ++j) { const f32x4 v = xr[64 * j], gg = gr[64 * j]; s += (v.x * v.x + v.y * v.y) + (v.z * v.z + v.w * v.w);
                u32x2 w; w.x = pk2(v.x * gg.x, v.y * gg.y); w.y = pk2(v.z * gg.z, v.w * gg.w); o8[64 * j] = w; }
            s = wave_sum(s); if (lane == 0) RSS0[m] = s;
        }
        for (int e = gtid; e < SEQ * 128; e += NGT) { const int pos = e >> 7, i = e & 127;
            const double inv = exp(-(double)i * (9.210340371976184 / 128.0)); double s, c; sincos_d((double)pos * inv, s, c); COS[e] = (float)c; SIN[e] = (float)s; }
        for (int e = gtid; e < 4096; e += NGT) { const int g = e >> 6, p = e & 63;
            const double lr = fmin((double)args.in[3][e], -1e-4), li = (double)args.in[4][e], dt = exp((double)args.in[5][g]);
            const double mag = exp(lr * dt); double sn, cs; sincos_d(li * dt, sn, cs);
            const double abr = mag * cs, abi = mag * sn, den = lr * lr + li * li, nr = abr - 1.0, ni = abi;
            const double zr = (nr * lr + ni * li) / den, zi = (ni * lr - nr * li) / den;
            double pr = abr, pi = abi;
#pragma unroll
            for (int k = 0; k < 4; ++k) { APOW[e * 8 + 2 * k] = (float)pr; APOW[e * 8 + 2 * k + 1] = (float)pi; const double t = pr * abr - pi * abi; pi = pr * abi + pi * abr; pr = t; }
            double qr = abr, qi = abi;
#pragma unroll
            for (int k = 0; k < 7; ++k) { const double t = qr * qr - qi * qi; qi = 2.0 * qr * qi; qr = t; }
            A128[e * 2] = (float)qr; A128[e * 2 + 1] = (float)qi;
            const float* br = args.in[6] + (size_t)e * 16; const float* bi = args.in[7] + (size_t)e * 16;
#pragma unroll
            for (int k = 0; k < 16; ++k) { const double b_r = br[k], b_i = bi[k];
                BBT[(size_t)(g * 128 + p) * 16 + k] = (bf16_t)f2bf((float)(zr * b_r - zi * b_i)); BBT[(size_t)(g * 128 + 64 + p) * 16 + k] = (bf16_t)f2bf((float)(zr * b_i + zi * b_r)); }
#pragma unroll
            for (int hh = 0; hh < 16; ++hh) { const float c_r = args.in[8][(size_t)(g * 16 + hh) * 64 + p], c_i = args.in[9][(size_t)(g * 16 + hh) * 64 + p];
                CCT[(size_t)(g * 16 + hh) * 128 + 2 * p] = (bf16_t)f2bf(c_r); CCT[(size_t)(g * 16 + hh) * 128 + 2 * p + 1] = (bf16_t)f2bf(-c_i); }
        }
        for (int e = gtid; e < M; e += NGT) { RSS1[e] = 0.f; VSUM[e] = 0.f; VSQ[e] = 0.f; RSS2[e] = 0.f; }
        __syncthreads();
    }
    SEAM(0);
    if (IN(1)) {
        pg8::Gemm g{XG0, WINE, M, 6144, 1024}; pg8::StaticOrder S; S.init(M, 6144, G, bid);
        Epi1 E{RSS0, U, CAT, Kb, Vb, SZB, COS, SIN};
        pg8::gemm_phase<Epi1, pg8::StaticOrder, true, true>(lds, g, S, E);
    }
    SEAM(1);
    if (IN(2)) {
        for (int it = gw; it < 2 * 64 * 64; it += NGW) { const int g = it & 63, c = (it >> 6) & 63, b = it >> 12;
            s5_item<false>(b, c, g, U, CHS, APOW, BBT, CCT, args.in[10], lds + wid * 8704, lane); }
        __syncthreads();
        LAS bf16_t* Vs = (LAS bf16_t*)lds; LAS bf16_t* Ks = (LAS bf16_t*)(lds + 34816);
        const int wm = wid >> 1, wn = wid & 1, h5_ = lane >> 5, r_ = lane & 31;
        u32x4 pv[4], pk[4];
#define RA_LOAD(IT) do { const int kt_ = (IT) & 1, vt_ = ((IT) >> 1) & 1, hh_ = ((IT) >> 2) & 3, c_ = ((IT) >> 4) & 63, b_ = (IT) >> 10; const size_t rw0 = (size_t)b_ * SEQ + (size_t)c_ * 128; \
            _Pragma("unroll") for (int i = 0; i < 4; ++i) { const int idx = tid + NTHR * i, row = idx >> 4, ch = idx & 15; \
                pv[i] = *(const u32x4*)(Vb + (rw0 + row) * 1024 + hh_ * 256 + vt_ * 128 + ch * 8); pk[i] = *(const u32x4*)(Kb + (rw0 + row) * 1024 + hh_ * 256 + kt_ * 128 + ch * 8); } } while (0)
        if (bid < 2048) RA_LOAD(bid);
        for (int it = bid; it < 2048; it += G) {
            const int kt = it & 1, vt = (it >> 1) & 1, hh = (it >> 2) & 3, c = (it >> 4) & 63, b = it >> 10;
            const float lg = lg_gamma(hh);
            int h5 = h5_, r = r_; asm volatile("" : "+v"(h5), "+v"(r));
#pragma unroll
            for (int i = 0; i < 4; ++i) { const int idx = tid + NTHR * i, row = idx >> 4, ch = idx & 15;
                const float z = __builtin_amdgcn_exp2f((float)(127 - row) * lg); const u32x4 w = pv[i]; u32x4 o;
                o.x = pk2(bflo(w.x) * z, bfhi(w.x) * z); o.y = pk2(bflo(w.y) * z, bfhi(w.y) * z); o.z = pk2(bflo(w.z) * z, bfhi(w.z) * z); o.w = pk2(bflo(w.w) * z, bfhi(w.w) * z);
                *(LAS u32x4*)(Vs + row * 136 + ch * 8) = o; *(LAS u32x4*)(Ks + row * 136 + ch * 8) = pk[i]; }
            __syncthreads();
            if (it + G < 2048) RA_LOAD(it + G);
            f32x16 acc[2] = {ZERO16, ZERO16};
#pragma unroll 4
            for (int ks = 0; ks < 8; ++ks) { const int m0 = 16 * ks + 8 * h5;
                const bf16x8 a = gather8(Vs + m0 * 136 + 32 * wm + r, 136);
#pragma unroll
                for (int nt = 0; nt < 2; ++nt) { const bf16x8 bb = gather8(Ks + m0 * 136 + 64 * wn + 32 * nt + r, 136); acc[nt] = MFMA32(bb, a, acc[nt]); } }
            bf16_t* dst = STATE + ((size_t)((b * 64 + c) * 4 + hh) * 256 + vt * 128 + 32 * wm + r) * 256 + kt * 128 + 64 * wn + 4 * h5;
#pragma unroll
            for (int nt = 0; nt < 2; ++nt)
#pragma unroll
                for (int iq = 0; iq < 4; ++iq) { u32x2 w; w.x = pk2(acc[nt][4 * iq], acc[nt][4 * iq + 1]); w.y = pk2(acc[nt][4 * iq + 2], acc[nt][4 * iq + 3]); *(u32x2*)(dst + 32 * nt + 8 * iq) = w; }
            __syncthreads();
        }
#undef RA_LOAD
    }
    SEAM(2);
    if (IN(3)) {
        for (int e = gtid; e < 131072; e += NGT) { const int bh = e >> 14, idx4 = e & 16383, b = bh >> 2, hh = bh & 3;
            const float cd = __builtin_amdgcn_exp2f(128.f * lg_gamma(hh)); float s0 = 0.f, s1 = 0.f, s2 = 0.f, s3 = 0.f;
            u32x2* p = (u32x2*)(STATE + ((size_t)(b * 64) * 4 + hh) * 65536 + (size_t)idx4 * 4);
#pragma unroll 8
            for (int c = 0; c < 64; ++c) { u32x2* q = p + (size_t)c * (4 * 65536 / 4); const u32x2 w = *q;
                u32x2 o; o.x = pk2(s0, s1); o.y = pk2(s2, s3); *q = o;
                s0 = s0 * cd + bflo(w.x); s1 = s1 * cd + bfhi(w.x); s2 = s2 * cd + bflo(w.y); s3 = s3 * cd + bfhi(w.y); } }
        for (int e = gtid; e < 8192; e += NGT) { const int b = e >> 12, gp = e & 4095; const float ar = A128[gp * 2], ai = A128[gp * 2 + 1]; float cr = 0.f, ci = 0.f;
            for (int c = 0; c < 64; ++c) { float* q = CHS + ((size_t)(b * 64 + c) * 4096 + gp) * 2; const float lr_ = q[0], li_ = q[1]; q[0] = cr; q[1] = ci;
                const float t = ar * cr - ai * ci + lr_; ci = ar * ci + ai * cr + li_; cr = t; } }
    }
    SEAM(3);
    if (IN(4)) {
        for (int it = gw; it < 2 * 64 * 64; it += NGW) { const int g = it & 63, c = (it >> 6) & 63, b = it >> 12;
            s5_item<true>(b, c, g, U, CHS, APOW, BBT, CCT, args.in[10], lds + wid * 8704, lane); }
        __syncthreads();
        LAS bf16_t* Qs = (LAS bf16_t*)lds; LAS bf16_t* Ks = (LAS bf16_t*)(lds + 67584); LAS bf16_t* Ps = (LAS bf16_t*)(lds + 67584); LAS bf16_t* Xs = (LAS bf16_t*)(lds + 67584 + 34816);
        LAS float* red = (LAS float*)lds;
        const int wm = wid >> 1, wn = wid & 1, h5_ = lane >> 5, r_ = lane & 31;
        const float* gain = args.in[13];
#define OPQ() asm volatile("" : "+v"(h5), "+v"(r))
        for (int it = bid; it < 512; it += G) {
            const int hh = it & 3, c = (it >> 2) & 63, b = it >> 8;
            const size_t row0 = (size_t)b * SEQ + (size_t)c * 128; const float lg = lg_gamma(hh);
            int h5 = h5_, r = r_; OPQ();
#pragma unroll 4
            for (int i = 0; i < 8; ++i) { const int idx = tid + NTHR * i, row = idx >> 5, ch = idx & 31;
                *(LAS u32x4*)(Qs + row * 264 + ch * 8) = *(const u32x4*)(CAT + (row0 + row) * 2048 + 1024 + hh * 256 + ch * 8);
                *(LAS u32x4*)(Ks + row * 264 + ch * 8) = *(const u32x4*)(Kb + (row0 + row) * 1024 + hh * 256 + ch * 8); }
            __syncthreads();
            u32x4 pvv[4], pc[4];
#define RC_LOADV(VH) do { _Pragma("unroll") for (int i = 0; i < 4; ++i) { const int idx = tid + NTHR * i, row = idx >> 4, ch = idx & 15; pvv[i] = *(const u32x4*)(Vb + (row0 + row) * 1024 + hh * 256 + (VH) * 128 + ch * 8); } } while (0)
#define RC_STOREV() do { _Pragma("unroll") for (int i = 0; i < 4; ++i) { const int idx = tid + NTHR * i, row = idx >> 4, ch = idx & 15; *(LAS u32x4*)(Xs + row * 136 + ch * 8) = pvv[i]; } } while (0)
#define RC_LOADC(STP, KC) do { _Pragma("unroll") for (int i = 0; i < 4; ++i) { const int idx = tid + NTHR * i, row = idx >> 4, ch = idx & 15; pc[i] = *(const u32x4*)((STP) + (size_t)row * 256 + (KC) * 128 + ch * 8); } } while (0)
#define RC_STOREC() do { _Pragma("unroll") for (int i = 0; i < 4; ++i) { const int idx = tid + NTHR * i, row = idx >> 4, ch = idx & 15; *(LAS u32x4*)(Xs + row * 136 + ch * 8) = pc[i]; } } while (0)
            RC_LOADV(0);
            f32x16 sacc[2] = {ZERO16, ZERO16};
#pragma unroll 4
            for (int ks = 0; ks < 16; ++ks) { const int k0 = 16 * ks + 8 * h5;
                const bf16x8 a = *(const LAS bf16x8*)(Qs + (32 * wm + r) * 264 + k0);
#pragma unroll
                for (int nt = 0; nt < 2; ++nt) { const bf16x8 bb = *(const LAS bf16x8*)(Ks + (64 * wn + 32 * nt + r) * 264 + k0); sacc[nt] = MFMA32(bb, a, sacc[nt]); } }
            __syncthreads();
            OPQ();
            { const int n = 32 * wm + r;
#pragma unroll
              for (int nt = 0; nt < 2; ++nt)
#pragma unroll
                for (int iq = 0; iq < 4; ++iq) { const int m0 = 64 * wn + 32 * nt + 8 * iq + 4 * h5; float pvl[4];
#pragma unroll
                    for (int j = 0; j < 4; ++j) { const int mc = m0 + j; pvl[j] = (n >= mc) ? sacc[nt][4 * iq + j] * __builtin_amdgcn_exp2f(-(float)(mc + 1) * lg) : 0.f; }
                    u32x2 w; w.x = pk2(pvl[0], pvl[1]); w.y = pk2(pvl[2], pvl[3]); *(LAS u32x2*)(Ps + n * 136 + m0) = w; } }
            RC_STOREV();
            __syncthreads();
            f32x16 oacc[2][2] = {{ZERO16, ZERO16}, {ZERO16, ZERO16}};
#pragma unroll
            for (int vh = 0; vh < 2; ++vh) {
                OPQ();
                const bf16_t* st = STATE + ((size_t)((b * 64 + c) * 4 + hh) * 256 + vh * 128) * 256;
                RC_LOADC(st, 0);
#pragma unroll 2
                for (int ks = 0; ks < 8; ++ks) { const int m0 = 16 * ks + 8 * h5;
                    const bf16x8 a = *(const LAS bf16x8*)(Ps + (32 * wm + r) * 136 + m0);
#pragma unroll
                    for (int nt = 0; nt < 2; ++nt) { const bf16x8 bb = gather8(Xs + m0 * 136 + 64 * wn + 32 * nt + r, 136); oacc[vh][nt] = MFMA32(bb, a, oacc[vh][nt]); } }
#pragma unroll 1
                for (int kc = 0; kc < 2; ++kc) {
                    __syncthreads();
                    RC_STOREC();
                    __syncthreads();
                    if (kc < 1) RC_LOADC(st, kc + 1); else if (vh == 0) RC_LOADV(1);
#pragma unroll 4
                    for (int ks = 0; ks < 8; ++ks) { const int k0 = 16 * ks + 8 * h5;
                        const bf16x8 a = *(const LAS bf16x8*)(Qs + (32 * wm + r) * 264 + kc * 128 + k0);
#pragma unroll
                        for (int nt = 0; nt < 2; ++nt) { const bf16x8 bb = *(const LAS bf16x8*)(Xs + (64 * wn + 32 * nt + r) * 136 + k0); oacc[vh][nt] = MFMA32(bb, a, oacc[vh][nt]); } }
                }
                __syncthreads();
                if (vh == 0) { RC_STOREV(); __syncthreads(); }
            }
            OPQ();
            const int n = 32 * wm + r; const float xi = __builtin_amdgcn_exp2f((float)(n + 1) * lg);
            float s = 0.f, q = 0.f;
#pragma unroll
            for (int vh = 0; vh < 2; ++vh)
#pragma unroll
                for (int nt = 0; nt < 2; ++nt)
#pragma unroll
                    for (int i = 0; i < 16; ++i) { const float o = oacc[vh][nt][i] * xi; oacc[vh][nt][i] = o; s += o; q += o * o; }
            s += __shfl_xor(s, 32); q += __shfl_xor(q, 32);
            if (h5 == 0) { red[(wn * 128 + n) * 2] = s; red[(wn * 128 + n) * 2 + 1] = q; }
            __syncthreads();
            OPQ();
            { const float st_ = red[n * 2] + red[(128 + n) * 2], qt = red[n * 2 + 1] + red[(128 + n) * 2 + 1];
              const float mu = st_ * (1.f / 256.f), var = fmaxf(qt * (1.f / 256.f) - mu * mu, 0.f), rstd = __builtin_amdgcn_rsqf(var + EPS);
#pragma unroll
              for (int vh = 0; vh < 2; ++vh)
#pragma unroll
                for (int nt = 0; nt < 2; ++nt)
#pragma unroll
                    for (int iq = 0; iq < 4; ++iq) { const int col = hh * 256 + vh * 128 + 64 * wn + 32 * nt + 8 * iq + 4 * h5;
                        const f32x4 gv = *(const f32x4*)(gain + col); const u32x2 zz = *(const u32x2*)(SZB + (row0 + n) * 1024 + col);
                        const float y0 = (oacc[vh][nt][4 * iq] - mu) * rstd * gv.x * bflo(zz.x), y1 = (oacc[vh][nt][4 * iq + 1] - mu) * rstd * gv.y * bfhi(zz.x);
                        const float y2 = (oacc[vh][nt][4 * iq + 2] - mu) * rstd * gv.z * bflo(zz.y), y3 = (oacc[vh][nt][4 * iq + 3] - mu) * rstd * gv.w * bfhi(zz.y);
                        u32x2 w; w.x = pk2(y0, y1); w.y = pk2(y2, y3); *(u32x2*)(CAT + (row0 + n) * 2048 + 1024 + col) = w; } }
            __syncthreads();
        }
#undef RC_LOADV
#undef RC_STOREV
#undef RC_LOADC
#undef RC_STOREC
    }
    SEAM(4);
    if (IN(5)) {
        pg8::Gemm g{U, WGLU, M, 1024, 1024}; pg8::StaticOrder S; S.init(M, 1024, G, bid);
        EpiGlu E{args.in[12], U, CAT};
        pg8::gemm_phase<EpiGlu, pg8::StaticOrder, true, true>(lds, g, S, E);
    }
    SEAM(5);
    if (IN(6)) {
        pg8::Gemm g{CAT, WOUTE, M, 1024, 2048}; pg8::StaticOrder S; S.init(M, 1024, G, bid);
        EpiOut E{x, X1, U, args.in[15], RSS1};
        pg8::gemm_phase<EpiOut, pg8::StaticOrder, true, true>(lds, g, S, E);
    }
    SEAM(6);
    if (IN(7)) {
        pg8::Gemm g{U, WINO, M, 2048, 1024}; pg8::StaticOrder S; S.init(M, 2048, G, bid);
        Epi7 E{RSS1, VB, VSUM, VSQ};
        pg8::gemm_phase<Epi7, pg8::StaticOrder, true, true>(lds, g, S, E);
    }
    SEAM(7);
    if (IN(8)) {
        LAS bf16_t* Wsm = (LAS bf16_t*)lds; LAS bf16_t* Vs = (LAS bf16_t*)(lds + 34816);
        const int wm = wid >> 1, wn = wid & 1, h5_ = lane >> 5, r_ = lane & 31;
        const float* vgain = args.in[17]; const float* wsp = args.in[18]; const float* bsp = args.in[19];
        u32x4 pvv[4]; f32x4 pw[4][2], pg[2]; float psum[4], psq[4];
#define SG_LOAD(IT) do { const int ds_ = (IT) & 3, gg_ = ((IT) >> 2) & 3, c_ = ((IT) >> 4) & 63, b_ = (IT) >> 10; const size_t rw0 = (size_t)b_ * SEQ + (size_t)c_ * 128; const int cl0 = gg_ * 512 + ds_ * 128; \
            pg[0] = *(const f32x4*)(vgain + cl0 + (tid & 15) * 8); pg[1] = *(const f32x4*)(vgain + cl0 + (tid & 15) * 8 + 4); \
            _Pragma("unroll") for (int i = 0; i < 4; ++i) { const int idx = tid + NTHR * i, row = idx >> 4, ch = idx & 15; \
                const float* wp = wsp + ((size_t)gg_ * 128 + row) * 128 + ch * 8; pw[i][0] = *(const f32x4*)wp; pw[i][1] = *(const f32x4*)(wp + 4); \
                pvv[i] = *(const u32x4*)(VB + (rw0 + row) * 2048 + cl0 + ch * 8); psum[i] = VSUM[rw0 + row]; psq[i] = VSQ[rw0 + row]; } } while (0)
        if (bid < 2048) SG_LOAD(bid);
        for (int it = bid; it < 2048; it += G) {
            const int ds = it & 3, gg = (it >> 2) & 3, c = (it >> 4) & 63, b = it >> 10;
            const size_t row0 = (size_t)b * SEQ + (size_t)c * 128; const int col0 = gg * 512 + ds * 128;
            int h5 = h5_, r = r_; asm volatile("" : "+v"(h5), "+v"(r));
#pragma unroll
            for (int i = 0; i < 4; ++i) { const int idx = tid + NTHR * i, row = idx >> 4, ch = idx & 15;
                float w[8] = {pw[i][0].x, pw[i][0].y, pw[i][0].z, pw[i][0].w, pw[i][1].x, pw[i][1].y, pw[i][1].z, pw[i][1].w};
#pragma unroll
                for (int j = 0; j < 8; ++j) w[j] = (ch * 8 + j <= row) ? w[j] : 0.f;
                u32x4 o; o.x = pk2(w[0], w[1]); o.y = pk2(w[2], w[3]); o.z = pk2(w[4], w[5]); o.w = pk2(w[6], w[7]);
                *(LAS u32x4*)(Wsm + row * 136 + ch * 8) = o;
                const float mu = psum[i] * (1.f / 2048.f), var = fmaxf(psq[i] * (1.f / 2048.f) - mu * mu, 0.f), rstd = __builtin_amdgcn_rsqf(var + EPS);
                const u32x4 vv = pvv[i]; u32x4 o2;
                o2.x = pk2((bflo(vv.x) - mu) * rstd * pg[0].x, (bfhi(vv.x) - mu) * rstd * pg[0].y); o2.y = pk2((bflo(vv.y) - mu) * rstd * pg[0].z, (bfhi(vv.y) - mu) * rstd * pg[0].w);
                o2.z = pk2((bflo(vv.z) - mu) * rstd * pg[1].x, (bfhi(vv.z) - mu) * rstd * pg[1].y); o2.w = pk2((bflo(vv.w) - mu) * rstd * pg[1].z, (bfhi(vv.w) - mu) * rstd * pg[1].w);
                *(LAS u32x4*)(Vs + row * 136 + ch * 8) = o2; }
            __syncthreads();
            if (it + G < 2048) SG_LOAD(it + G);
            f32x16 acc[2] = {ZERO16, ZERO16};
            const int nks = 2 * wm + 2;
#pragma unroll 2
            for (int ks = 0; ks < nks; ++ks) { const int m0 = 16 * ks + 8 * h5;
                const bf16x8 a = *(const LAS bf16x8*)(Wsm + (32 * wm + r) * 136 + m0);
#pragma unroll
                for (int nt = 0; nt < 2; ++nt) { const bf16x8 bb = gather8(Vs + m0 * 136 + 64 * wn + 32 * nt + r, 136); acc[nt] = MFMA32(bb, a, acc[nt]); } }
            const int t = 32 * wm + r; const float bias = bsp[gg * 128 + t];
            bf16_t* dst = VB + (row0 + t) * 2048 + col0 + 64 * wn + 4 * h5;
#pragma unroll
            for (int nt = 0; nt < 2; ++nt)
#pragma unroll
                for (int iq = 0; iq < 4; ++iq) { u32x2 w; w.x = pk2(acc[nt][4 * iq] + bias, acc[nt][4 * iq + 1] + bias); w.y = pk2(acc[nt][4 * iq + 2] + bias, acc[nt][4 * iq + 3] + bias); *(u32x2*)(dst + 32 * nt + 8 * iq) = w; }
            __syncthreads();
        }
#undef SG_LOAD
    }
    SEAM(8);
    if (IN(9)) {
        pg8::Gemm g{U, WINO + (size_t)2048 * 1024, M, 4096, 1024}; pg8::StaticOrder S; S.init(M, 4096, G, bid);
        Epi9 E{RSS1, VB, CAT};
        pg8::gemm_phase<Epi9, pg8::StaticOrder, true, true>(lds, g, S, E);
    }
    SEAM(9);
    if (IN(10)) {
        pg8::Gemm g{CAT, WOUTO, M, 1024, 2048}; pg8::StaticOrder S; S.init(M, 1024, G, bid);
        EpiOut E{X1, X1, nullptr, nullptr, RSS2};
        pg8::gemm_phase<EpiOut, pg8::StaticOrder, true, true>(lds, g, S, E);
    }
    SEAM(10);
    if (IN(11)) {
        const f32x4* gr = (const f32x4*)args.in[21] + lane; f32x4 gg[4];
#pragma unroll
        for (int j = 0; j < 4; ++j) gg[j] = gr[64 * j];
        for (int m = gw; m < M; m += 4 * NGW) {
            f32x4 v[4][4]; float rs[4];
#pragma unroll
            for (int k = 0; k < 4; ++k) { const int mm = m + k * NGW; if (mm < M) { const f32x4* xr = (const f32x4*)(X1 + (size_t)mm * D) + lane; rs[k] = RSS2[mm];
#pragma unroll
                for (int j = 0; j < 4; ++j) v[k][j] = __builtin_nontemporal_load(xr + 64 * j); } }
#pragma unroll
            for (int k = 0; k < 4; ++k) { const int mm = m + k * NGW; if (mm < M) { f32x4* o = (f32x4*)(args.out + (size_t)mm * D) + lane; const float r = __builtin_amdgcn_rsqf(rs[k] * (1.f / 1024.f) + EPS);
#pragma unroll
                for (int j = 0; j < 4; ++j) { const f32x4 x_ = v[k][j]; __builtin_nontemporal_store((f32x4){x_.x * r * gg[j].x, x_.y * r * gg[j].y, x_.z * r * gg[j].z, x_.w * r * gg[j].w}, o + 64 * j); } } }
        }
    }
#undef IN
#undef SEAM
}

extern "C" void kernel_launch(void* const* d_in, const int* in_sizes, int n_in, void* d_out, int out_size, void* d_ws, size_t ws_size, hipStream_t stream) {
    static int grid = 0;
    if (grid == 0) {
        if (n_in != 22 || out_size != M * D || ws_size < WS_END) { fprintf(stderr, "kernel_launch: unexpected shapes (n_in %d out %d ws %zu)\n", n_in, out_size, ws_size); grid = -1; return; }
        int dev = 0, cus = 0, per_cu = 0;
        hipGetDevice(&dev); hipDeviceGetAttribute(&cus, hipDeviceAttributeMultiprocessorCount, dev);
        if (hipFuncSetAttribute((const void*)mk_fwd, hipFuncAttributeMaxDynamicSharedMemorySize, LDS_BYTES) != hipSuccess) { fprintf(stderr, "kernel_launch: hipFuncSetAttribute failed\n"); grid = -1; return; }
        if (hipOccupancyMaxActiveBlocksPerMultiprocessor(&per_cu, (const void*)mk_fwd, NTHR, LDS_BYTES) != hipSuccess || per_cu < 1) { fprintf(stderr, "kernel_launch: occupancy query says %d\n", per_cu); grid = -1; return; }
        grid = cus * (per_cu > 1 ? 1 : per_cu);
    }
    if (grid < 0) return;
    if (hipMemsetAsync((char*)d_ws + WS_BAR, 0, BAR_BYTES, stream) != hipSuccess) { fprintf(stderr, "kernel_launch: memset failed\n"); return; }
    Args a{};
    for (int i = 0; i < 22; ++i) a.in[i] = (const float*)d_in[i];
    a.out = (float*)d_out; a.ws = (unsigned char*)d_ws;
#if MK_PER_PHASE
#ifdef PROBE_PREFIX
    for (int p = 0; p <= PROBE_PREFIX; ++p) { a.ph_lo = p; a.ph_hi = p + 1; hipLaunchKernelGGL(mk_fwd, dim3(grid), dim3(NTHR), LDS_BYTES, stream, a); }
#endif
    for (int p = 0; p < NPH; ++p) { a.ph_lo = p; a.ph_hi = p + 1; hipLaunchKernelGGL(mk_fwd, dim3(grid), dim3(NTHR), LDS_BYTES, stream, a); }
#else
    a.ph_lo = 0; a.ph_hi = NPH;
    void* kargs[] = {&a};
    hipError_t e = hipLaunchCooperativeKernel((const void*)mk_fwd, dim3(grid), dim3(NTHR), kargs, LDS_BYTES, stream);
    if (e != hipSuccess) fprintf(stderr, "kernel_launch: cooperative launch failed: %s (grid %d)\n", hipGetErrorString(e), grid);
#endif
}
```

```cpp
#include <hip/hip_runtime.h>
#include <hip/hip_cooperative_groups.h>
#include <cstdio>
#include <cstdint>
namespace cg = cooperative_groups;
namespace pg8 {
#define PG8_LAS __attribute__((address_space(3)))
typedef unsigned short bf16_t;
typedef short bf16x8 __attribute__((ext_vector_type(8)));
typedef float f32x4 __attribute__((ext_vector_type(4)));
typedef unsigned u32x4 __attribute__((ext_vector_type(4)));
constexpr int BM = 256, BK = 64, HALF = 128, HTB = HALF * BK * 2  , STAGE_BYTES = 8 * HTB, NXCD = 8, WGM = 8;

__host__ __device__ __forceinline__ int lds_byte(int r, int c) { const int st = (r >> 4) * 2 + (c >> 5), rr = r & 15, cc = c & 31, ob = rr * 64 + cc * 2; return st * 1024 + (ob ^ (((ob >> 9) & 1) << 5)); }
__host__ __device__ __forceinline__ void stage_rc(int b, int& R, int& C) { const int st = b / 1024, sb = b % 1024, swz = sb ^ (((sb >> 9) & 1) << 5); R = (st >> 1) * 16 + swz / 64; C = (st & 1) * 32 + (swz % 64) / 2; }
__host__ __device__ __forceinline__ int perm32(int rho) { const int n = rho >> 4, i = rho & 15; return 8 * (i >> 2) + 4 * n + (i & 3); }

struct Unit { int pm, pn; };
struct Gemm { const bf16_t* A; const bf16_t* Bt; int M, N, K; };

struct StaticOrder {
    int nM, nN, nwg, G, c;
    __host__ __device__ void init(int M, int N, int G_, int c_) { nM = M / BM; nN = N / BM; nwg = nM * nN; G = G_; c = c_; }
    __host__ __device__ bool next(int i, Unit& u) const {
        const long L = (long)i * G + c; if (L >= nwg) return false;
        int wgid = (int)L; { const int q = nwg / NXCD, r = nwg % NXCD, xcd = wgid % NXCD, off = wgid / NXCD; wgid = (xcd < r ? xcd * (q + 1) : r * (q + 1) + (xcd - r) * q) + off; }
        const int nig = WGM * nN, gid = wgid / nig, fm = gid * WGM, gsz = (nM - fm) < WGM ? (nM - fm) : WGM;
        u.pm = fm + ((wgid % nig) % gsz); u.pn = (wgid % nig) / gsz; return true;
    }
    __device__ __forceinline__ void a_ready(const Unit&) const {}
    __device__ __forceinline__ void done(const Unit&) const {}
};

__device__ __forceinline__ unsigned cvt_pk_bf16(float lo, float hi) { unsigned r; asm volatile("v_cvt_pk_bf16_f32 %0, %1, %2" : "=v"(r) : "v"(lo), "v"(hi)); return r; }
template <class Epi, class Sched, bool ALIGN_EPI = false, bool SP2 = false>
__device__ __forceinline__ void gemm_phase(PG8_LAS unsigned char* lds, const Gemm g, const Sched& S, const Epi& E) {
    const int tid = threadIdx.x, wid = __builtin_amdgcn_readfirstlane(tid >> 6), lane = tid & 63, wr = wid >> 2, wc = wid & 3, fr = lane & 15, fq = lane >> 4;
    const int K = g.K, nt = K / BK;
    unsigned voffA[2], voffB[2];
#pragma unroll
    for (int i = 0; i < 2; ++i) { int R, C; stage_rc(tid * 16 + i * 8192, R, C); const int Rb = Epi::PERM ? ((R & ~31) + perm32(R & 31)) : R;
        voffA[i] = (unsigned)(R * K + C) * 2u; voffB[i] = (unsigned)(Rb * K + C) * 2u; }
    const size_t kstep = (size_t)(BK * 2);
    const size_t hstep = (size_t)HALF * K * 2;
    const size_t tstep = 2 * hstep;
    const unsigned ldsw = (unsigned)wid * 1024u;
    const int aoff = lds_byte(wr * 64 + fr, fq * 8), boff = lds_byte(wc * 32 + fr, fq * 8);
#define PG8_SA(b, h) (((b) * 2 + (h)) * HTB)
#define PG8_SB(b, h) ((4 + (b) * 2 + (h)) * HTB)
#define PG8_STAGE(bufoff, gbase, voff) do { _Pragma("unroll") for (int _i = 0; _i < 2; ++_i) \
        __builtin_amdgcn_global_load_lds((const unsigned*)((const char*)(gbase) + (voff)[_i]), (PG8_LAS unsigned*)(lds + (bufoff) + ldsw + _i * 8192), 16, 0, 0); } while (0)
#define PG8_LDA(dst, b, h) do { _Pragma("unroll") for (int m = 0; m < 4; ++m) _Pragma("unroll") for (int k = 0; k < 2; ++k) dst[m][k] = *(const PG8_LAS bf16x8*)(lds + PG8_SA(b, h) + aoff + m * 2048 + k * 1024); } while (0)
#define PG8_LDB(dst, b, h) do { _Pragma("unroll") for (int n = 0; n < 2; ++n) _Pragma("unroll") for (int k = 0; k < 2; ++k) dst[n][k] = *(const PG8_LAS bf16x8*)(lds + PG8_SB(b, h) + boff + n * 2048 + k * 1024); } while (0)
#define PG8_MMA(ai, bj, At, Bt) do { __builtin_amdgcn_s_setprio(1); _Pragma("unroll") for (int m = 0; m < 4; ++m) _Pragma("unroll") for (int n = 0; n < 2; ++n) _Pragma("unroll") for (int k = 0; k < 2; ++k) \
        acc[ai][bj][m][n] = __builtin_amdgcn_mfma_f32_16x16x32_bf16(Bt[n][k], At[m][k], acc[ai][bj][m][n], 0, 0, 0); __builtin_amdgcn_s_setprio(0); } while (0)
#define PG8_WAIT_V(n) asm volatile("s_waitcnt vmcnt(" #n ")" ::: "memory")
#define PG8_WAIT_L(n) asm volatile("s_waitcnt lgkmcnt(" #n ")" ::: "memory")
#define PG8_BAR __builtin_amdgcn_s_barrier()
#define PG8_SCHED __builtin_amdgcn_sched_barrier(0)
    Unit cur, nxt; int ui = 0;
    if (!S.next(0, cur)) return;
    f32x4 acc[2][2][4][2];
#pragma unroll
    for (int a = 0; a < 2; ++a)
#pragma unroll
        for (int b = 0; b < 2; ++b)
#pragma unroll
            for (int m = 0; m < 4; ++m)
#pragma unroll
                for (int n = 0; n < 2; ++n) acc[a][b][m][n] = (f32x4){0.f, 0.f, 0.f, 0.f};
    bf16x8 At[4][2], B0[2][2], B1[2][2];
    const char* cA = (const char*)g.A + (size_t)cur.pm * tstep; const char* cB = (const char*)g.Bt + (size_t)cur.pn * tstep;
    S.a_ready(cur);
    if constexpr (SP2) {
        PG8_STAGE(PG8_SB(0, 0), cB, voffB); PG8_STAGE(PG8_SB(0, 1), cB + hstep, voffB); PG8_STAGE(PG8_SA(0, 0), cA, voffA); PG8_STAGE(PG8_SA(0, 1), cA + hstep, voffA);
        if (wr == 1) PG8_BAR;
        PG8_WAIT_V(2); PG8_BAR;
        PG8_STAGE(PG8_SB(1, 0), cB + kstep, voffB); PG8_STAGE(PG8_SA(1, 0), cA + kstep, voffA); PG8_STAGE(PG8_SB(1, 1), cB + hstep + kstep, voffB);
        PG8_WAIT_V(6); PG8_BAR;
    } else {
        PG8_STAGE(PG8_SB(0, 0), cB, voffB); PG8_STAGE(PG8_SA(0, 0), cA, voffA); PG8_STAGE(PG8_SB(0, 1), cB + hstep, voffB); PG8_STAGE(PG8_SA(0, 1), cA + hstep, voffA);
        if (wr == 1) PG8_BAR;
        PG8_WAIT_V(4); PG8_BAR;
        PG8_STAGE(PG8_SB(1, 0), cB + kstep, voffB); PG8_STAGE(PG8_SA(1, 0), cA + kstep, voffA); PG8_STAGE(PG8_SB(1, 1), cB + hstep + kstep, voffB);
        PG8_WAIT_V(6); PG8_BAR;
    }
    for (;;) {
        const bool has_next = S.next(ui + 1, nxt);
        const char* nA = has_next ? (const char*)g.A + (size_t)nxt.pm * tstep : cA; const char* nB = has_next ? (const char*)g.Bt + (size_t)nxt.pn * tstep : cB;
        for (int t = 0; t < nt; t += 2) {
            const bool last = (t == nt - 2);
            const char* a1 = cA + (size_t)(t + 1) * kstep;
            const char* a2 = last ? nA : cA + (size_t)(t + 2) * kstep; const char* b2 = last ? nB : cB + (size_t)(t + 2) * kstep;
            const char* a3 = a2 + kstep; const char* b3 = b2 + kstep;
            if (last && has_next) S.a_ready(nxt);
            if constexpr (SP2) {
            PG8_LDB(B0, 0, 0); PG8_LDB(B1, 0, 1); PG8_SCHED; PG8_LDA(At, 0, 0); PG8_STAGE(PG8_SA(1, 1), a1 + hstep, voffA);
            PG8_WAIT_V(8); PG8_WAIT_L(0); PG8_BAR; PG8_MMA(0, 0, At, B0); PG8_MMA(0, 1, At, B1); PG8_BAR; PG8_SCHED;
            PG8_LDA(At, 0, 1); PG8_STAGE(PG8_SB(0, 0), b2, voffB); PG8_STAGE(PG8_SB(0, 1), b2 + hstep, voffB); PG8_STAGE(PG8_SA(0, 0), a2, voffA);
            PG8_WAIT_V(8); PG8_WAIT_L(0); PG8_BAR; PG8_MMA(1, 0, At, B0); PG8_MMA(1, 1, At, B1); PG8_BAR; PG8_SCHED;
            PG8_LDB(B0, 1, 0); PG8_LDB(B1, 1, 1); PG8_SCHED; PG8_LDA(At, 1, 0); PG8_STAGE(PG8_SA(0, 1), a2 + hstep, voffA);
            PG8_WAIT_V(8); PG8_WAIT_L(0); PG8_BAR; PG8_MMA(0, 0, At, B0); PG8_MMA(0, 1, At, B1); PG8_BAR; PG8_SCHED;
            PG8_LDA(At, 1, 1); PG8_STAGE(PG8_SB(1, 0), b3, voffB); PG8_STAGE(PG8_SB(1, 1), b3 + hstep, voffB); PG8_STAGE(PG8_SA(1, 0), a3, voffA);
            PG8_WAIT_V(8); PG8_WAIT_L(0); PG8_BAR; PG8_MMA(1, 0, At, B0); PG8_MMA(1, 1, At, B1); PG8_BAR; PG8_SCHED;
            } else {
            PG8_LDB(B0, 0, 0); PG8_SCHED; PG8_LDA(At, 0, 0); PG8_STAGE(PG8_SA(1, 1), a1 + hstep, voffA);
            PG8_WAIT_L(8); PG8_BAR; PG8_WAIT_L(0); PG8_MMA(0, 0, At, B0); PG8_BAR; PG8_SCHED;
            PG8_LDB(B1, 0, 1); PG8_STAGE(PG8_SB(0, 0), b2, voffB);
            PG8_BAR; PG8_WAIT_L(0); PG8_MMA(0, 1, At, B1); PG8_BAR;
            PG8_LDA(At, 0, 1); PG8_STAGE(PG8_SA(0, 0), a2, voffA);
            PG8_BAR; PG8_WAIT_L(0); PG8_MMA(1, 0, At, B0); PG8_BAR; PG8_SCHED;
            PG8_STAGE(PG8_SB(0, 1), b2 + hstep, voffB);
            PG8_WAIT_V(6); PG8_BAR; PG8_MMA(1, 1, At, B1); PG8_BAR;
            PG8_LDB(B0, 1, 0); PG8_SCHED; PG8_LDA(At, 1, 0); PG8_STAGE(PG8_SA(0, 1), a2 + hstep, voffA);
            PG8_WAIT_L(8); PG8_BAR; PG8_WAIT_L(0); PG8_MMA(0, 0, At, B0); PG8_BAR; PG8_SCHED;
            PG8_LDB(B1, 1, 1); PG8_STAGE(PG8_SB(1, 0), b3, voffB);
            PG8_BAR; PG8_WAIT_L(0); PG8_MMA(0, 1, At, B1); PG8_BAR;
            PG8_LDA(At, 1, 1); PG8_STAGE(PG8_SA(1, 0), a3, voffA);
            PG8_BAR; PG8_WAIT_L(0); PG8_MMA(1, 0, At, B0); PG8_BAR; PG8_SCHED;
            PG8_STAGE(PG8_SB(1, 1), b3 + hstep, voffB);
            PG8_WAIT_V(6); PG8_BAR; PG8_MMA(1, 1, At, B1); PG8_BAR;
            }
        }
        if constexpr (ALIGN_EPI) { if (wr == 0) PG8_BAR; }
        if constexpr (!Epi::AFTER_DRAIN) { E(acc, cur, wr, wc, fr, fq); S.done(cur); }
        if (!has_next) break;
#pragma unroll
        for (int a = 0; a < 2; ++a)
#pragma unroll
            for (int b = 0; b < 2; ++b)
#pragma unroll
                for (int m = 0; m < 4; ++m)
#pragma unroll
                    for (int n = 0; n < 2; ++n) acc[a][b][m][n] = (f32x4){0.f, 0.f, 0.f, 0.f};
        cur = nxt; cA = nA; cB = nB; ++ui;
        if constexpr (ALIGN_EPI) { if (wr == 1) PG8_BAR; }
    }
    PG8_WAIT_V(0);
    if constexpr (!ALIGN_EPI) { if (wr == 0) PG8_BAR; }
    PG8_BAR;
    if constexpr (Epi::AFTER_DRAIN) { E.fused(acc, cur, wr, wc, fr, fq, lds, wid, lane); S.done(cur); }
#undef PG8_SA
#undef PG8_SB
#undef PG8_STAGE
#undef PG8_LDA
#undef PG8_LDB
#undef PG8_MMA
#undef PG8_WAIT_V
#undef PG8_WAIT_L
#undef PG8_BAR
#undef PG8_SCHED
}
}

#ifndef MK_PER_PHASE
#define MK_PER_PHASE 0
#endif
using pg8::bf16_t; using pg8::bf16x8; using pg8::f32x4; using pg8::u32x4;
typedef float f32x16 __attribute__((ext_vector_type(16)));
typedef unsigned u32x2 __attribute__((ext_vector_type(2)));
#define LAS __attribute__((address_space(3)))
constexpr int M = 16384, D = 1024, SEQ = 8192, NTHR = 512, NPH = 12;
constexpr float EPS = 1e-6f;
constexpr size_t MiB = 1u << 20;
constexpr size_t WS_RSS0 = 0, WS_RSS1 = 65536, WS_VSUM = 131072, WS_VSQ = 196608, WS_RSS2 = 262144;
constexpr size_t WS_BAR = 512 * 1024, BAR_BYTES = 16384;
constexpr size_t WS_APOW = 1 * MiB, WS_A128 = 1 * MiB + 131072, WS_BBT = 1 * MiB + 262144, WS_CCT = 1 * MiB + 524288;
constexpr size_t WS_COS = 2 * MiB, WS_SIN = 6 * MiB, WS_CHS = 10 * MiB;
constexpr size_t WS_WINE = 16 * MiB, WS_WGLU = 28 * MiB, WS_WOUTE = 30 * MiB, WS_WINO = 34 * MiB, WS_WOUTO = 46 * MiB;
constexpr size_t WS_U = 52 * MiB, WS_CAT = 84 * MiB, WS_K = 148 * MiB, WS_V = 180 * MiB, WS_SZB = 212 * MiB, WS_END = 244 * MiB;
constexpr size_t WS_X1 = WS_K;
constexpr int LDS_BYTES = 143360;

struct Args { const float* in[22]; float* out; unsigned char* ws; int ph_lo, ph_hi; };

__device__ __forceinline__ unsigned f2bf(float f) { unsigned u = __builtin_bit_cast(unsigned, f); return (u + 0x7fffu + ((u >> 16) & 1u)) >> 16; }
__device__ __forceinline__ unsigned pk2(float lo, float hi) { return pg8::cvt_pk_bf16(lo, hi); }
__device__ __forceinline__ float bflo(unsigned w) { return __builtin_bit_cast(float, w << 16); }
__device__ __forceinline__ float bfhi(unsigned w) { return __builtin_bit_cast(float, w & 0xffff0000u); }
__device__ __forceinline__ float bf2f(bf16_t b) { return __builtin_bit_cast(float, (unsigned)b << 16); }
__device__ __forceinline__ float fast_rcp(float x) { return __builtin_amdgcn_rcpf(x); }
__device__ __forceinline__ float sigmoidf_(float t) { return fast_rcp(1.f + __builtin_amdgcn_exp2f(-1.4426950408889634f * t)); }
__device__ __forceinline__ float siluf_(float t) { return t * sigmoidf_(t); }
__device__ __forceinline__ float geluf_(float x) { const float u = 0.7978845608028654f * (x + 0.044715f * x * x * x); return x * sigmoidf_(2.f * u); }
__device__ __forceinline__ float wave_sum(float v) {
#pragma unroll
    for (int o = 1; o < 64; o <<= 1) v += __shfl_xor(v, o);
    return v;
}
__device__ __forceinline__ float lg_gamma(int h) { return h == 0 ? -0.04580368961312479f : (h == 1 ? -0.02272007650008353f : (h == 2 ? -0.011315313227834146f : -0.005646563141142063f)); }
__device__ __forceinline__ void sincos_d(double x, double& s, double& c) {
    double t = x * 0.15915494309189535; t -= __builtin_rint(t);
    const double qd = __builtin_rint(4.0 * t); const int q = (int)qd;
    const double r = (t - 0.25 * qd) * 6.283185307179586; const double r2 = r * r;
    double sp = -1.0 / 1307674368000.0; sp = sp * r2 + 1.0 / 6227020800.0; sp = sp * r2 - 1.0 / 39916800.0; sp = sp * r2 + 1.0 / 362880.0; sp = sp * r2 - 1.0 / 5040.0; sp = sp * r2 + 1.0 / 120.0; sp = sp * r2 - 1.0 / 6.0; sp = sp * r2 + 1.0;
    const double sr = sp * r;
    double cp = 1.0 / 20922789888000.0; cp = cp * r2 - 1.0 / 87178291200.0; cp = cp * r2 + 1.0 / 479001600.0; cp = cp * r2 - 1.0 / 3628800.0; cp = cp * r2 + 1.0 / 40320.0; cp = cp * r2 - 1.0 / 720.0; cp = cp * r2 + 1.0 / 24.0; cp = cp * r2 - 0.5; cp = cp * r2 + 1.0;
    const int qq = q & 3;
    if (qq == 0) { s = sr; c = cp; } else if (qq == 1) { s = cp; c = -sr; } else if (qq == 2) { s = -sr; c = -cp; } else { s = -cp; c = sr; }
}

#define EPI_ARGS const f32x4 (&acc)[2][2][4][2], const pg8::Unit& u, int wr, int wc, int fr, int fq
__device__ __forceinline__ void st8bf(bf16_t* p, const float (&v)[8]) { u32x4 w; w.x = pk2(v[0], v[1]); w.y = pk2(v[2], v[3]); w.z = pk2(v[4], v[5]); w.w = pk2(v[6], v[7]); *(u32x4*)p = w; }
__device__ __forceinline__ void ld8bf(const bf16_t* p, float (&v)[8]) { const u32x4 w = *(const u32x4*)p; v[0] = bflo(w.x); v[1] = bfhi(w.x); v[2] = bflo(w.y); v[3] = bfhi(w.y); v[4] = bflo(w.z); v[5] = bfhi(w.z); v[6] = bflo(w.w); v[7] = bfhi(w.w); }
__device__ __forceinline__ void ld8f(const float* p, float (&v)[8]) { const f32x4 a = *(const f32x4*)p, b = *(const f32x4*)(p + 4); v[0] = a.x; v[1] = a.y; v[2] = a.z; v[3] = a.w; v[4] = b.x; v[5] = b.y; v[6] = b.z; v[7] = b.w; }
__device__ __forceinline__ void st8f(float* p, const float (&v)[8]) { *(f32x4*)p = (f32x4){v[0], v[1], v[2], v[3]}; *(f32x4*)(p + 4) = (f32x4){v[4], v[5], v[6], v[7]}; }
#define ACC8(dst, ai, bj, m, sc) do { const f32x4 _a = acc[ai][bj][m][0], _b = acc[ai][bj][m][1]; dst[0] = _a.x * (sc); dst[1] = _a.y * (sc); dst[2] = _a.z * (sc); dst[3] = _a.w * (sc); dst[4] = _b.x * (sc); dst[5] = _b.y * (sc); dst[6] = _b.z * (sc); dst[7] = _b.w * (sc); } while (0)

struct Epi1 {
    static constexpr bool PERM = true, AFTER_DRAIN = false;
    const float* rss; bf16_t* U; bf16_t* CAT; bf16_t* Kb; bf16_t* Vb; bf16_t* SZB; const float* COS; const float* SIN;
    __device__ __forceinline__ void operator()(EPI_ARGS) const {
        const int seg = u.pn >> 2, cb = (u.pn & 3) * 256, colL = wc * 32 + 8 * fq;
        const int row0 = u.pm * 256 + wr * 64 + fr;
        float rsv[2][4];
#pragma unroll
        for (int ai = 0; ai < 2; ++ai)
#pragma unroll
            for (int m = 0; m < 4; ++m) rsv[ai][m] = rss[row0 + ai * 128 + m * 16];
        if (seg == 2 || seg == 3) {
#pragma unroll
            for (int aim = 0; aim < 4; ++aim) { const int ai = aim >> 1, mlo = (aim & 1) * 2;
                f32x4 cv[4][2], sv[4][2];
#pragma unroll
                for (int m = mlo; m < mlo + 2; ++m) { const int pos = (row0 + ai * 128 + m * 16) & (SEQ - 1); const float* pc = COS + (size_t)pos * 128 + colL; const float* ps = SIN + (size_t)pos * 128 + colL;
                    cv[m][0] = *(const f32x4*)pc; cv[m][1] = *(const f32x4*)(pc + 4); sv[m][0] = *(const f32x4*)ps; sv[m][1] = *(const f32x4*)(ps + 4); }
#pragma unroll
                for (int m = mlo; m < mlo + 2; ++m) {
                    const int row = row0 + ai * 128 + m * 16;
                    const float rs = __builtin_amdgcn_rsqf(rsv[ai][m] * (1.f / 1024.f) + EPS);
                    float x1[8], x2[8], o1[8], o2[8];
                    const float sc = (seg == 3) ? rs * 0.0625f : rs;
                    ACC8(x1, ai, 0, m, sc); ACC8(x2, ai, 1, m, sc);
                    const float cs[8] = {cv[m][0].x, cv[m][0].y, cv[m][0].z, cv[m][0].w, cv[m][1].x, cv[m][1].y, cv[m][1].z, cv[m][1].w};
                    const float sn[8] = {sv[m][0].x, sv[m][0].y, sv[m][0].z, sv[m][0].w, sv[m][1].x, sv[m][1].y, sv[m][1].z, sv[m][1].w};
#pragma unroll
                    for (int j = 0; j < 8; ++j) { o1[j] = x1[j] * cs[j] - x2[j] * sn[j]; o2[j] = x1[j] * sn[j] + x2[j] * cs[j]; }
                    bf16_t* dst = (seg == 2) ? CAT + (size_t)row * 2048 + 1024 + cb + colL : Kb + (size_t)row * 1024 + cb + colL;
                    st8bf(dst, o1); st8bf(dst + 128, o2);
                }
            }
        } else {
#pragma unroll
            for (int ai = 0; ai < 2; ++ai)
#pragma unroll
                for (int m = 0; m < 4; ++m) {
                    const int row = row0 + ai * 128 + m * 16;
                    const float rs = __builtin_amdgcn_rsqf(rsv[ai][m] * (1.f / 1024.f) + EPS);
#pragma unroll
                    for (int bj = 0; bj < 2; ++bj) {
                        float v[8]; ACC8(v, ai, bj, m, rs);
                        const int col = cb + bj * 128 + colL;
                        if (seg == 1 || seg == 5) {
#pragma unroll
                            for (int j = 0; j < 8; ++j) v[j] = siluf_(v[j]);
                        }
                        bf16_t* dst = (seg == 0) ? U + (size_t)row * 1024 + col : (seg == 1) ? CAT + (size_t)row * 2048 + col : (seg == 4) ? Vb + (size_t)row * 1024 + col : SZB + (size_t)row * 1024 + col;
                        st8bf(dst, v);
                    }
                }
        }
    }
};
struct EpiGlu {
    static constexpr bool PERM = true, AFTER_DRAIN = false;
    const float* bglu; const bf16_t* Y1; bf16_t* CAT;
    __device__ __forceinline__ void operator()(EPI_ARGS) const {
        const int colL = wc * 32 + 8 * fq, row0 = u.pm * 256 + wr * 64 + fr;
#pragma unroll
        for (int bj = 0; bj < 2; ++bj) {
            const int col = u.pn * 256 + bj * 128 + colL;
            float bb[8]; ld8f(bglu + col, bb);
#pragma unroll
            for (int ai = 0; ai < 2; ++ai) {
            u32x4 yy[2][4], zz[2][4];
#pragma unroll
                for (int m = 0; m < 4; ++m) { const int row = row0 + ai * 128 + m * 16; yy[ai][m] = *(const u32x4*)(Y1 + (size_t)row * 1024 + col); zz[ai][m] = *(const u32x4*)(CAT + (size_t)row * 2048 + col); }
#pragma unroll
                for (int m = 0; m < 4; ++m) {
                    const int row = row0 + ai * 128 + m * 16;
                    float t[8]; ACC8(t, ai, bj, m, 1.f);
                    const u32x4 y = yy[ai][m], z = zz[ai][m];
                    const float yf[8] = {bflo(y.x), bfhi(y.x), bflo(y.y), bfhi(y.y), bflo(y.z), bfhi(y.z), bflo(y.w), bfhi(y.w)};
                    const float zf[8] = {bflo(z.x), bfhi(z.x), bflo(z.y), bfhi(z.y), bflo(z.z), bfhi(z.z), bflo(z.w), bfhi(z.w)};
#pragma unroll
                    for (int j = 0; j < 8; ++j) t[j] = yf[j] * sigmoidf_(t[j] + bb[j]) * zf[j];
                    st8bf(CAT + (size_t)row * 2048 + col, t);
                }
            }
        }
    }
};
struct EpiOut {
    static constexpr bool PERM = true, AFTER_DRAIN = false;
    const float* Xi; float* Xo; bf16_t* XG; const float* g; float* rss;
    __device__ __forceinline__ void operator()(EPI_ARGS) const {
        const int colL = wc * 32 + 8 * fq, row0 = u.pm * 256 + wr * 64 + fr;
        float gg[2][8];
        if (XG) { ld8f(g + u.pn * 256 + colL, gg[0]); ld8f(g + u.pn * 256 + 128 + colL, gg[1]); }
#pragma unroll
        for (int aim = 0; aim < 4; ++aim) { const int ai = aim >> 1, mlo = (aim & 1) * 2;
            f32x4 xv[4][2][2];
#pragma unroll
            for (int m = mlo; m < mlo + 2; ++m)
#pragma unroll
                for (int bj = 0; bj < 2; ++bj) { const float* p = Xi + (size_t)(row0 + ai * 128 + m * 16) * 1024 + u.pn * 256 + bj * 128 + colL; xv[m][bj][0] = *(const f32x4*)p; xv[m][bj][1] = *(const f32x4*)(p + 4); }
#pragma unroll
            for (int m = mlo; m < mlo + 2; ++m) {
                const int row = row0 + ai * 128 + m * 16; float ss = 0.f;
#pragma unroll
                for (int bj = 0; bj < 2; ++bj) {
                    const int col = u.pn * 256 + bj * 128 + colL;
                    float a[8]; ACC8(a, ai, bj, m, 1.f);
                    float x[8] = {xv[m][bj][0].x, xv[m][bj][0].y, xv[m][bj][0].z, xv[m][bj][0].w, xv[m][bj][1].x, xv[m][bj][1].y, xv[m][bj][1].z, xv[m][bj][1].w};
#pragma unroll
                    for (int j = 0; j < 8; ++j) { x[j] += a[j]; ss += x[j] * x[j]; }
                    st8f(Xo + (size_t)row * 1024 + col, x);
                    if (XG) {
#pragma unroll
                        for (int j = 0; j < 8; ++j) x[j] *= gg[bj][j];
                        st8bf(XG + (size_t)row * 1024 + col, x); }
                }
                ss += __shfl_xor(ss, 16); ss += __shfl_xor(ss, 32);
                if (fq == 0) atomicAdd(rss + row, ss);
            }
        }
    }
};
struct Epi7 {
    static constexpr bool PERM = true, AFTER_DRAIN = false;
    const float* rss; bf16_t* VB; float* vsum; float* vsq;
    __device__ __forceinline__ void operator()(EPI_ARGS) const {
        const int colL = wc * 32 + 8 * fq, row0 = u.pm * 256 + wr * 64 + fr;
        float rsv[2][4];
#pragma unroll
        for (int ai = 0; ai < 2; ++ai)
#pragma unroll
            for (int m = 0; m < 4; ++m) rsv[ai][m] = rss[row0 + ai * 128 + m * 16];
#pragma unroll
        for (int ai = 0; ai < 2; ++ai)
#pragma unroll
            for (int m = 0; m < 4; ++m) {
                const int row = row0 + ai * 128 + m * 16; float s = 0.f, q = 0.f;
                const float rs = __builtin_amdgcn_rsqf(rsv[ai][m] * (1.f / 1024.f) + EPS);
#pragma unroll
                for (int bj = 0; bj < 2; ++bj) {
                    const int col = u.pn * 256 + bj * 128 + colL;
                    float v[8]; ACC8(v, ai, bj, m, rs);
#pragma unroll
                    for (int j = 0; j < 8; ++j) { v[j] = geluf_(v[j]); s += v[j]; q += v[j] * v[j]; }
                    st8bf(VB + (size_t)row * 2048 + col, v);
                }
                s += __shfl_xor(s, 16); s += __shfl_xor(s, 32); q += __shfl_xor(q, 16); q += __shfl_xor(q, 32);
                if (fq == 0) { atomicAdd(vsum + row, s); atomicAdd(vsq + row, q); }
            }
    }
};
struct Epi9 {
    static constexpr bool PERM = true, AFTER_DRAIN = false;
    const float* rss; const bf16_t* SB; bf16_t* Y;
    __device__ __forceinline__ void operator()(EPI_ARGS) const {
        const int colL = wc * 32 + 8 * fq, row0 = u.pm * 256 + wr * 64 + fr, col = u.pn * 128 + colL;
        float rsv[2][4]; u32x4 sv[2][4];
#pragma unroll
        for (int ai = 0; ai < 2; ++ai)
#pragma unroll
            for (int m = 0; m < 4; ++m) { const int row = row0 + ai * 128 + m * 16; rsv[ai][m] = rss[row]; sv[ai][m] = *(const u32x4*)(SB + (size_t)row * 2048 + col); }
#pragma unroll
        for (int ai = 0; ai < 2; ++ai)
#pragma unroll
            for (int m = 0; m < 4; ++m) {
                const int row = row0 + ai * 128 + m * 16;
                const float rs = __builtin_amdgcn_rsqf(rsv[ai][m] * (1.f / 1024.f) + EPS);
                float uu[8], zz[8]; ACC8(uu, ai, 0, m, rs); ACC8(zz, ai, 1, m, rs);
                const u32x4 w = sv[ai][m]; const float s[8] = {bflo(w.x), bfhi(w.x), bflo(w.y), bfhi(w.y), bflo(w.z), bfhi(w.z), bflo(w.w), bfhi(w.w)};
#pragma unroll
                for (int j = 0; j < 8; ++j) uu[j] = geluf_(uu[j]) * s[j] * siluf_(zz[j]);
                st8bf(Y + (size_t)row * 2048 + col, uu);
            }
    }
};

__device__ __forceinline__ void p0_transpose_item(const float* W, int K, int N, bf16_t* WT, int row_off, LAS float* scr, int kb, int nb, int lane) {
    const int k0 = 64 * kb, n0 = 32 * nb;
#pragma unroll 8
    for (int i = 0; i < 32; ++i) { const int kk = 2 * i + (lane >> 5); scr[kk * 33 + (lane & 31)] = W[(size_t)(k0 + kk) * N + n0 + (lane & 31)]; }
    asm volatile("s_waitcnt lgkmcnt(0)" ::: "memory");
    const int c = lane & 7;
#pragma unroll
    for (int j = 0; j < 4; ++j) { const int n = (lane >> 3) + 8 * j; const LAS float* s = scr + (8 * c) * 33 + n;
        u32x4 o; o.x = pk2(s[0 * 33], s[1 * 33]); o.y = pk2(s[2 * 33], s[3 * 33]); o.z = pk2(s[4 * 33], s[5 * 33]); o.w = pk2(s[6 * 33], s[7 * 33]);
        *(u32x4*)(WT + (size_t)(row_off + n0 + n) * K + k0 + 8 * c) = o; }
    asm volatile("s_waitcnt lgkmcnt(0)" ::: "memory");
}
__device__ __forceinline__ int wino_row(int n) {
    if (n < 2048) return 2048 + 256 * (n >> 7) + (n & 127);
    if (n < 4096) return n - 2048;
    const int z = n - 4096; return 2048 + 256 * (z >> 7) + 128 + (z & 127);
}

template <bool FINAL>
__device__ __forceinline__ void s5_item(int b, int c, int g, bf16_t* U, float* CHS, const float* APOW, const bf16_t* BBT, const bf16_t* CCT, const float* dsk, LAS unsigned char* wlds, int lane) {
    const int h = lane >> 5, r = lane & 31;
    const size_t row0 = (size_t)b * SEQ + (size_t)c * 128;
    bf16x8 bfrag[4];
#pragma unroll
    for (int nt = 0; nt < 4; ++nt) bfrag[nt] = *(const bf16x8*)(BBT + ((size_t)(g * 128 + nt * 32 + r) * 16 + 8 * h));
    float ar[2][4], ai_[2][4], cr[2], ci[2];
#pragma unroll
    for (int ph = 0; ph < 2; ++ph) {
        const int p = 32 * ph + r; const f32x4 w0 = *(const f32x4*)(APOW + (size_t)(g * 64 + p) * 8), w1 = *(const f32x4*)(APOW + (size_t)(g * 64 + p) * 8 + 4);
        ar[ph][0] = w0.x; ai_[ph][0] = w0.y; ar[ph][1] = w0.z; ai_[ph][1] = w0.w; ar[ph][2] = w1.x; ai_[ph][2] = w1.y; ar[ph][3] = w1.z; ai_[ph][3] = w1.w;
        if (FINAL) { const float* cp = CHS + ((size_t)((b * 64 + c) * 64 + g) * 64 + p) * 2; cr[ph] = cp[0]; ci[ph] = cp[1]; } else { cr[ph] = 0.f; ci[ph] = 0.f; }
    }
    bf16x8 cfrag[4];
    if (FINAL) {
#pragma unroll
        for (int ks = 0; ks < 4; ++ks) cfrag[ks] = *(const bf16x8*)(CCT + ((size_t)(g * 16 + (lane & 15)) * 128 + ks * 32 + 8 * (lane >> 4)));
    }
    const float dk = FINAL ? dsk[g * 16 + (lane & 15)] : 0.f;
    for (int sb = 0; sb < 4; ++sb) {
        const bf16x8 afrag = *(const bf16x8*)(U + (row0 + sb * 32 + r) * 1024 + g * 16 + 8 * h);
        f32x16 re[2], im[2];
        const f32x16 zero16 = {0.f, 0.f, 0.f, 0.f, 0.f, 0.f, 0.f, 0.f, 0.f, 0.f, 0.f, 0.f, 0.f, 0.f, 0.f, 0.f};
        re[0] = __builtin_amdgcn_mfma_f32_32x32x16_bf16(afrag, bfrag[0], zero16, 0, 0, 0);
        re[1] = __builtin_amdgcn_mfma_f32_32x32x16_bf16(afrag, bfrag[1], zero16, 0, 0, 0);
        im[0] = __builtin_amdgcn_mfma_f32_32x32x16_bf16(afrag, bfrag[2], zero16, 0, 0, 0);
        im[1] = __builtin_amdgcn_mfma_f32_32x32x16_bf16(afrag, bfrag[3], zero16, 0, 0, 0);
#pragma unroll
        for (int ph = 0; ph < 2; ++ph) {
            const float a1r = ar[ph][0], a1i = ai_[ph][0], a4r = ar[ph][3], a4i = ai_[ph][3];
#pragma unroll
            for (int q = 0; q < 4; ++q) {
#pragma unroll
                for (int j = 1; j < 4; ++j) { const int i = 4 * q + j; const float pr = re[ph][i - 1], pi = im[ph][i - 1];
                    re[ph][i] += a1r * pr - a1i * pi; im[ph][i] += a1r * pi + a1i * pr; }
            }
#pragma unroll
            for (int q = 0; q < 4; ++q) {
                const float Er = re[ph][4 * q + 3], Ei = im[ph][4 * q + 3];
                const float Xr = Er + a4r * cr[ph] - a4i * ci[ph], Xi = Ei + a4r * ci[ph] + a4i * cr[ph];
                const float Xor_ = __shfl_xor(Xr, 32), Xoi = __shfl_xor(Xi, 32);
                const float cinr = h ? Xor_ : cr[ph], cini = h ? Xoi : ci[ph];
                const float Yr = Er + a4r * cinr - a4i * cini, Yi = Ei + a4r * cini + a4i * cinr;
                const float Yor = __shfl_xor(Yr, 32), Yoi = __shfl_xor(Yi, 32);
                if (FINAL) {
#pragma unroll
                    for (int j = 0; j < 4; ++j) { const int i = 4 * q + j; re[ph][i] += ar[ph][j] * cinr - ai_[ph][j] * cini; im[ph][i] += ar[ph][j] * cini + ai_[ph][j] * cinr; }
                }
                cr[ph] = h ? Yr : Yor; ci[ph] = h ? Yi : Yoi;
            }
        }
        if (FINAL) {
#pragma unroll
            for (int ph = 0; ph < 2; ++ph)
#pragma unroll
                for (int i = 0; i < 16; ++i) { const int tok = (i & 3) + 8 * (i >> 2) + 4 * h; const int p = 32 * ph + r;
                    *(LAS unsigned*)(wlds + tok * 272 + 4 * p) = pk2(re[ph][i], im[ph][i]); }
            asm volatile("s_waitcnt lgkmcnt(0)" ::: "memory");
            f32x4 yacc[2] = {(f32x4){0.f, 0.f, 0.f, 0.f}, (f32x4){0.f, 0.f, 0.f, 0.f}};
#pragma unroll
            for (int mt = 0; mt < 2; ++mt)
#pragma unroll
                for (int ks = 0; ks < 4; ++ks) { const bf16x8 a = *(const LAS bf16x8*)(wlds + (mt * 16 + (lane & 15)) * 272 + (ks * 32 + 8 * (lane >> 4)) * 2);
                    yacc[mt] = __builtin_amdgcn_mfma_f32_16x16x32_bf16(a, cfrag[ks], yacc[mt], 0, 0, 0); }
            asm volatile("s_waitcnt lgkmcnt(0)" ::: "memory");
#pragma unroll
            for (int mt = 0; mt < 2; ++mt)
#pragma unroll
                for (int j = 0; j < 4; ++j) { const size_t row = row0 + sb * 32 + mt * 16 + 4 * (lane >> 4) + j; const bf16_t* pu = U + row * 1024 + g * 16 + (lane & 15);
                    const float y = yacc[mt][j] + dk * bf2f(*pu); U[row * 1024 + g * 16 + (lane & 15)] = (bf16_t)f2bf(geluf_(y)); }
        }
    }
    if (!FINAL && h == 0) {
#pragma unroll
        for (int ph = 0; ph < 2; ++ph) { float* cp = CHS + ((size_t)((b * 64 + c) * 64 + g) * 64 + 32 * ph + r) * 2; cp[0] = cr[ph]; cp[1] = ci[ph]; }
    }
}

__device__ __forceinline__ bf16x8 gather8(const LAS bf16_t* p, int pitch) {
    bf16x8 v;
#pragma unroll
    for (int j = 0; j < 8; ++j) v[j] = (short)p[j * pitch];
    return v;
}
typedef short v4i16_t __attribute__((ext_vector_type(4)));
__device__ __forceinline__ bf16x8 tr_frag(const LAS bf16_t* T, int row0, int col0, int pitch, int lane) {
    const int q = (lane & 15) >> 2, p = lane & 3, blk = (lane >> 4) & 1;
    const LAS bf16_t* a0 = T + (row0 + q) * pitch + col0 + 16 * blk + 4 * p;
    const v4i16_t lo = __builtin_amdgcn_ds_read_tr16_b64_v4i16((LAS v4i16_t*)a0);
    const v4i16_t hi = __builtin_amdgcn_ds_read_tr16_b64_v4i16((LAS v4i16_t*)(a0 + 4 * pitch));
    bf16x8 v; v[0] = lo[0]; v[1] = lo[1]; v[2] = lo[2]; v[3] = lo[3]; v[4] = hi[0]; v[5] = hi[1]; v[6] = hi[2]; v[7] = hi[3];
    return v;
}
#define MFMA32(a, b, c) __builtin_amdgcn_mfma_f32_32x32x16_bf16((a), (b), (c), 0, 0, 0)
#define ZERO16 ((f32x16){0.f, 0.f, 0.f, 0.f, 0.f, 0.f, 0.f, 0.f, 0.f, 0.f, 0.f, 0.f, 0.f, 0.f, 0.f, 0.f})

#define XB_TMO      128
#define XB_XCNT(j)  (256  + 64 * (j))
#define XB_XSUB(j)  (1280 + 64 * (j))
#define XB_XGEN(j)  (2304 + 64 * (j))
#define XB_TOP      3328
#define XB_TOPGEN   3392
#define XCD_BAR_WORDS 3456
#define XB_SPIN_CAP (1u << 18)

__device__ __forceinline__ unsigned xb_ld(unsigned* p)              { return __hip_atomic_load(p, __ATOMIC_RELAXED, __HIP_MEMORY_SCOPE_AGENT); }
__device__ __forceinline__ unsigned xb_add(unsigned* p, unsigned v) { return __hip_atomic_fetch_add(p, v, __ATOMIC_RELAXED, __HIP_MEMORY_SCOPE_AGENT); }
__device__ __forceinline__ unsigned xb_xcc_id() { return (unsigned)__builtin_amdgcn_s_getreg((3 << 11) | 20) & 0xFu; }
#define XB_SPIN(cond, bar) do { unsigned _sp = 0; while (cond) { __builtin_amdgcn_s_sleep(1); \
    if ((++_sp & 255u) == 0u) { if (xb_ld(&(bar)[XB_TMO])) break; if (_sp > XB_SPIN_CAP) { atomicAdd(&(bar)[XB_TMO], 1u); break; } } } } while (0)

struct XcdBarrier {
    unsigned* bar; unsigned x;
    volatile LAS unsigned* st;
};

__device__ __forceinline__ XcdBarrier xcd_barrier_post(unsigned* bar, volatile LAS unsigned* st) {
    XcdBarrier b; b.bar = bar; b.x = xb_xcc_id(); b.st = st;
    if (threadIdx.x == 0) (void)xb_add(&bar[XB_XCNT(b.x)], 1u);
    return b;
}
__device__ __forceinline__ void xcd_barrier_complete(unsigned* bar, unsigned x, unsigned& nloc, unsigned& nx) {
    const unsigned G = gridDim.x * gridDim.y * gridDim.z;
    unsigned sum, cnt, mine, sp = 0u;
    for (;;) {
        sum = 0u; cnt = 0u; mine = 0u;
#pragma unroll
        for (unsigned j = 0; j < 16; ++j) { const unsigned c = xb_ld(&bar[XB_XCNT(j)]); sum += c; cnt += (c > 0u) ? 1u : 0u; mine = (j == x) ? c : mine; }
        if (sum == G) break;
        __builtin_amdgcn_s_sleep(1);
        if ((++sp & 255u) == 0u) { if (xb_ld(&bar[XB_TMO])) break; if (sp > XB_SPIN_CAP) { atomicAdd(&bar[XB_TMO], 1u); break; } }
    }
    nloc = mine > 0u ? mine : 1u; nx = cnt > 0u ? cnt : 1u;
}

__device__ __forceinline__ void xcd_barrier(const XcdBarrier& b) {
    asm volatile("s_waitcnt vmcnt(0)" ::: "memory");
    __syncthreads();
    if (threadIdx.x == 0) {
        unsigned* bar = b.bar;
        __builtin_amdgcn_s_waitcnt(0);
        unsigned nloc = b.st[0], nx = b.st[1];
        if (nloc == 0u) { xcd_barrier_complete(bar, b.x, nloc, nx); b.st[0] = nloc; b.st[1] = nx; }
        const unsigned old = xb_add(&bar[XB_XSUB(b.x)], 1u);
        const unsigned gen = old / nloc;
        if (old + 1u == (gen + 1u) * nloc) {
            __builtin_amdgcn_fence(__ATOMIC_RELEASE, "agent");
            asm volatile("s_waitcnt vmcnt(0)" ::: "memory");
            const unsigned og = xb_add(&bar[XB_TOP], 1u);
            const unsigned tg = og / nx;
            if (og + 1u == (tg + 1u) * nx) xb_add(&bar[XB_TOPGEN], 1u);
            else XB_SPIN(xb_ld(&bar[XB_TOPGEN]) == tg, bar);
            __builtin_amdgcn_fence(__ATOMIC_ACQUIRE, "agent");
            xb_add(&bar[XB_XGEN(b.x)], 1u);
            asm volatile("s_waitcnt vmcnt(0)" ::: "memory");
        } else {
            XB_SPIN(xb_ld(&bar[XB_XGEN(b.x)]) == gen, bar);
            __builtin_amdgcn_fence(__ATOMIC_ACQUIRE, "agent");
            asm volatile("s_waitcnt vmcnt(0)" ::: "memory");
        }
    }
    __syncthreads();
}

__global__ void __launch_bounds__(NTHR, 2) mk_fwd(Args args) {
    extern __shared__ __attribute__((aligned(16))) unsigned char lds_raw[];
    LAS unsigned char* lds = (LAS unsigned char*)lds_raw;
    cg::grid_group grid = cg::this_grid();
    const int tid = threadIdx.x, lane = tid & 63, wid = __builtin_amdgcn_readfirstlane(tid >> 6);
    const int G = gridDim.x, bid = blockIdx.x;
    const int gw = bid * 8 + wid, NGW = G * 8;
    const int gtid = bid * NTHR + tid, NGT = G * NTHR;
    unsigned char* ws = args.ws;
    const float* x = args.in[0];
    float* RSS0 = (float*)(ws + WS_RSS0); float* RSS1 = (float*)(ws + WS_RSS1); float* VSUM = (float*)(ws + WS_VSUM); float* VSQ = (float*)(ws + WS_VSQ); float* RSS2 = (float*)(ws + WS_RSS2);
    float* APOW = (float*)(ws + WS_APOW); float* A128 = (float*)(ws + WS_A128); bf16_t* BBT = (bf16_t*)(ws + WS_BBT); bf16_t* CCT = (bf16_t*)(ws + WS_CCT);
    float* COS = (float*)(ws + WS_COS); float* SIN = (float*)(ws + WS_SIN); float* CHS = (float*)(ws + WS_CHS);
    bf16_t* WINE = (bf16_t*)(ws + WS_WINE); bf16_t* WGLU = (bf16_t*)(ws + WS_WGLU); bf16_t* WOUTE = (bf16_t*)(ws + WS_WOUTE); bf16_t* WINO = (bf16_t*)(ws + WS_WINO); bf16_t* WOUTO = (bf16_t*)(ws + WS_WOUTO);
    bf16_t* U = (bf16_t*)(ws + WS_U); bf16_t* CAT = (bf16_t*)(ws + WS_CAT); bf16_t* Kb = (bf16_t*)(ws + WS_K); bf16_t* Vb = (bf16_t*)(ws + WS_V); bf16_t* SZB = (bf16_t*)(ws + WS_SZB);
    float* X1 = (float*)(ws + WS_X1);
    bf16_t* XG0 = (bf16_t*)args.out;
    bf16_t* STATE = (bf16_t*)args.out;
    bf16_t* VB = (bf16_t*)args.out;
    const int lo = args.ph_lo, hi = args.ph_hi;
    volatile LAS unsigned* xst = (volatile LAS unsigned*)(lds + LDS_BYTES - 64);
    if (tid == 0) { xst[0] = 0u; xst[1] = 0u; }
    __syncthreads();
    const XcdBarrier xbar = xcd_barrier_post((unsigned*)(ws + WS_BAR), xst);
#ifndef PHMASK
#define PHMASK 0xFFF
#endif
#define IN(k) (((PHMASK >> (k)) & 1) && lo <= (k) && (k) < hi)
#define SEAM(k) do { if (IN(k) && IN((k) + 1)) { if ((k) == 0) grid.sync(); else xcd_barrier(xbar); } } while (0)
#ifndef PROBE_REP
#define PROBE_REP (-1)
#endif
#define PROBE_BEGIN(k) for (int pass = (PROBE_REP == (k)) ? 0 : 1; pass < 2; ++pass) { const bool dummy = (pass == 0); const size_t omask = dummy ? (size_t)2047 : ~(size_t)0; (void)omask;
#define PROBE_END if (pass == 0) grid.sync(); }
    bf16_t* DUMMY = (bf16_t*)(ws + WS_END);

    if (IN(0)) {
        LAS float* scr = (LAS float*)(lds + wid * 16384);
        constexpr int I_INE = 16 * 192, I_GLU = 16 * 32, I_OUTE = 32 * 32, I_INO = 16 * 192, I_OUTO = 32 * 32;
        constexpr int NIT = I_INE + I_GLU + I_OUTE + I_INO + I_OUTO;
        for (int it = gw; it < NIT; it += NGW) {
            int rr = it;
            if (rr < I_INE) { p0_transpose_item(args.in[2], 1024, 6144, WINE, 0, scr, rr / 192, rr % 192, lane); continue; } rr -= I_INE;
            if (rr < I_GLU) { p0_transpose_item(args.in[11], 1024, 1024, WGLU, 0, scr, rr / 32, rr % 32, lane); continue; } rr -= I_GLU;
            if (rr < I_OUTE) { p0_transpose_item(args.in[14], 2048, 1024, WOUTE, 0, scr, rr / 32, rr % 32, lane); continue; } rr -= I_OUTE;
            if (rr < I_INO) { const int nb = rr % 192; p0_transpose_item(args.in[16], 1024, 6144, WINO, wino_row(32 * nb) - 32 * nb, scr, rr / 192, nb, lane); continue; } rr -= I_INO;
            p0_transpose_item(args.in[20], 2048, 1024, WOUTO, 0, scr, rr / 32, rr % 32, lane);
        }
        for (int m = gw; m < M; m += NGW) {
            const f32x4* xr = (const f32x4*)(x + (size_t)m * D) + lane; const f32x4* gr = (const f32x4*)args.in[1] + lane;
            float s = 0.f; u32x2* o8 = (u32x2*)(XG0 + (size_t)m * D) + lane;
#pragma unroll
            for (int j = 0; j < 4; ++j) { const f32x4 v = xr[64 * j], gg = gr[64 * j]; s += (v.x * v.x + v.y * v.y) + (v.z * v.z + v.w * v.w);
                u32x2 w; w.x = pk2(v.x * gg.x, v.y * gg.y); w.y = pk2(v.z * gg.z, v.w * gg.w); o8[64 * j] = w; }
            s = wave_sum(s); if (lane == 0) RSS0[m] = s;
        }
        for (int e = gtid; e < SEQ * 128; e += NGT) { const int pos = e >> 7, i = e & 127;
            const double inv = exp(-(double)i * (9.210340371976184 / 128.0)); double s, c; sincos_d((double)pos * inv, s, c); COS[e] = (float)c; SIN[e] = (float)s; }
        for (int e = gtid; e < 4096; e += NGT) { const int g = e >> 6, p = e & 63;
            const double lr = fmin((double)args.in[3][e], -1e-4), li = (double)args.in[4][e], dt = exp((double)args.in[5][g]);
            const double mag = exp(lr * dt); double sn, cs; sincos_d(li * dt, sn, cs);
            const double abr = mag * cs, abi = mag * sn, den = lr * lr + li * li, nr = abr - 1.0, ni = abi;
            const double zr = (nr * lr + ni * li) / den, zi = (ni * lr - nr * li) / den;
            double pr = abr, pi = abi;
#pragma unroll
            for (int k = 0; k < 4; ++k) { APOW[e * 8 + 2 * k] = (float)pr; APOW[e * 8 + 2 * k + 1] = (float)pi; const double t = pr * abr - pi * abi; pi = pr * abi + pi * abr; pr = t; }
            double qr = abr, qi = abi;
#pragma unroll
            for (int k = 0; k < 7; ++k) { const double t = qr * qr - qi * qi; qi = 2.0 * qr * qi; qr = t; }
            A128[e * 2] = (float)qr; A128[e * 2 + 1] = (float)qi;
            const float* br = args.in[6] + (size_t)e * 16; const float* bi = args.in[7] + (size_t)e * 16;
#pragma unroll
            for (int k = 0; k < 16; ++k) { const double b_r = br[k], b_i = bi[k];
                BBT[(size_t)(g * 128 + p) * 16 + k] = (bf16_t)f2bf((float)(zr * b_r - zi * b_i)); BBT[(size_t)(g * 128 + 64 + p) * 16 + k] = (bf16_t)f2bf((float)(zr * b_i + zi * b_r)); }
#pragma unroll
            for (int hh = 0; hh < 16; ++hh) { const float c_r = args.in[8][(size_t)(g * 16 + hh) * 64 + p], c_i = args.in[9][(size_t)(g * 16 + hh) * 64 + p];
                CCT[(size_t)(g * 16 + hh) * 128 + 2 * p] = (bf16_t)f2bf(c_r); CCT[(size_t)(g * 16 + hh) * 128 + 2 * p + 1] = (bf16_t)f2bf(-c_i); }
        }
        for (int e = gtid; e < M; e += NGT) { RSS1[e] = 0.f; VSUM[e] = 0.f; VSQ[e] = 0.f; RSS2[e] = 0.f; }
        __syncthreads();
    }
    SEAM(0);
    if (IN(1)) {
        pg8::Gemm g{XG0, WINE, M, 6144, 1024}; pg8::StaticOrder S; S.init(M, 6144, G, bid);
        Epi1 E{RSS0, U, CAT, Kb, Vb, SZB, COS, SIN};
        pg8::gemm_phase<Epi1, pg8::StaticOrder, true, true>(lds, g, S, E);
    }
    SEAM(1);
    if (IN(2)) {
        for (int it = gw; it < 2 * 64 * 64; it += NGW) { const int g = it & 63, c = (it >> 6) & 63, b = it >> 12;
            s5_item<false>(b, c, g, U, CHS, APOW, BBT, CCT, args.in[10], lds + wid * 8704, lane); }
        __syncthreads();
        LAS bf16_t* Vs = (LAS bf16_t*)lds; LAS bf16_t* Ks = (LAS bf16_t*)(lds + 34816);
        const int wm = wid >> 1, wn = wid & 1, h5_ = lane >> 5, r_ = lane & 31;
        u32x4 pv[4], pk[4];
#define RA_LOAD(IT) do { const int kt_ = (IT) & 1, vt_ = ((IT) >> 1) & 1, hh_ = ((IT) >> 2) & 3, c_ = ((IT) >> 4) & 63, b_ = (IT) >> 10; const size_t rw0 = (size_t)b_ * SEQ + (size_t)c_ * 128; \
            _Pragma("unroll") for (int i = 0; i < 4; ++i) { const int idx = tid + NTHR * i, row = idx >> 4, ch = idx & 15; \
                pv[i] = *(const u32x4*)(Vb + (rw0 + row) * 1024 + hh_ * 256 + vt_ * 128 + ch * 8); pk[i] = *(const u32x4*)(Kb + (rw0 + row) * 1024 + hh_ * 256 + kt_ * 128 + ch * 8); } } while (0)
        if (bid < 2048) RA_LOAD(bid);
        for (int it = bid; it < 2048; it += G) {
            const int kt = it & 1, vt = (it >> 1) & 1, hh = (it >> 2) & 3, c = (it >> 4) & 63, b = it >> 10;
            const float lg = lg_gamma(hh);
            int h5 = h5_, r = r_; asm volatile("" : "+v"(h5), "+v"(r));
#pragma unroll
            for (int i = 0; i < 4; ++i) { const int idx = tid + NTHR * i, row = idx >> 4, ch = idx & 15;
                const float z = __builtin_amdgcn_exp2f((float)(127 - row) * lg); const u32x4 w = pv[i]; u32x4 o;
                o.x = pk2(bflo(w.x) * z, bfhi(w.x) * z); o.y = pk2(bflo(w.y) * z, bfhi(w.y) * z); o.z = pk2(bflo(w.z) * z, bfhi(w.z) * z); o.w = pk2(bflo(w.w) * z, bfhi(w.w) * z);
                *(LAS u32x4*)(Vs + row * 136 + ch * 8) = o; *(LAS u32x4*)(Ks + row * 136 + ch * 8) = pk[i]; }
            __syncthreads();
            if (it + G < 2048) RA_LOAD(it + G);
            f32x16 acc[2] = {ZERO16, ZERO16};
#pragma unroll 4
            for (int ks = 0; ks < 8; ++ks) { const int m0 = 16 * ks + 8 * h5;
                const bf16x8 a = tr_frag(Vs, m0, 32 * wm, 136, lane);
#pragma unroll
                for (int nt = 0; nt < 2; ++nt) { const bf16x8 bb = tr_frag(Ks, m0, 64 * wn + 32 * nt, 136, lane); acc[nt] = MFMA32(bb, a, acc[nt]); } }
            bf16_t* dst = STATE + ((size_t)((b * 64 + c) * 4 + hh) * 256 + vt * 128 + 32 * wm + r) * 256 + kt * 128 + 64 * wn + 4 * h5;
#pragma unroll
            for (int nt = 0; nt < 2; ++nt)
#pragma unroll
                for (int iq = 0; iq < 4; ++iq) { u32x2 w; w.x = pk2(acc[nt][4 * iq], acc[nt][4 * iq + 1]); w.y = pk2(acc[nt][4 * iq + 2], acc[nt][4 * iq + 3]); *(u32x2*)(dst + 32 * nt + 8 * iq) = w; }
            __syncthreads();
        }
#undef RA_LOAD
    }
    SEAM(2);
    if (IN(3)) {
        for (int e = gtid; e < 131072; e += NGT) { const int bh = e >> 14, idx4 = e & 16383, b = bh >> 2, hh = bh & 3;
            const float cd = __builtin_amdgcn_exp2f(128.f * lg_gamma(hh)); float s0 = 0.f, s1 = 0.f, s2 = 0.f, s3 = 0.f;
            u32x2* p = (u32x2*)(STATE + ((size_t)(b * 64) * 4 + hh) * 65536 + (size_t)idx4 * 4);
#pragma unroll 8
            for (int c = 0; c < 64; ++c) { u32x2* q = p + (size_t)c * (4 * 65536 / 4); const u32x2 w = *q;
                u32x2 o; o.x = pk2(s0, s1); o.y = pk2(s2, s3); *q = o;
                s0 = s0 * cd + bflo(w.x); s1 = s1 * cd + bfhi(w.x); s2 = s2 * cd + bflo(w.y); s3 = s3 * cd + bfhi(w.y); } }
        for (int e = gtid; e < 8192; e += NGT) { const int b = e >> 12, gp = e & 4095; const float ar = A128[gp * 2], ai = A128[gp * 2 + 1]; float cr = 0.f, ci = 0.f;
            for (int c = 0; c < 64; ++c) { float* q = CHS + ((size_t)(b * 64 + c) * 4096 + gp) * 2; const float lr_ = q[0], li_ = q[1]; q[0] = cr; q[1] = ci;
                const float t = ar * cr - ai * ci + lr_; ci = ar * ci + ai * cr + li_; cr = t; } }
    }
    SEAM(3);
    if (IN(4)) {
        for (int it = gw; it < 2 * 64 * 64; it += NGW) { const int g = it & 63, c = (it >> 6) & 63, b = it >> 12;
            s5_item<true>(b, c, g, U, CHS, APOW, BBT, CCT, args.in[10], lds + wid * 8704, lane); }
        __syncthreads();
        LAS bf16_t* Qs = (LAS bf16_t*)lds; LAS bf16_t* Ks = (LAS bf16_t*)(lds + 67584); LAS bf16_t* Ps = (LAS bf16_t*)(lds + 67584); LAS bf16_t* Xs = (LAS bf16_t*)(lds + 67584 + 34816);
        LAS float* red = (LAS float*)lds;
        const int wm = wid >> 1, wn = wid & 1, h5_ = lane >> 5, r_ = lane & 31;
        const float* gain = args.in[13];
#define OPQ() asm volatile("" : "+v"(h5), "+v"(r))
        for (int it = bid; it < 512; it += G) {
            const int hh = it & 3, c = (it >> 2) & 63, b = it >> 8;
            const size_t row0 = (size_t)b * SEQ + (size_t)c * 128; const float lg = lg_gamma(hh);
            int h5 = h5_, r = r_; OPQ();
#pragma unroll 4
            for (int i = 0; i < 8; ++i) { const int idx = tid + NTHR * i, row = idx >> 5, ch = idx & 31;
                *(LAS u32x4*)(Qs + row * 264 + ch * 8) = *(const u32x4*)(CAT + (row0 + row) * 2048 + 1024 + hh * 256 + ch * 8);
                *(LAS u32x4*)(Ks + row * 264 + ch * 8) = *(const u32x4*)(Kb + (row0 + row) * 1024 + hh * 256 + ch * 8); }
            __syncthreads();
            u32x4 pvv[4], pc[4];
#define RC_LOADV(VH) do { _Pragma("unroll") for (int i = 0; i < 4; ++i) { const int idx = tid + NTHR * i, row = idx >> 4, ch = idx & 15; pvv[i] = *(const u32x4*)(Vb + (row0 + row) * 1024 + hh * 256 + (VH) * 128 + ch * 8); } } while (0)
#define RC_STOREV() do { _Pragma("unroll") for (int i = 0; i < 4; ++i) { const int idx = tid + NTHR * i, row = idx >> 4, ch = idx & 15; *(LAS u32x4*)(Xs + row * 136 + ch * 8) = pvv[i]; } } while (0)
#define RC_LOADC(STP, KC) do { _Pragma("unroll") for (int i = 0; i < 4; ++i) { const int idx = tid + NTHR * i, row = idx >> 4, ch = idx & 15; pc[i] = *(const u32x4*)((STP) + (size_t)row * 256 + (KC) * 128 + ch * 8); } } while (0)
#define RC_STOREC() do { _Pragma("unroll") for (int i = 0; i < 4; ++i) { const int idx = tid + NTHR * i, row = idx >> 4, ch = idx & 15; *(LAS u32x4*)(Xs + row * 136 + ch * 8) = pc[i]; } } while (0)
            RC_LOADV(0);
            f32x16 sacc[2] = {ZERO16, ZERO16};
#pragma unroll 4
            for (int ks = 0; ks < 16; ++ks) { const int k0 = 16 * ks + 8 * h5;
                const bf16x8 a = *(const LAS bf16x8*)(Qs + (32 * wm + r) * 264 + k0);
#pragma unroll
                for (int nt = 0; nt < 2; ++nt) { const bf16x8 bb = *(const LAS bf16x8*)(Ks + (64 * wn + 32 * nt + r) * 264 + k0); sacc[nt] = MFMA32(bb, a, sacc[nt]); } }
            __syncthreads();
            OPQ();
            { const int n = 32 * wm + r;
#pragma unroll
              for (int nt = 0; nt < 2; ++nt)
#pragma unroll
                for (int iq = 0; iq < 4; ++iq) { const int m0 = 64 * wn + 32 * nt + 8 * iq + 4 * h5; float pvl[4];
#pragma unroll
                    for (int j = 0; j < 4; ++j) { const int mc = m0 + j; pvl[j] = (n >= mc) ? sacc[nt][4 * iq + j] * __builtin_amdgcn_exp2f(-(float)(mc + 1) * lg) : 0.f; }
                    u32x2 w; w.x = pk2(pvl[0], pvl[1]); w.y = pk2(pvl[2], pvl[3]); *(LAS u32x2*)(Ps + n * 136 + m0) = w; } }
            RC_STOREV();
            __syncthreads();
            f32x16 oacc[2][2] = {{ZERO16, ZERO16}, {ZERO16, ZERO16}};
#pragma unroll
            for (int vh = 0; vh < 2; ++vh) {
                OPQ();
                const bf16_t* st = STATE + ((size_t)((b * 64 + c) * 4 + hh) * 256 + vh * 128) * 256;
                RC_LOADC(st, 0);
#pragma unroll 2
                for (int ks = 0; ks < 8; ++ks) { const int m0 = 16 * ks + 8 * h5;
                    const bf16x8 a = *(const LAS bf16x8*)(Ps + (32 * wm + r) * 136 + m0);
#pragma unroll
                    for (int nt = 0; nt < 2; ++nt) { const bf16x8 bb = tr_frag(Xs, m0, 64 * wn + 32 * nt, 136, lane); oacc[vh][nt] = MFMA32(bb, a, oacc[vh][nt]); } }
#pragma unroll 1
                for (int kc = 0; kc < 2; ++kc) {
                    __syncthreads();
                    RC_STOREC();
                    __syncthreads();
                    if (kc < 1) RC_LOADC(st, kc + 1); else if (vh == 0) RC_LOADV(1);
#pragma unroll 4
                    for (int ks = 0; ks < 8; ++ks) { const int k0 = 16 * ks + 8 * h5;
                        const bf16x8 a = *(const LAS bf16x8*)(Qs + (32 * wm + r) * 264 + kc * 128 + k0);
#pragma unroll
                        for (int nt = 0; nt < 2; ++nt) { const bf16x8 bb = *(const LAS bf16x8*)(Xs + (64 * wn + 32 * nt + r) * 136 + k0); oacc[vh][nt] = MFMA32(bb, a, oacc[vh][nt]); } }
                }
                __syncthreads();
                if (vh == 0) { RC_STOREV(); __syncthreads(); }
            }
            OPQ();
            const int n = 32 * wm + r; const float xi = __builtin_amdgcn_exp2f((float)(n + 1) * lg);
            float s = 0.f, q = 0.f;
#pragma unroll
            for (int vh = 0; vh < 2; ++vh)
#pragma unroll
                for (int nt = 0; nt < 2; ++nt)
#pragma unroll
                    for (int i = 0; i < 16; ++i) { const float o = oacc[vh][nt][i] * xi; oacc[vh][nt][i] = o; s += o; q += o * o; }
            s += __shfl_xor(s, 32); q += __shfl_xor(q, 32);
            if (h5 == 0) { red[(wn * 128 + n) * 2] = s; red[(wn * 128 + n) * 2 + 1] = q; }
            __syncthreads();
            OPQ();
            { const float st_ = red[n * 2] + red[(128 + n) * 2], qt = red[n * 2 + 1] + red[(128 + n) * 2 + 1];
              const float mu = st_ * (1.f / 256.f), var = fmaxf(qt * (1.f / 256.f) - mu * mu, 0.f), rstd = __builtin_amdgcn_rsqf(var + EPS);
#pragma unroll
              for (int vh = 0; vh < 2; ++vh)
#pragma unroll
                for (int nt = 0; nt < 2; ++nt)
#pragma unroll
                    for (int iq = 0; iq < 4; ++iq) { const int col = hh * 256 + vh * 128 + 64 * wn + 32 * nt + 8 * iq + 4 * h5;
                        const f32x4 gv = *(const f32x4*)(gain + col); const u32x2 zz = *(const u32x2*)(SZB + (row0 + n) * 1024 + col);
                        const float y0 = (oacc[vh][nt][4 * iq] - mu) * rstd * gv.x * bflo(zz.x), y1 = (oacc[vh][nt][4 * iq + 1] - mu) * rstd * gv.y * bfhi(zz.x);
                        const float y2 = (oacc[vh][nt][4 * iq + 2] - mu) * rstd * gv.z * bflo(zz.y), y3 = (oacc[vh][nt][4 * iq + 3] - mu) * rstd * gv.w * bfhi(zz.y);
                        u32x2 w; w.x = pk2(y0, y1); w.y = pk2(y2, y3); *(u32x2*)(CAT + (row0 + n) * 2048 + 1024 + col) = w; } }
            __syncthreads();
        }
#undef RC_LOADV
#undef RC_STOREV
#undef RC_LOADC
#undef RC_STOREC
    }
    SEAM(4);
    if (IN(5)) {
        pg8::Gemm g{U, WGLU, M, 1024, 1024}; pg8::StaticOrder S; S.init(M, 1024, G, bid);
        EpiGlu E{args.in[12], U, CAT};
        pg8::gemm_phase<EpiGlu, pg8::StaticOrder, true, true>(lds, g, S, E);
    }
    SEAM(5);
    if (IN(6)) {
        pg8::Gemm g{CAT, WOUTE, M, 1024, 2048}; pg8::StaticOrder S; S.init(M, 1024, G, bid);
        EpiOut E{x, X1, U, args.in[15], RSS1};
        pg8::gemm_phase<EpiOut, pg8::StaticOrder, true, true>(lds, g, S, E);
    }
    SEAM(6);
    if (IN(7)) {
        pg8::Gemm g{U, WINO, M, 2048, 1024}; pg8::StaticOrder S; S.init(M, 2048, G, bid);
        Epi7 E{RSS1, VB, VSUM, VSQ};
        pg8::gemm_phase<Epi7, pg8::StaticOrder, true, true>(lds, g, S, E);
    }
    SEAM(7);
    if (IN(8)) {
        LAS bf16_t* Wsm = (LAS bf16_t*)lds; LAS bf16_t* Vs = (LAS bf16_t*)(lds + 34816);
        const int wm = wid >> 1, wn = wid & 1, h5_ = lane >> 5, r_ = lane & 31;
        const float* vgain = args.in[17]; const float* wsp = args.in[18]; const float* bsp = args.in[19];
        u32x4 pvv[4]; f32x4 pw[4][2], pg[2]; float psum[4], psq[4];
#define SG_LOAD(IT) do { const int ds_ = (IT) & 3, gg_ = ((IT) >> 2) & 3, c_ = ((IT) >> 4) & 63, b_ = (IT) >> 10; const size_t rw0 = (size_t)b_ * SEQ + (size_t)c_ * 128; const int cl0 = gg_ * 512 + ds_ * 128; \
            pg[0] = *(const f32x4*)(vgain + cl0 + (tid & 15) * 8); pg[1] = *(const f32x4*)(vgain + cl0 + (tid & 15) * 8 + 4); \
            _Pragma("unroll") for (int i = 0; i < 4; ++i) { const int idx = tid + NTHR * i, row = idx >> 4, ch = idx & 15; \
                const float* wp = wsp + ((size_t)gg_ * 128 + row) * 128 + ch * 8; pw[i][0] = *(const f32x4*)wp; pw[i][1] = *(const f32x4*)(wp + 4); \
                pvv[i] = *(const u32x4*)(VB + (rw0 + row) * 2048 + cl0 + ch * 8); psum[i] = VSUM[rw0 + row]; psq[i] = VSQ[rw0 + row]; } } while (0)
        if (bid < 2048) SG_LOAD(bid);
        for (int it = bid; it < 2048; it += G) {
            const int ds = it & 3, gg = (it >> 2) & 3, c = (it >> 4) & 63, b = it >> 10;
            const size_t row0 = (size_t)b * SEQ + (size_t)c * 128; const int col0 = gg * 512 + ds * 128;
            int h5 = h5_, r = r_; asm volatile("" : "+v"(h5), "+v"(r));
#pragma unroll
            for (int i = 0; i < 4; ++i) { const int idx = tid + NTHR * i, row = idx >> 4, ch = idx & 15;
                float w[8] = {pw[i][0].x, pw[i][0].y, pw[i][0].z, pw[i][0].w, pw[i][1].x, pw[i][1].y, pw[i][1].z, pw[i][1].w};
#pragma unroll
                for (int j = 0; j < 8; ++j) w[j] = (ch * 8 + j <= row) ? w[j] : 0.f;
                u32x4 o; o.x = pk2(w[0], w[1]); o.y = pk2(w[2], w[3]); o.z = pk2(w[4], w[5]); o.w = pk2(w[6], w[7]);
                *(LAS u32x4*)(Wsm + row * 136 + ch * 8) = o;
                const float mu = psum[i] * (1.f / 2048.f), var = fmaxf(psq[i] * (1.f / 2048.f) - mu * mu, 0.f), rstd = __builtin_amdgcn_rsqf(var + EPS);
                const u32x4 vv = pvv[i]; u32x4 o2;
                o2.x = pk2((bflo(vv.x) - mu) * rstd * pg[0].x, (bfhi(vv.x) - mu) * rstd * pg[0].y); o2.y = pk2((bflo(vv.y) - mu) * rstd * pg[0].z, (bfhi(vv.y) - mu) * rstd * pg[0].w);
                o2.z = pk2((bflo(vv.z) - mu) * rstd * pg[1].x, (bfhi(vv.z) - mu) * rstd * pg[1].y); o2.w = pk2((bflo(vv.w) - mu) * rstd * pg[1].z, (bfhi(vv.w) - mu) * rstd * pg[1].w);
                *(LAS u32x4*)(Vs + row * 136 + ch * 8) = o2; }
            __syncthreads();
            if (it + G < 2048) SG_LOAD(it + G);
            f32x16 acc[2] = {ZERO16, ZERO16};
            const int nks = 2 * wm + 2;
#pragma unroll 2
            for (int ks = 0; ks < nks; ++ks) { const int m0 = 16 * ks + 8 * h5;
                const bf16x8 a = *(const LAS bf16x8*)(Wsm + (32 * wm + r) * 136 + m0);
#pragma unroll
                for (int nt = 0; nt < 2; ++nt) { const bf16x8 bb = tr_frag(Vs, m0, 64 * wn + 32 * nt, 136, lane); acc[nt] = MFMA32(bb, a, acc[nt]); } }
            const int t = 32 * wm + r; const float bias = bsp[gg * 128 + t];
            bf16_t* dst = VB + (row0 + t) * 2048 + col0 + 64 * wn + 4 * h5;
#pragma unroll
            for (int nt = 0; nt < 2; ++nt)
#pragma unroll
                for (int iq = 0; iq < 4; ++iq) { u32x2 w; w.x = pk2(acc[nt][4 * iq] + bias, acc[nt][4 * iq + 1] + bias); w.y = pk2(acc[nt][4 * iq + 2] + bias, acc[nt][4 * iq + 3] + bias); *(u32x2*)(dst + 32 * nt + 8 * iq) = w; }
            __syncthreads();
        }
#undef SG_LOAD
    }
    SEAM(8);
    if (IN(9)) {
        pg8::Gemm g{U, WINO + (size_t)2048 * 1024, M, 4096, 1024}; pg8::StaticOrder S; S.init(M, 4096, G, bid);
        Epi9 E{RSS1, VB, CAT};
        pg8::gemm_phase<Epi9, pg8::StaticOrder, true, true>(lds, g, S, E);
    }
    SEAM(9);
    if (IN(10)) {
        pg8::Gemm g{CAT, WOUTO, M, 1024, 2048}; pg8::StaticOrder S; S.init(M, 1024, G, bid);
        EpiOut E{X1, X1, nullptr, nullptr, RSS2};
        pg8::gemm_phase<EpiOut, pg8::StaticOrder, true, true>(lds, g, S, E);
    }
    SEAM(10);
    if (IN(11)) {
        const f32x4* gr = (const f32x4*)args.in[21] + lane; f32x4 gg[4];
#pragma unroll
        for (int j = 0; j < 4; ++j) gg[j] = gr[64 * j];
        for (int m = gw; m < M; m += 4 * NGW) {
            f32x4 v[4][4]; float rs[4];
#pragma unroll
            for (int k = 0; k < 4; ++k) { const int mm = m + k * NGW; if (mm < M) { const f32x4* xr = (const f32x4*)(X1 + (size_t)mm * D) + lane; rs[k] = RSS2[mm];
#pragma unroll
                for (int j = 0; j < 4; ++j) v[k][j] = __builtin_nontemporal_load(xr + 64 * j); } }
#pragma unroll
            for (int k = 0; k < 4; ++k) { const int mm = m + k * NGW; if (mm < M) { f32x4* o = (f32x4*)(args.out + (size_t)mm * D) + lane; const float r = __builtin_amdgcn_rsqf(rs[k] * (1.f / 1024.f) + EPS);
#pragma unroll
                for (int j = 0; j < 4; ++j) { const f32x4 x_ = v[k][j]; __builtin_nontemporal_store((f32x4){x_.x * r * gg[j].x, x_.y * r * gg[j].y, x_.z * r * gg[j].z, x_.w * r * gg[j].w}, o + 64 * j); } } }
        }
    }
#undef IN
#undef SEAM
}

extern "C" void kernel_launch(void* const* d_in, const int* in_sizes, int n_in, void* d_out, int out_size, void* d_ws, size_t ws_size, hipStream_t stream) {
    static int grid = 0;
    if (grid == 0) {
        if (n_in != 22 || out_size != M * D || ws_size < WS_END) { fprintf(stderr, "kernel_launch: unexpected shapes (n_in %d out %d ws %zu)\n", n_in, out_size, ws_size); grid = -1; return; }
        int dev = 0, cus = 0, per_cu = 0;
        hipGetDevice(&dev); hipDeviceGetAttribute(&cus, hipDeviceAttributeMultiprocessorCount, dev);
        if (hipFuncSetAttribute((const void*)mk_fwd, hipFuncAttributeMaxDynamicSharedMemorySize, LDS_BYTES) != hipSuccess) { fprintf(stderr, "kernel_launch: hipFuncSetAttribute failed\n"); grid = -1; return; }
        if (hipOccupancyMaxActiveBlocksPerMultiprocessor(&per_cu, (const void*)mk_fwd, NTHR, LDS_BYTES) != hipSuccess || per_cu < 1) { fprintf(stderr, "kernel_launch: occupancy query says %d\n", per_cu); grid = -1; return; }
        grid = cus * (per_cu > 1 ? 1 : per_cu);
    }
    if (grid < 0) return;
    if (hipMemsetAsync((char*)d_ws + WS_BAR, 0, BAR_BYTES, stream) != hipSuccess) { fprintf(stderr, "kernel_launch: memset failed\n"); return; }
    Args a{};
    for (int i = 0; i < 22; ++i) a.in[i] = (const float*)d_in[i];
    a.out = (float*)d_out; a.ws = (unsigned char*)d_ws;
#if MK_PER_PHASE
#ifdef PROBE_PREFIX
    for (int p = 0; p <= PROBE_PREFIX; ++p) { a.ph_lo = p; a.ph_hi = p + 1; hipLaunchKernelGGL(mk_fwd, dim3(grid), dim3(NTHR), LDS_BYTES, stream, a); }
#endif
    for (int p = 0; p < NPH; ++p) { a.ph_lo = p; a.ph_hi = p + 1; hipLaunchKernelGGL(mk_fwd, dim3(grid), dim3(NTHR), LDS_BYTES, stream, a); }
#else
    a.ph_lo = 0; a.ph_hi = NPH;
    void* kargs[] = {&a};
    hipError_t e = hipLaunchCooperativeKernel((const void*)mk_fwd, dim3(grid), dim3(NTHR), kargs, LDS_BYTES, stream);
    if (e != hipSuccess) fprintf(stderr, "kernel_launch: cooperative launch failed: %s (grid %d)\n", hipGetErrorString(e), grid);
#endif
}
```
